# Optimizing an MI355X kernel written in HIP

```python
import math
import jax
import jax.numpy as jnp
from jax import lax
import numpy as np

D_MODEL = 2048
BATCH = 2
SEQ = 4096
DEPTH = 1

HEAD_DIM = 64
ATT_HEADS = 16
RWKV_HEADS = 16
ATT_WIDTH = ATT_HEADS * HEAD_DIM
RWKV_WIDTH = RWKV_HEADS * HEAD_DIM
MIX_WIDTH = ATT_WIDTH + RWKV_WIDTH
MOBA_BLOCK = 256
MOBA_TOPK = 3
Q_CHUNK = 128
REL_BUCKETS = 32
REL_MAX_DIST = 128
DECAY_LORA = 64
AAA_LORA = 64
GATE_LORA = 160
RWKV_COLS = 3 * RWKV_WIDTH + DECAY_LORA + AAA_LORA + GATE_LORA
IN_COLS = 3 * ATT_WIDTH + RWKV_COLS
D_FF = 5632
PLE_DIM = 256
LN_EPS = 1e-5
GN_EPS = 64e-5
NEG = -1e30
DEEPNORM_ALPHA = (2 * DEPTH) ** 0.25
DEEPNORM_BETA = (8 * DEPTH) ** -0.25

kernel_name = "hymba_moba_rwkv7_macaron_deepnorm"


def layer_norm(x, g, b):
    xf = x.astype(jnp.float32)
    mu = xf.mean(-1, keepdims=True)
    var = jnp.square(xf - mu).mean(-1, keepdims=True)
    return (xf - mu) * lax.rsqrt(var + LN_EPS) * g + b


def swiglu(x, w_gate, w_up, w_down):
    return (jax.nn.silu(x @ w_gate) * (x @ w_up)) @ w_down


def rel_bucket(dist):
    max_exact = REL_BUCKETS // 2
    n = jnp.maximum(dist, 0)
    nf = jnp.maximum(n, 1).astype(jnp.float32)
    large = max_exact + (jnp.log(nf / max_exact) / math.log(REL_MAX_DIST / max_exact)
                         * (REL_BUCKETS - max_exact)).astype(jnp.int32)
    large = jnp.minimum(large, REL_BUCKETS - 1)
    return jnp.where(n < max_exact, n, large)


def moba_attention(q, k, v, rel_bias):
    B, H, S, Dh = q.shape
    nb = -(-S // MOBA_BLOCK)
    pad = nb * MOBA_BLOCK - S
    kp = jnp.pad(k, ((0, 0), (0, 0), (0, pad), (0, 0)))
    vp = jnp.pad(v, ((0, 0), (0, 0), (0, pad), (0, 0)))
    k_blk = kp.reshape(B, H, nb, MOBA_BLOCK, Dh)
    v_blk = vp.reshape(B, H, nb, MOBA_BLOCK, Dh)
    k_mean = k_blk.mean(axis=3)
    topk = min(MOBA_TOPK, nb)
    bias_hb = rel_bias.T.astype(jnp.float32)
    head_idx = jnp.arange(H)[None, :, None, None, None]
    offs = jnp.arange(MOBA_BLOCK)
    scale = Dh ** -0.5
    gather = jax.vmap(jax.vmap(lambda blocks, idx: blocks[idx]))

    def chunk(c):
        q0 = c * Q_CHUNK
        qc = lax.dynamic_slice_in_dim(q, q0, Q_CHUNK, axis=2)
        q_pos = q0 + jnp.arange(Q_CHUNK)
        own = q0 // MOBA_BLOCK
        gate = jnp.einsum('bhqd,bhnd->bhqn', qc, k_mean)
        gate = jnp.where(jnp.arange(nb) < own, gate, -jnp.inf)
        _, sel = lax.top_k(gate, topk)
        sel_ok = jnp.arange(topk) < own
        ks = gather(k_blk, sel)
        vs = gather(v_blk, sel)
        s_sel = jnp.einsum('bhqd,bhqnld->bhqnl', qc, ks) * scale
        k_pos_sel = sel[..., None] * MOBA_BLOCK + offs
        b_sel = bias_hb[head_idx, rel_bucket(q_pos[None, None, :, None, None] - k_pos_sel)]
        s_sel = jnp.where(sel_ok[:, None], s_sel + b_sel, NEG)
        k_own = lax.dynamic_slice_in_dim(kp, own * MOBA_BLOCK, MOBA_BLOCK, axis=2)
        v_own = lax.dynamic_slice_in_dim(vp, own * MOBA_BLOCK, MOBA_BLOCK, axis=2)
        dist_own = q_pos[:, None] - (own * MOBA_BLOCK + offs)[None, :]
        s_own = jnp.einsum('bhqd,bhld->bhql', qc, k_own) * scale
        s_own = jnp.where(dist_own >= 0, s_own + bias_hb[:, rel_bucket(dist_own)], NEG)
        n_sel = topk * MOBA_BLOCK
        logits = jnp.concatenate([s_sel.reshape(B, H, Q_CHUNK, n_sel), s_own], axis=-1)
        probs = jax.nn.softmax(logits, axis=-1)
        p_sel = probs[..., :n_sel].reshape(B, H, Q_CHUNK, topk, MOBA_BLOCK)
        p_own = probs[..., n_sel:]
        return (jnp.einsum('bhqnl,bhqnld->bhqd', p_sel, vs)
                + jnp.einsum('bhql,bhld->bhqd', p_own, v_own))

    outs = lax.map(chunk, jnp.arange(S // Q_CHUNK))
    return outs.transpose(1, 2, 0, 3, 4).reshape(B, H, S, Dh)


def rwkv7_time_mix(u, shift_mix, w0, w2, a0, a2, g2, k_k, k_a, r_k, gn_g, gn_b):
    u = u.astype(jnp.float32)
    B, S, _ = u.shape
    H, N, C = RWKV_HEADS, HEAD_DIM, RWKV_WIDTH
    prev = jnp.pad(u, ((0, 0), (1, 0), (0, 0)))[:, :-1]
    u = u + (prev - u) * shift_mix
    r = u[..., 0:C]
    k = u[..., C:2 * C]
    v = u[..., 2 * C:3 * C]
    wd = u[..., 3 * C:3 * C + DECAY_LORA]
    ad = u[..., 3 * C + DECAY_LORA:3 * C + DECAY_LORA + AAA_LORA]
    gd = u[..., 3 * C + DECAY_LORA + AAA_LORA:]
    w_log = -jax.nn.softplus(-(w0 + jnp.tanh(wd) @ w2)) - 0.5
    decay = jnp.exp(-jnp.exp(w_log))
    a = jax.nn.sigmoid(a0 + ad @ a2)
    g = jax.nn.sigmoid(gd) @ g2
    kk = (k * k_k).reshape(B, S, H, N)
    kk = kk / jnp.maximum(jnp.linalg.norm(kk, axis=-1, keepdims=True), 1e-12)
    k = k * (1.0 + (a - 1.0) * k_a)
    hd = lambda t: t.reshape(B, S, H, N)
    r_h, k_h, v_h, w_h, a_h = hd(r), hd(k), hd(v), hd(decay), hd(a)

    def step(state, inp):
        r_t, w_t, k_t, v_t, aa_t, bb_t = inp
        sa = jnp.einsum('bhij,bhj->bhi', state, aa_t)
        state = (state * w_t[:, :, None, :] + sa[..., None] * bb_t[:, :, None, :]
                 + v_t[..., None] * k_t[:, :, None, :])
        return state, jnp.einsum('bhij,bhj->bhi', state, r_t)

    xs = tuple(t.transpose(1, 0, 2, 3) for t in (r_h, w_h, k_h, v_h, -kk, kk * a_h))
    _, ys = lax.scan(step, jnp.zeros((B, H, N, N), jnp.float32), xs)
    y = ys.transpose(1, 0, 2, 3)
    mu = y.mean(-1, keepdims=True)
    var = jnp.square(y - mu).mean(-1, keepdims=True)
    y = ((y - mu) * lax.rsqrt(var + GN_EPS)).reshape(B, S, C) * gn_g + gn_b
    bonus = (r_h * k_h * r_k).sum(-1, keepdims=True) * v_h
    return (y + bonus.reshape(B, S, C)) * g


def setup_inputs(seed: int = 0) -> dict:
    key = jax.random.key(seed)
    ks = iter(jax.random.split(key, 40))
    nrm = lambda shape, s: jax.random.normal(next(ks), shape, jnp.float32) * s
    gain = lambda shape: 1.0 + nrm(shape, 0.02)
    L = DEPTH
    col_scale = jnp.concatenate([
        jnp.ones((2 * ATT_WIDTH,), jnp.float32),
        jnp.full((ATT_WIDTH,), DEEPNORM_BETA, jnp.float32),
        jnp.ones((2 * RWKV_WIDTH,), jnp.float32),
        jnp.full((RWKV_WIDTH,), DEEPNORM_BETA, jnp.float32),
        jnp.ones((DECAY_LORA + AAA_LORA + GATE_LORA,), jnp.float32)])
    return {
        "x": nrm((BATCH, SEQ, D_MODEL), 1.0),
        "p": nrm((DEPTH, BATCH, SEQ, PLE_DIM), 1.0),
        "ffn1_w_gate": nrm((L, D_MODEL, D_FF), D_MODEL ** -0.5),
        "ffn1_w_up": nrm((L, D_MODEL, D_FF), D_MODEL ** -0.5),
        "ffn1_w_down": nrm((L, D_FF, D_MODEL), DEEPNORM_BETA * D_FF ** -0.5),
        "ln1_g": gain((L, D_MODEL)),
        "ln1_b": nrm((L, D_MODEL), 0.02),
        "w_in": nrm((L, D_MODEL, IN_COLS), D_MODEL ** -0.5) * col_scale,
        "rel_bias": nrm((REL_BUCKETS, ATT_HEADS), 0.5),
        "shift_mix": jax.random.uniform(next(ks), (L, RWKV_COLS), jnp.float32),
        "decay_w0": jax.random.uniform(next(ks), (L, RWKV_WIDTH), jnp.float32, -6.0, 1.0),
        "decay_w2": nrm((L, DECAY_LORA, RWKV_WIDTH), 0.5 * DECAY_LORA ** -0.5),
        "a_a0": nrm((L, RWKV_WIDTH), 0.1),
        "a_a2": nrm((L, AAA_LORA, RWKV_WIDTH), 0.5 * AAA_LORA ** -0.5),
        "gate_g2": nrm((L, GATE_LORA, RWKV_WIDTH), GATE_LORA ** -0.5),
        "k_k": 0.85 + nrm((L, RWKV_WIDTH), 0.05),
        "k_a": 1.0 + nrm((L, RWKV_WIDTH), 0.05),
        "r_k": nrm((L, RWKV_HEADS, HEAD_DIM), 0.1),
        "gn_g": gain((L, RWKV_WIDTH)),
        "gn_b": nrm((L, RWKV_WIDTH), 0.02),
        "w_out": nrm((L, MIX_WIDTH, D_MODEL), DEEPNORM_BETA * MIX_WIDTH ** -0.5),
        "ln2_g": gain((L, D_MODEL)),
        "ln2_b": nrm((L, D_MODEL), 0.02),
        "ffn2_w_gate": nrm((L, D_MODEL, D_FF), D_MODEL ** -0.5),
        "ffn2_w_up": nrm((L, D_MODEL, D_FF), D_MODEL ** -0.5),
        "ffn2_w_down": nrm((L, D_FF, D_MODEL), DEEPNORM_BETA * D_FF ** -0.5),
        "ln3_g": gain((L, D_MODEL)),
        "ln3_b": nrm((L, D_MODEL), 0.02),
        "ple_w_up": nrm((L, PLE_DIM, D_MODEL), DEEPNORM_BETA * PLE_DIM ** -0.5),
        "ple_w_gate": nrm((L, D_MODEL, D_MODEL), D_MODEL ** -0.5),
        "ple_b_gate": nrm((L, D_MODEL), 0.02),
        "ln4_g": gain((L, D_MODEL)),
        "ln4_b": nrm((L, D_MODEL), 0.02),
    }


def reference(x, p, ffn1_w_gate, ffn1_w_up, ffn1_w_down, ln1_g, ln1_b, w_in, rel_bias,
              shift_mix, decay_w0, decay_w2, a_a0, a_a2, gate_g2, k_k, k_a, r_k, gn_g, gn_b,
              w_out, ln2_g, ln2_b, ffn2_w_gate, ffn2_w_up, ffn2_w_down, ln3_g, ln3_b,
              ple_w_up, ple_w_gate, ple_b_gate, ln4_g, ln4_b):
    B, S, _ = x.shape
    h = x.astype(jnp.float32)
    alpha = DEEPNORM_ALPHA
    for i in range(DEPTH):
        h = layer_norm(alpha * h + 0.5 * swiglu(h, ffn1_w_gate[i], ffn1_w_up[i], ffn1_w_down[i]),
                       ln1_g[i], ln1_b[i])
        u = (h @ w_in[i]).astype(jnp.float32)
        heads = lambda t: t.reshape(B, S, ATT_HEADS, HEAD_DIM).transpose(0, 2, 1, 3)
        q = heads(u[..., 0:ATT_WIDTH])
        k = heads(u[..., ATT_WIDTH:2 * ATT_WIDTH])
        v = heads(u[..., 2 * ATT_WIDTH:3 * ATT_WIDTH])
        att = moba_attention(q, k, v, rel_bias)
        att = att.transpose(0, 2, 1, 3).reshape(B, S, ATT_WIDTH)
        rw = rwkv7_time_mix(u[..., 3 * ATT_WIDTH:], shift_mix[i], decay_w0[i], decay_w2[i],
                            a_a0[i], a_a2[i], gate_g2[i], k_k[i], k_a[i], r_k[i], gn_g[i], gn_b[i])
        mix = jnp.concatenate([att, rw], axis=-1) @ w_out[i]
        h = layer_norm(alpha * h + mix, ln2_g[i], ln2_b[i])
        h = layer_norm(alpha * h + 0.5 * swiglu(h, ffn2_w_gate[i], ffn2_w_up[i], ffn2_w_down[i]),
                       ln3_g[i], ln3_b[i])
        e = p[i].astype(jnp.float32) @ ple_w_up[i]
        gate = jax.nn.sigmoid(h @ ple_w_gate[i] + ple_b_gate[i])
        h = layer_norm(alpha * h + gate * e, ln4_g[i], ln4_b[i])
    return h.astype(x.dtype)
```

```cpp
#include <hip/hip_runtime.h>
#include <cstdio>
#include <cstdint>
namespace pg8 {
#define PG8_LAS __attribute__((address_space(3)))
typedef unsigned short bf16_t;
typedef short bf16x8 __attribute__((ext_vector_type(8)));
typedef float f32x4 __attribute__((ext_vector_type(4)));
typedef unsigned u32x4 __attribute__((ext_vector_type(4)));
constexpr int BM = 256, BK = 64, HALF = 128, HTB = HALF * BK * 2  , STAGE_BYTES = 8 * HTB, NXCD = 8, WGM = 8;

__host__ __device__ __forceinline__ int lds_byte(int r, int c) { const int st = (r >> 4) * 2 + (c >> 5), rr = r & 15, cc = c & 31, ob = rr * 64 + cc * 2; return st * 1024 + (ob ^ (((ob >> 9) & 1) << 5)); }
__host__ __device__ __forceinline__ void stage_rc(int b, int& R, int& C) { const int st = b / 1024, sb = b % 1024, swz = sb ^ (((sb >> 9) & 1) << 5); R = (st >> 1) * 16 + swz / 64; C = (st & 1) * 32 + (swz % 64) / 2; }
__host__ __device__ __forceinline__ int perm32(int rho) { const int n = rho >> 4, i = rho & 15; return 8 * (i >> 2) + 4 * n + (i & 3); }

struct Unit { int pm, pn; };
struct Gemm { const bf16_t* A; const bf16_t* Bt; int M, N, K; };

struct StaticOrder {
    int nM, nN, nwg, G, c;
    __host__ __device__ void init(int M, int N, int G_, int c_) { nM = M / BM; nN = N / BM; nwg = nM * nN; G = G_; c = c_; }
    __host__ __device__ bool next(int i, Unit& u) const {
        const long L = (long)i * G + c; if (L >= nwg) return false;
        int wgid = (int)L; { const int q = nwg / NXCD, r = nwg % NXCD, xcd = wgid % NXCD, off = wgid / NXCD; wgid = (xcd < r ? xcd * (q + 1) : r * (q + 1) + (xcd - r) * q) + off; }
        const int nig = WGM * nN, gid = wgid / nig, fm = gid * WGM, gsz = (nM - fm) < WGM ? (nM - fm) : WGM;
        u.pm = fm + ((wgid % nig) % gsz); u.pn = (wgid % nig) / gsz; return true;
    }
    __device__ __forceinline__ void a_ready(const Unit&) const {}
    __device__ __forceinline__ void done(const Unit&) const {}
};

__device__ __forceinline__ unsigned cvt_pk_bf16(float lo, float hi) { unsigned r; asm volatile("v_cvt_pk_bf16_f32 %0, %1, %2" : "=v"(r) : "v"(lo), "v"(hi)); return r; }
typedef float f32x2 __attribute__((ext_vector_type(2)));
__device__ __forceinline__ f32x2 gelu_pk(f32x2 v) {
    const f32x2 av = __builtin_elementwise_abs(v), d = av * 0.2316418882f + 1.0f;
    f32x2 t; t.x = __builtin_amdgcn_rcpf(d.x); t.y = __builtin_amdgcn_rcpf(d.y);
    f32x2 q = t * 0.5307027145f + (-0.7265760135f); q = q * t + 0.7107068705f; q = q * t + (-0.142248368f); q = q * t + 0.127414796f; q = q * t;
    const f32x2 s = (v * v) * (-0.72134752044f);
    f32x2 e; e.x = __builtin_amdgcn_exp2f(s.x); e.y = __builtin_amdgcn_exp2f(s.y);
    const f32x2 m = v * (q * e), r = v - m;
    f32x2 o; o.x = v.x < 0.f ? m.x : r.x; o.y = v.y < 0.f ? m.y : r.y; return o;
}

template <int ACT  > struct EpiBf16 {
    static constexpr bool PERM = true, AFTER_DRAIN = false; static_assert(ACT == 0 || ACT == 1, "EpiBf16: ACT is 0 (none) or 1 (gelu_pk)");
    bf16_t* O; int ldc; const float* bias; int split_cols; size_t split_stride; float scale0;
    __device__ __forceinline__ void operator()(const f32x4 (&acc)[2][2][4][2], const Unit& u, int wr, int wc, int fr, int fq) const {
        const int row0 = u.pm * BM + wr * 64 + fr; int colt = u.pn * BM; bf16_t* base = O;
        float sc = 1.f; if (split_cols) { const int t = colt / split_cols; base += (size_t)t * split_stride; colt -= t * split_cols; if (t == 0) sc = scale0; }
        const int col0 = colt + wc * 32 + 8 * fq, bcol0 = u.pn * BM + wc * 32 + 8 * fq;
        f32x4 bv[2][2];
#pragma unroll
        for (int bj = 0; bj < 2; ++bj)
#pragma unroll
            for (int n = 0; n < 2; ++n) bv[bj][n] = bias ? *(const f32x4*)(bias + bcol0 + bj * HALF + 4 * n) : (f32x4){0.f, 0.f, 0.f, 0.f};
#pragma unroll
        for (int ai = 0; ai < 2; ++ai)
#pragma unroll
            for (int m = 0; m < 4; ++m) { bf16_t* rowp = base + (size_t)(row0 + ai * HALF + m * 16) * ldc + col0;
#pragma unroll
                for (int bj = 0; bj < 2; ++bj) { f32x4 v0 = acc[ai][bj][m][0] + bv[bj][0], v1 = acc[ai][bj][m][1] + bv[bj][1];
                    if (ACT == 1) { f32x2 a = gelu_pk((f32x2){v0[0], v0[1]}), b = gelu_pk((f32x2){v0[2], v0[3]}), c = gelu_pk((f32x2){v1[0], v1[1]}), d = gelu_pk((f32x2){v1[2], v1[3]});
                        v0 = (f32x4){a.x, a.y, b.x, b.y}; v1 = (f32x4){c.x, c.y, d.x, d.y}; }
                    v0 = v0 * sc; v1 = v1 * sc; u32x4 w; w.x = cvt_pk_bf16(v0[0], v0[1]); w.y = cvt_pk_bf16(v0[2], v0[3]); w.z = cvt_pk_bf16(v1[0], v1[1]); w.w = cvt_pk_bf16(v1[2], v1[3]);
                    *(u32x4*)(rowp + bj * HALF) = w; } }
    }
};
__device__ __forceinline__ float sigmoid_f(float x) { return __builtin_amdgcn_rcpf(1.0f + __builtin_amdgcn_exp2f(-1.4426950408889634f * x)); }
struct EpiSwiGLU {
    static constexpr bool PERM = true, AFTER_DRAIN = false;
    bf16_t* O; int ldc;
    __device__ __forceinline__ void operator()(const f32x4 (&acc)[2][2][4][2], const Unit& u, int wr, int wc, int fr, int fq) const {
        const int row0 = u.pm * BM + wr * 64 + fr; const int col0 = u.pn * HALF + wc * 32 + 8 * fq;
#pragma unroll
        for (int ai = 0; ai < 2; ++ai)
#pragma unroll
            for (int m = 0; m < 4; ++m) { bf16_t* rowp = O + (size_t)(row0 + ai * HALF + m * 16) * ldc + col0;
                const f32x4 g0 = acc[ai][0][m][0], g1 = acc[ai][0][m][1], u0 = acc[ai][1][m][0], u1 = acc[ai][1][m][1];
                f32x4 h0, h1;
#pragma unroll
                for (int i = 0; i < 4; ++i) { h0[i] = g0[i] * sigmoid_f(g0[i]) * u0[i]; h1[i] = g1[i] * sigmoid_f(g1[i]) * u1[i]; }
                u32x4 w; w.x = cvt_pk_bf16(h0[0], h0[1]); w.y = cvt_pk_bf16(h0[2], h0[3]); w.z = cvt_pk_bf16(h1[0], h1[1]); w.w = cvt_pk_bf16(h1[2], h1[3]);
                *(u32x4*)rowp = w; }
    }
};
struct EpiResid {
    static constexpr bool PERM = false, AFTER_DRAIN = false;
    const float* base; float* out; int ldc; float alpha, s;
    __device__ __forceinline__ void operator()(const f32x4 (&acc)[2][2][4][2], const Unit& u, int wr, int wc, int fr, int fq) const {
        const int col0 = u.pn * BM + wc * 32 + 4 * fq;
#pragma unroll
        for (int ai = 0; ai < 2; ++ai)
#pragma unroll
            for (int m = 0; m < 4; ++m) { const size_t off = (size_t)(u.pm * BM + ai * HALF + wr * 64 + m * 16 + fr) * ldc + col0;
#pragma unroll
                for (int bj = 0; bj < 2; ++bj)
#pragma unroll
                    for (int n = 0; n < 2; ++n) { const f32x4 bs = *(const f32x4*)(base + off + bj * HALF + n * 16);
                        *(f32x4*)(out + off + bj * HALF + n * 16) = bs * alpha + acc[ai][bj][m][n] * s; }
                if (m & 1) asm volatile("" ::: "memory"); }
    }
};
struct EpiPle {
    static constexpr bool PERM = false, AFTER_DRAIN = false;
    const float* base; float* out; const bf16_t* e; const float* bias; int ldc; float alpha;
    __device__ __forceinline__ void operator()(const f32x4 (&acc)[2][2][4][2], const Unit& u, int wr, int wc, int fr, int fq) const {
        typedef unsigned u32x2v __attribute__((ext_vector_type(2)));
        const int col0 = u.pn * BM + wc * 32 + 4 * fq;
        f32x4 bv[2][2];
#pragma unroll
        for (int bj = 0; bj < 2; ++bj)
#pragma unroll
            for (int n = 0; n < 2; ++n) bv[bj][n] = *(const f32x4*)(bias + col0 + bj * HALF + n * 16);
#pragma unroll
        for (int ai = 0; ai < 2; ++ai)
#pragma unroll
            for (int m = 0; m < 4; ++m) { const size_t off = (size_t)(u.pm * BM + ai * HALF + wr * 64 + m * 16 + fr) * ldc + col0;
#pragma unroll
                for (int bj = 0; bj < 2; ++bj)
#pragma unroll
                    for (int n = 0; n < 2; ++n) { const f32x4 bs = *(const f32x4*)(base + off + bj * HALF + n * 16);
                        const u32x2v ew = *(const u32x2v*)(e + off + bj * HALF + n * 16);
                        f32x4 ev; ev[0] = __uint_as_float(ew.x << 16); ev[1] = __uint_as_float(ew.x & 0xffff0000u); ev[2] = __uint_as_float(ew.y << 16); ev[3] = __uint_as_float(ew.y & 0xffff0000u);
                        const f32x4 a = acc[ai][bj][m][n] + bv[bj][n]; f32x4 o;
#pragma unroll
                        for (int i = 0; i < 4; ++i) o[i] = bs[i] * alpha + sigmoid_f(a[i]) * ev[i];
                        *(f32x4*)(out + off + bj * HALF + n * 16) = o; }
                if (m & 1) asm volatile("" ::: "memory"); }
    }
};
template <class Epi, class Sched, bool ALIGN_EPI = false, bool SP2 = false>
__device__ __forceinline__ void gemm_phase(PG8_LAS unsigned char* lds, const Gemm g, const Sched& S, const Epi& E) {
    const int tid = threadIdx.x, wid = __builtin_amdgcn_readfirstlane(tid >> 6), lane = tid & 63, wr = wid >> 2, wc = wid & 3, fr = lane & 15, fq = lane >> 4;
    const int K = g.K, nt = K / BK;
    unsigned voffA[2], voffB[2];
#pragma unroll
    for (int i = 0; i < 2; ++i) { int R, C; stage_rc(tid * 16 + i * 8192, R, C); const int Rb = Epi::PERM ? ((R & ~31) + perm32(R & 31)) : R;
        voffA[i] = (unsigned)(R * K + C) * 2u; voffB[i] = (unsigned)(Rb * K + C) * 2u; }
    const size_t kstep = (size_t)(BK * 2);
    const size_t hstep = (size_t)HALF * K * 2;
    const size_t tstep = 2 * hstep;
    const unsigned ldsw = (unsigned)wid * 1024u;
    const int aoff = lds_byte(wr * 64 + fr, fq * 8), boff = lds_byte(wc * 32 + fr, fq * 8);
#define PG8_SA(b, h) (((b) * 2 + (h)) * HTB)
#define PG8_SB(b, h) ((4 + (b) * 2 + (h)) * HTB)
#define PG8_STAGE(bufoff, gbase, voff) do { _Pragma("unroll") for (int _i = 0; _i < 2; ++_i) \
        __builtin_amdgcn_global_load_lds((const unsigned*)((const char*)(gbase) + (voff)[_i]), (PG8_LAS unsigned*)(lds + (bufoff) + ldsw + _i * 8192), 16, 0, 0); } while (0)
#define PG8_LDA(dst, b, h) do { _Pragma("unroll") for (int m = 0; m < 4; ++m) _Pragma("unroll") for (int k = 0; k < 2; ++k) dst[m][k] = *(const PG8_LAS bf16x8*)(lds + PG8_SA(b, h) + aoff + m * 2048 + k * 1024); } while (0)
#define PG8_LDB(dst, b, h) do { _Pragma("unroll") for (int n = 0; n < 2; ++n) _Pragma("unroll") for (int k = 0; k < 2; ++k) dst[n][k] = *(const PG8_LAS bf16x8*)(lds + PG8_SB(b, h) + boff + n * 2048 + k * 1024); } while (0)
#define PG8_MMA(ai, bj, At, Bt) do { __builtin_amdgcn_s_setprio(1); _Pragma("unroll") for (int m = 0; m < 4; ++m) _Pragma("unroll") for (int n = 0; n < 2; ++n) _Pragma("unroll") for (int k = 0; k < 2; ++k) \
        acc[ai][bj][m][n] = __builtin_amdgcn_mfma_f32_16x16x32_bf16(Bt[n][k], At[m][k], acc[ai][bj][m][n], 0, 0, 0); __builtin_amdgcn_s_setprio(0); } while (0)
#define PG8_WAIT_V(n) asm volatile("s_waitcnt vmcnt(" #n ")" ::: "memory")
#define PG8_WAIT_L(n) asm volatile("s_waitcnt lgkmcnt(" #n ")" ::: "memory")
#define PG8_BAR __builtin_amdgcn_s_barrier()
#define PG8_SCHED __builtin_amdgcn_sched_barrier(0)
    Unit cur, nxt; int ui = 0;
    if (!S.next(0, cur)) return;
    f32x4 acc[2][2][4][2];
#pragma unroll
    for (int a = 0; a < 2; ++a)
#pragma unroll
        for (int b = 0; b < 2; ++b)
#pragma unroll
            for (int m = 0; m < 4; ++m)
#pragma unroll
                for (int n = 0; n < 2; ++n) acc[a][b][m][n] = (f32x4){0.f, 0.f, 0.f, 0.f};
    bf16x8 At[4][2], B0[2][2], B1[2][2];
    const char* cA = (const char*)g.A + (size_t)cur.pm * tstep; const char* cB = (const char*)g.Bt + (size_t)cur.pn * tstep;
    S.a_ready(cur);
    if constexpr (SP2) {
        PG8_STAGE(PG8_SB(0, 0), cB, voffB); PG8_STAGE(PG8_SB(0, 1), cB + hstep, voffB); PG8_STAGE(PG8_SA(0, 0), cA, voffA); PG8_STAGE(PG8_SA(0, 1), cA + hstep, voffA);
        if (wr == 1) PG8_BAR;
        PG8_WAIT_V(2); PG8_BAR;
        PG8_STAGE(PG8_SB(1, 0), cB + kstep, voffB); PG8_STAGE(PG8_SA(1, 0), cA + kstep, voffA); PG8_STAGE(PG8_SB(1, 1), cB + hstep + kstep, voffB);
        PG8_WAIT_V(6); PG8_BAR;
    } else {
        PG8_STAGE(PG8_SB(0, 0), cB, voffB); PG8_STAGE(PG8_SA(0, 0), cA, voffA); PG8_STAGE(PG8_SB(0, 1), cB + hstep, voffB); PG8_STAGE(PG8_SA(0, 1), cA + hstep, voffA);
        if (wr == 1) PG8_BAR;
        PG8_WAIT_V(4); PG8_BAR;
        PG8_STAGE(PG8_SB(1, 0), cB + kstep, voffB); PG8_STAGE(PG8_SA(1, 0), cA + kstep, voffA); PG8_STAGE(PG8_SB(1, 1), cB + hstep + kstep, voffB);
        PG8_WAIT_V(6); PG8_BAR;
    }
    for (;;) {
        const bool has_next = S.next(ui + 1, nxt);
        const char* nA = has_next ? (const char*)g.A + (size_t)nxt.pm * tstep : cA; const char* nB = has_next ? (const char*)g.Bt + (size_t)nxt.pn * tstep : cB;
        for (int t = 0; t < nt; t += 2) {
            const bool last = (t == nt - 2);
            const char* a1 = cA + (size_t)(t + 1) * kstep;
            const char* a2 = last ? nA : cA + (size_t)(t + 2) * kstep; const char* b2 = last ? nB : cB + (size_t)(t + 2) * kstep;
            const char* a3 = a2 + kstep; const char* b3 = b2 + kstep;
            if (last && has_next) S.a_ready(nxt);
            if constexpr (SP2) {
            PG8_LDB(B0, 0, 0); PG8_LDB(B1, 0, 1); PG8_SCHED; PG8_LDA(At, 0, 0); PG8_STAGE(PG8_SA(1, 1), a1 + hstep, voffA);
            PG8_WAIT_V(8); PG8_WAIT_L(0); PG8_BAR; PG8_MMA(0, 0, At, B0); PG8_MMA(0, 1, At, B1); PG8_BAR; PG8_SCHED;
            PG8_LDA(At, 0, 1); PG8_STAGE(PG8_SB(0, 0), b2, voffB); PG8_STAGE(PG8_SB(0, 1), b2 + hstep, voffB); PG8_STAGE(PG8_SA(0, 0), a2, voffA);
            PG8_WAIT_V(8); PG8_WAIT_L(0); PG8_BAR; PG8_MMA(1, 0, At, B0); PG8_MMA(1, 1, At, B1); PG8_BAR; PG8_SCHED;
            PG8_LDB(B0, 1, 0); PG8_LDB(B1, 1, 1); PG8_SCHED; PG8_LDA(At, 1, 0); PG8_STAGE(PG8_SA(0, 1), a2 + hstep, voffA);
            PG8_WAIT_V(8); PG8_WAIT_L(0); PG8_BAR; PG8_MMA(0, 0, At, B0); PG8_MMA(0, 1, At, B1); PG8_BAR; PG8_SCHED;
            PG8_LDA(At, 1, 1); PG8_STAGE(PG8_SB(1, 0), b3, voffB); PG8_STAGE(PG8_SB(1, 1), b3 + hstep, voffB); PG8_STAGE(PG8_SA(1, 0), a3, voffA);
            PG8_WAIT_V(8); PG8_WAIT_L(0); PG8_BAR; PG8_MMA(1, 0, At, B0); PG8_MMA(1, 1, At, B1); PG8_BAR; PG8_SCHED;
            } else {
            PG8_LDB(B0, 0, 0); PG8_SCHED; PG8_LDA(At, 0, 0); PG8_STAGE(PG8_SA(1, 1), a1 + hstep, voffA);
            PG8_WAIT_L(8); PG8_BAR; PG8_WAIT_L(0); PG8_MMA(0, 0, At, B0); PG8_BAR; PG8_SCHED;
            PG8_LDB(B1, 0, 1); PG8_STAGE(PG8_SB(0, 0), b2, voffB);
            PG8_BAR; PG8_WAIT_L(0); PG8_MMA(0, 1, At, B1); PG8_BAR;
            PG8_LDA(At, 0, 1); PG8_STAGE(PG8_SA(0, 0), a2, voffA);
            PG8_BAR; PG8_WAIT_L(0); PG8_MMA(1, 0, At, B0); PG8_BAR; PG8_SCHED;
            PG8_STAGE(PG8_SB(0, 1), b2 + hstep, voffB);
            PG8_WAIT_V(6); PG8_BAR; PG8_MMA(1, 1, At, B1); PG8_BAR;
            PG8_LDB(B0, 1, 0); PG8_SCHED; PG8_LDA(At, 1, 0); PG8_STAGE(PG8_SA(0, 1), a2 + hstep, voffA);
            PG8_WAIT_L(8); PG8_BAR; PG8_WAIT_L(0); PG8_MMA(0, 0, At, B0); PG8_BAR; PG8_SCHED;
            PG8_LDB(B1, 1, 1); PG8_STAGE(PG8_SB(1, 0), b3, voffB);
            PG8_BAR; PG8_WAIT_L(0); PG8_MMA(0, 1, At, B1); PG8_BAR;
            PG8_LDA(At, 1, 1); PG8_STAGE(PG8_SA(1, 0), a3, voffA);
            PG8_BAR; PG8_WAIT_L(0); PG8_MMA(1, 0, At, B0); PG8_BAR; PG8_SCHED;
            PG8_STAGE(PG8_SB(1, 1), b3 + hstep, voffB);
            PG8_WAIT_V(6); PG8_BAR; PG8_MMA(1, 1, At, B1); PG8_BAR;
            }
        }
        if constexpr (ALIGN_EPI) { if (wr == 0) PG8_BAR; }
        if constexpr (!Epi::AFTER_DRAIN) { E(acc, cur, wr, wc, fr, fq); S.done(cur); }
        if (!has_next) break;
#pragma unroll
        for (int a = 0; a < 2; ++a)
#pragma unroll
            for (int b = 0; b < 2; ++b)
#pragma unroll
                for (int m = 0; m < 4; ++m)
#pragma unroll
                    for (int n = 0; n < 2; ++n) acc[a][b][m][n] = (f32x4){0.f, 0.f, 0.f, 0.f};
        cur = nxt; cA = nA; cB = nB; ++ui;
        if constexpr (ALIGN_EPI) { if (wr == 1) PG8_BAR; }
    }
    PG8_WAIT_V(0);
    if constexpr (!ALIGN_EPI) { if (wr == 0) PG8_BAR; }
    PG8_BAR;
    if constexpr (Epi::AFTER_DRAIN) { E.fused(acc, cur, wr, wc, fr, fq, lds, wid, lane); S.done(cur); }
#undef PG8_SA
#undef PG8_SB
#undef PG8_STAGE
#undef PG8_LDA
#undef PG8_LDB
#undef PG8_MMA
#undef PG8_WAIT_V
#undef PG8_WAIT_L
#undef PG8_BAR
#undef PG8_SCHED
}
}

constexpr int NWAVES = 8, NT = NWAVES * 64;
constexpr int BATCH = 2, SEQ = 4096, DM = 2048, M = BATCH * SEQ;
constexpr int DFF = 5632, NGU = 2 * DFF;
constexpr int INC = 6432, INP = 6656;
constexpr int AW = 1024, RW = 1024, NH = 16, HD = 64;
constexpr int PLE = 256;
constexpr int UQ = 0, UK = 1024, UV = 2048, UR = 3072;
constexpr float LN_EPS = 1e-5f, GN_EPS = 64e-5f;
constexpr float ALPHA = 1.189207115002721f;
constexpr float LOG2E = 1.4426950408889634f;

constexpr size_t MiB = 1u << 20;
constexpr size_t WS_CTL = 0, CTL_ZERO_BYTES = 1 * MiB;
constexpr size_t WS_WGU = 2 * MiB;
constexpr size_t WS_WD = 46 * MiB;
constexpr size_t WS_WIN = 68 * MiB;
constexpr size_t WS_WOUT = 94 * MiB;
constexpr size_t WS_WPG = 102 * MiB;
constexpr size_t WS_WPU = 110 * MiB;
constexpr size_t WS_SMALL = 111 * MiB;
constexpr size_t WS_XB = 112 * MiB;
constexpr size_t WS_BIG = 144 * MiB;
constexpr size_t WS_MIX = 248 * MiB;
constexpr size_t WS_SCAN = 280 * MiB;
constexpr size_t WS_PB = 392 * MiB;
constexpr size_t WS_END = 396 * MiB;
constexpr size_t SM_W2T = 0, SM_A2T = 131072, SM_G2T = 262144, SM_KMEAN = 655360;
constexpr size_t WS_BONUS = 1 * MiB;
static_assert(SM_G2T + 1024 * 192 * 2 <= SM_KMEAN && SM_KMEAN + 2 * 16 * 16 * 64 * 2 <= MiB, "small map");
constexpr int CW_TMO = 0, CW_BAR = 4096;

constexpr int RING_BYTES = 131072;
constexpr int LDSCTL_OFF = RING_BYTES, MISC_OFF = LDSCTL_OFF + 320;
constexpr int LDS_BYTES = 147456;

#define GAS __attribute__((address_space(1)))
#define LAS __attribute__((address_space(3)))
typedef unsigned short bf16;
typedef unsigned v4u __attribute__((ext_vector_type(4)));
typedef unsigned v2u __attribute__((ext_vector_type(2)));
typedef float f32x4 __attribute__((ext_vector_type(4)));
typedef float f32x16 __attribute__((ext_vector_type(16)));
typedef short bf16x8 __attribute__((ext_vector_type(8)));
typedef short s16x4 __attribute__((ext_vector_type(4)));
typedef GAS unsigned gu32;
#define RLX_AGENT __ATOMIC_RELAXED, __HIP_MEMORY_SCOPE_AGENT
#define LDS_WAIT() asm volatile("s_waitcnt lgkmcnt(0)" ::: "memory")
#define VM_WAIT() asm volatile("s_waitcnt vmcnt(0)" ::: "memory")
__device__ __forceinline__ unsigned f2bf(float f) { unsigned u = __builtin_bit_cast(unsigned, f); return (u + 0x7fffu + ((u >> 16) & 1u)) >> 16; }
__device__ __forceinline__ unsigned pk2(float lo, float hi) { return f2bf(lo) | (f2bf(hi) << 16); }
__device__ __forceinline__ float bf2f(unsigned short b) { return __uint_as_float((unsigned)b << 16); }
__device__ __forceinline__ float bflo(unsigned w) { return __uint_as_float(w << 16); }
__device__ __forceinline__ float bfhi(unsigned w) { return __uint_as_float(w & 0xffff0000u); }

#define XB_TMO      128
#define XB_XCNT(j)  (256  + 64 * (j))
#define XB_XSUB(j)  (1280 + 64 * (j))
#define XB_XGEN(j)  (2304 + 64 * (j))
#define XB_TOP      3328
#define XB_TOPGEN   3392
#define XCD_BAR_WORDS 3456
#define XB_SPIN_CAP (1u << 18)
__device__ __forceinline__ unsigned xb_ld(unsigned* p)              { return __hip_atomic_load(p, __ATOMIC_RELAXED, __HIP_MEMORY_SCOPE_AGENT); }
__device__ __forceinline__ unsigned xb_add(unsigned* p, unsigned v) { return __hip_atomic_fetch_add(p, v, __ATOMIC_RELAXED, __HIP_MEMORY_SCOPE_AGENT); }
__device__ __forceinline__ unsigned xb_xcc_id() { return (unsigned)__builtin_amdgcn_s_getreg((3 << 11) | 20) & 0xFu; }
#define XB_SPIN(cond, bar) do { unsigned _sp = 0; while (cond) { __builtin_amdgcn_s_sleep(1); \
    if ((++_sp & 255u) == 0u) { if (xb_ld(&(bar)[XB_TMO])) break; if (_sp > XB_SPIN_CAP) { atomicAdd(&(bar)[XB_TMO], 1u); break; } } } } while (0)
struct XcdBarrier { unsigned* bar; unsigned x; volatile LAS unsigned* st; };
__device__ __forceinline__ XcdBarrier xcd_barrier_post(unsigned* bar, volatile LAS unsigned* st) {
    XcdBarrier b; b.bar = bar; b.x = xb_xcc_id(); b.st = st;
    if (threadIdx.x == 0) (void)xb_add(&bar[XB_XCNT(b.x)], 1u);
    return b;
}
__device__ __forceinline__ void xcd_barrier_complete(unsigned* bar, unsigned x, unsigned& nloc, unsigned& nx) {
    const unsigned G = gridDim.x * gridDim.y * gridDim.z;
    unsigned sum, cnt, mine, sp = 0u;
    for (;;) {
        sum = 0u; cnt = 0u; mine = 0u;
#pragma unroll
        for (unsigned j = 0; j < 16; ++j) { const unsigned c = xb_ld(&bar[XB_XCNT(j)]); sum += c; cnt += (c > 0u) ? 1u : 0u; mine = (j == x) ? c : mine; }
        if (sum == G) break;
        __builtin_amdgcn_s_sleep(1);
        if ((++sp & 255u) == 0u) { if (xb_ld(&bar[XB_TMO])) break; if (sp > XB_SPIN_CAP) { atomicAdd(&bar[XB_TMO], 1u); break; } }
    }
    nloc = mine > 0u ? mine : 1u; nx = cnt > 0u ? cnt : 1u;
}
__device__ __forceinline__ void xcd_barrier(const XcdBarrier& b) {
    asm volatile("s_waitcnt vmcnt(0)" ::: "memory");
    __syncthreads();
    if (threadIdx.x == 0) {
        unsigned* bar = b.bar;
        __builtin_amdgcn_s_waitcnt(0);
        unsigned nloc = b.st[0], nx = b.st[1];
        if (nloc == 0u) { xcd_barrier_complete(bar, b.x, nloc, nx); b.st[0] = nloc; b.st[1] = nx; }
        const unsigned old = xb_add(&bar[XB_XSUB(b.x)], 1u);
        const unsigned gen = old / nloc;
        if (old + 1u == (gen + 1u) * nloc) {
            __builtin_amdgcn_fence(__ATOMIC_RELEASE, "agent");
            asm volatile("s_waitcnt vmcnt(0)" ::: "memory");
            const unsigned og = xb_add(&bar[XB_TOP], 1u);
            const unsigned tg = og / nx;
            if (og + 1u == (tg + 1u) * nx) xb_add(&bar[XB_TOPGEN], 1u);
            else XB_SPIN(xb_ld(&bar[XB_TOPGEN]) == tg, bar);
            __builtin_amdgcn_fence(__ATOMIC_ACQUIRE, "agent");
            xb_add(&bar[XB_XGEN(b.x)], 1u);
            asm volatile("s_waitcnt vmcnt(0)" ::: "memory");
        } else {
            XB_SPIN(xb_ld(&bar[XB_XGEN(b.x)]) == gen, bar);
            __builtin_amdgcn_fence(__ATOMIC_ACQUIRE, "agent");
            asm volatile("s_waitcnt vmcnt(0)" ::: "memory");
        }
    }
    __syncthreads();
}

struct Args { const float* in[33]; float* out; unsigned char* ws; int ph_lo, ph_hi; };
struct Frame {
    LAS unsigned char* lds;
    int tid, lane, wave, G, bid;
    const float* const* in;
    float* hz;
    unsigned char* ws;
};
__device__ __forceinline__ float wave_sum(float v) {
#pragma unroll
    for (int o = 1; o < 64; o <<= 1) v += __shfl_xor(v, o);
    return v;
}

__device__ __forceinline__ void transpose_item(const float* W, int Kvalid, int N, bf16* WT, int ldo, int orow0, LAS float* scr, int k0, int n0, int lane) {
#pragma unroll 8
    for (int i = 0; i < 32; ++i) { const int kk = 2 * i + (lane >> 5); float v = 0.f; if (k0 + kk < Kvalid) v = W[(size_t)(k0 + kk) * N + n0 + (lane & 31)]; scr[kk * 33 + (lane & 31)] = v; }
    LDS_WAIT(); asm volatile("" ::: "memory");
    const int c = lane & 7;
#pragma unroll
    for (int j = 0; j < 4; ++j) { const int n = (lane >> 3) + 8 * j; const LAS float* s = scr + (8 * c) * 33 + n;
        v4u o; o.x = pk2(s[0 * 33], s[1 * 33]); o.y = pk2(s[2 * 33], s[3 * 33]); o.z = pk2(s[4 * 33], s[5 * 33]); o.w = pk2(s[6 * 33], s[7 * 33]);
        *(GAS v4u*)(WT + (size_t)(orow0 + n) * ldo + k0 + 8 * c) = o; }
    LDS_WAIT(); asm volatile("" ::: "memory");
}
__device__ __forceinline__ void transpose_job(Frame& F, const float* W, int Kvalid, int Kpad, int N, bf16* WT, int ldo, int mode, int& base) {
    LAS float* scr = (LAS float*)(F.lds + F.wave * 16384);
    const int gw = F.bid * NWAVES + F.wave, NGW = F.G * NWAVES;
    const int nblk = N / 32, items = (Kpad / 64) * nblk;
    int first = (gw - base % NGW + NGW) % NGW;
    for (int it = first; it < items; it += NGW) {
        const int kb = it / nblk, nb = it % nblk, n0 = 32 * nb;
        const int orow0 = (mode == 0) ? n0 : ((n0 >> 7) * 256 + (mode == 2 ? 128 : 0) + (n0 & 127));
        transpose_item(W, Kvalid, N, WT, ldo, orow0, scr, 64 * kb, n0, F.lane);
    }
    base += items;
}
__device__ __forceinline__ void convert_bf16(Frame& F, const float* src, bf16* dst, size_t n) {
    const size_t gt = (size_t)F.bid * NT + F.tid, NGT = (size_t)F.G * NT;
    for (size_t i = gt; i * 8 < n; i += NGT) { const f32x4 a = *(const GAS f32x4*)(src + i * 8), b = *(const GAS f32x4*)(src + i * 8 + 4);
        v4u o; o.x = pk2(a[0], a[1]); o.y = pk2(a[2], a[3]); o.z = pk2(b[0], b[1]); o.w = pk2(b[2], b[3]); *(GAS v4u*)(dst + i * 8) = o; }
}
__device__ __forceinline__ void ffn_weights(Frame& F, int gi, int ui, int di, int& base) {
    transpose_job(F, F.in[gi], DM, DM, DFF, (bf16*)(F.ws + WS_WGU), DM, 1, base);
    transpose_job(F, F.in[ui], DM, DM, DFF, (bf16*)(F.ws + WS_WGU), DM, 2, base);
    transpose_job(F, F.in[di], DFF, DFF, DM, (bf16*)(F.ws + WS_WD), DFF, 0, base);
}

template <bool WRITE_BF16>
__device__ __forceinline__ void ln_phase(Frame& F, float* hz, const float* g, const float* b, bf16* hb) {
    const int gw = F.bid * NWAVES + F.wave, NGW = F.G * NWAVES;
    f32x4 gv[8], bv[8];
#pragma unroll
    for (int j = 0; j < 8; ++j) { gv[j] = *(const GAS f32x4*)(g + F.lane * 4 + 256 * j); bv[j] = *(const GAS f32x4*)(b + F.lane * 4 + 256 * j); }
    for (int m = gw; m < M; m += NGW) {
        GAS f32x4* xr = (GAS f32x4*)(hz + (size_t)m * DM) + F.lane;
        f32x4 v[8]; float s = 0.f;
#pragma unroll
        for (int j = 0; j < 8; ++j) { v[j] = xr[64 * j]; s += (v[j][0] + v[j][1]) + (v[j][2] + v[j][3]); }
        const float mean = wave_sum(s) * (1.f / DM); float s2 = 0.f;
#pragma unroll
        for (int j = 0; j < 8; ++j) { v[j] = v[j] - mean; s2 += (v[j][0] * v[j][0] + v[j][1] * v[j][1]) + (v[j][2] * v[j][2] + v[j][3] * v[j][3]); }
        const float rstd = 1.f / sqrtf(wave_sum(s2) * (1.f / DM) + LN_EPS);
#pragma unroll
        for (int j = 0; j < 8; ++j) { v[j] = v[j] * rstd * gv[j] + bv[j]; xr[64 * j] = v[j]; }
        if (WRITE_BF16) { GAS v2u* o8 = (GAS v2u*)(hb + (size_t)m * DM) + F.lane;
#pragma unroll
            for (int j = 0; j < 8; ++j) { v2u w; w.x = pk2(v[j][0], v[j][1]); w.y = pk2(v[j][2], v[j][3]); o8[64 * j] = w; } }
    }
}

__device__ __forceinline__ int crow(int r, int hi) { return (r & 3) + 8 * (r >> 2) + 4 * hi; }
__device__ __forceinline__ float red32(float v) {
#pragma unroll
    for (int o = 1; o < 32; o <<= 1) v += __shfl_xor(v, o);
    return v;
}
__device__ __forceinline__ void kmean_tasks(Frame& F) {
    const bf16* ub = (const bf16*)(F.ws + WS_BIG); bf16* km = (bf16*)(F.ws + WS_SMALL + SM_KMEAN);
    const int gw = F.bid * NWAVES + F.wave, NGW = F.G * NWAVES;
    for (int task = gw; task < BATCH * 16 * NH; task += NGW) {
        const int b = task >> 8, blk = (task >> 4) & 15, h = task & 15;
        const bf16* p = ub + (size_t)(b * SEQ + blk * 256) * INP + UK + h * HD + F.lane;
        float s0 = 0.f, s1 = 0.f, s2 = 0.f, s3 = 0.f;
#pragma unroll 4
        for (int i = 0; i < 256; i += 4) { s0 += bf2f(p[(size_t)i * INP]); s1 += bf2f(p[(size_t)(i + 1) * INP]); s2 += bf2f(p[(size_t)(i + 2) * INP]); s3 += bf2f(p[(size_t)(i + 3) * INP]); }
        km[((b * NH + h) * 16 + blk) * HD + F.lane] = (bf16)f2bf(((s0 + s1) + (s2 + s3)) * (1.f / 256.f));
    }
}
__device__ __forceinline__ void shifted4(const bf16* ucol  , bool first_is_seq_start, float mix, float (&o)[4]) {
    float pv = first_is_seq_start ? 0.f : bf2f(*(ucol - INP));
#pragma unroll
    for (int i = 0; i < 4; ++i) { const float c = bf2f(ucol[(size_t)i * INP]); o[i] = c + (pv - c) * mix; pv = c; }
}
constexpr int PA_W = 0, PA_A = 4608, PA_G = 9216, PA_PITCH = 144, PG_PITCH = 400;
__device__ __forceinline__ void prep_tile(Frame& F, int tile) {
    const bf16* ub = (const bf16*)(F.ws + WS_BIG);
    const int m0 = tile * 32;
    const float* shift_mix = F.in[9];
    LAS unsigned char* L = F.lds;
    for (int idx = F.tid; idx < 32 * 288; idx += NT) {
        const int t = idx / 288, k = idx - t * 288, m = m0 + t;
        const bf16* up = ub + (size_t)m * INP + UR + 3072 + k;
        const float cur = bf2f(*up), prev = ((m & (SEQ - 1)) == 0) ? 0.f : bf2f(*(up - INP));
        const float us = cur + (prev - cur) * shift_mix[3072 + k];
        if (k < 64) { const float e2 = __expf(2.f * us); *(LAS bf16*)(L + PA_W + t * PA_PITCH + k * 2) = (bf16)f2bf(1.f - 2.f / (e2 + 1.f)); }
        else if (k < 128) *(LAS bf16*)(L + PA_A + t * PA_PITCH + (k - 64) * 2) = (bf16)f2bf(us);
        else *(LAS bf16*)(L + PA_G + t * PG_PITCH + (k - 128) * 2) = (bf16)f2bf(1.f / (1.f + __expf(-us)));
    }
    for (int idx = F.tid; idx < 32 * 32; idx += NT) *(LAS bf16*)(L + PA_G + (idx >> 5) * PG_PITCH + (160 + (idx & 31)) * 2) = 0;
    __syncthreads();
    const bf16* w2t = (const bf16*)(F.ws + WS_SMALL + SM_W2T); const bf16* a2t = (const bf16*)(F.ws + WS_SMALL + SM_A2T); const bf16* g2t = (const bf16*)(F.ws + WS_SMALL + SM_G2T);
    const float *w0 = F.in[10], *a0 = F.in[12], *k_k = F.in[15], *k_a = F.in[16], *r_k = F.in[17];
    bf16* SR = (bf16*)(F.ws + WS_SCAN); bf16* SE = SR + (size_t)M * RW; bf16* SKP = SE + (size_t)M * RW; bf16* SV = SKP + (size_t)M * RW;
    bf16* SKK = SV + (size_t)M * RW; bf16* SBB = SKK + (size_t)M * RW; bf16* SGG = SBB + (size_t)M * RW;
    float* bonus = (float*)(F.ws + WS_BONUS);
    const int r32 = F.lane & 31, hi = F.lane >> 5;
    const bool seq0 = (m0 & (SEQ - 1)) == 0;
    for (int hp = 0; hp < 2; ++hp) {
        const int head = 2 * F.wave + hp;
        float n2[16], bon[16];
#pragma unroll
        for (int r = 0; r < 16; ++r) { n2[r] = 0.f; bon[r] = 0.f; }
        for (int nt = 0; nt < 2; ++nt) {
            const int c = head * 64 + 32 * nt + r32;
            f32x16 accA = {};
#pragma unroll
            for (int ks = 0; ks < 4; ++ks) { const bf16x8 af = *(const LAS bf16x8*)(L + PA_A + r32 * PA_PITCH + (16 * ks + 8 * hi) * 2); const bf16x8 bfr = *(const GAS bf16x8*)(a2t + c * 64 + 16 * ks + 8 * hi);
                accA = __builtin_amdgcn_mfma_f32_32x32x16_bf16(af, bfr, accA, 0, 0, 0); }
            const float a0c = a0[c], kkc = k_k[c], kac = k_a[c], rkc = r_k[c], mixr = shift_mix[c], mixk = shift_mix[1024 + c];
#pragma unroll
            for (int g = 0; g < 4; ++g) { const int tb = 8 * g + 4 * hi; float rr[4], kr[4];
                shifted4(ub + (size_t)(m0 + tb) * INP + UR + c, seq0 && tb == 0, mixr, rr);
                shifted4(ub + (size_t)(m0 + tb) * INP + UR + 1024 + c, seq0 && tb == 0, mixk, kr);
#pragma unroll
                for (int i = 0; i < 4; ++i) { const int r = 4 * g + i; const float a = 1.f / (1.f + __expf(-(a0c + accA[r])));
                    const float kq = kr[i] * kkc; n2[r] += kq * kq; bon[r] += rr[i] * kr[i] * (1.f + (a - 1.f) * kac) * rkc; } }
        }
        float inv[16];
#pragma unroll
        for (int r = 0; r < 16; ++r) { const float s = red32(n2[r]); inv[r] = 1.f / fmaxf(sqrtf(s), 1e-12f); bon[r] = red32(bon[r]); }
        if (r32 == 0) {
#pragma unroll
            for (int r = 0; r < 16; ++r) bonus[(size_t)(m0 + crow(r, hi)) * NH + head] = bon[r]; }
        for (int nt = 0; nt < 2; ++nt) {
            const int c = head * 64 + 32 * nt + r32;
            f32x16 accA = {}, accW = {}, accG = {};
#pragma unroll
            for (int ks = 0; ks < 4; ++ks) { const bf16x8 af = *(const LAS bf16x8*)(L + PA_A + r32 * PA_PITCH + (16 * ks + 8 * hi) * 2); const bf16x8 bfr = *(const GAS bf16x8*)(a2t + c * 64 + 16 * ks + 8 * hi);
                accA = __builtin_amdgcn_mfma_f32_32x32x16_bf16(af, bfr, accA, 0, 0, 0);
                const bf16x8 wf = *(const LAS bf16x8*)(L + PA_W + r32 * PA_PITCH + (16 * ks + 8 * hi) * 2); const bf16x8 bw = *(const GAS bf16x8*)(w2t + c * 64 + 16 * ks + 8 * hi);
                accW = __builtin_amdgcn_mfma_f32_32x32x16_bf16(wf, bw, accW, 0, 0, 0); }
#pragma unroll
            for (int ks = 0; ks < 12; ++ks) { const bf16x8 gf = *(const LAS bf16x8*)(L + PA_G + r32 * PG_PITCH + (16 * ks + 8 * hi) * 2); const bf16x8 bg = *(const GAS bf16x8*)(g2t + c * 192 + 16 * ks + 8 * hi);
                accG = __builtin_amdgcn_mfma_f32_32x32x16_bf16(gf, bg, accG, 0, 0, 0); }
            const float a0c = a0[c], w0c = w0[c], kkc = k_k[c], kac = k_a[c], mixr = shift_mix[c], mixk = shift_mix[1024 + c], mixv = shift_mix[2048 + c];
#pragma unroll
            for (int g = 0; g < 4; ++g) { const int tb = 8 * g + 4 * hi; float rr[4], kr[4], vr[4];
                shifted4(ub + (size_t)(m0 + tb) * INP + UR + c, seq0 && tb == 0, mixr, rr);
                shifted4(ub + (size_t)(m0 + tb) * INP + UR + 1024 + c, seq0 && tb == 0, mixk, kr);
                shifted4(ub + (size_t)(m0 + tb) * INP + UR + 2048 + c, seq0 && tb == 0, mixv, vr);
#pragma unroll
                for (int i = 0; i < 4; ++i) { const int r = 4 * g + i; const size_t o = (size_t)(m0 + tb + i) * RW + c;
                    const float a = 1.f / (1.f + __expf(-(a0c + accA[r])));
                    const float x = -(w0c + accW[r]);
                    const float sp = fmaxf(x, 0.f) + __logf(1.f + __expf(-fabsf(x)));
                    const float e = __expf(-sp - 0.5f);
                    const float kk = kr[i] * kkc * inv[r], kp = kr[i] * (1.f + (a - 1.f) * kac);
                    SR[o] = (bf16)f2bf(rr[i]); SE[o] = (bf16)f2bf(e); SKP[o] = (bf16)f2bf(kp); SV[o] = (bf16)f2bf(vr[i]);
                    SKK[o] = (bf16)f2bf(kk); SBB[o] = (bf16)f2bf(kk * a); SGG[o] = (bf16)f2bf(accG[r]); } }
        }
    }
    __syncthreads();
}

__device__ __forceinline__ float dpp_add16(float x) {
    x += __builtin_bit_cast(float, __builtin_amdgcn_update_dpp(0, __builtin_bit_cast(int, x), 0xB1, 0xF, 0xF, true));
    x += __builtin_bit_cast(float, __builtin_amdgcn_update_dpp(0, __builtin_bit_cast(int, x), 0x4E, 0xF, 0xF, true));
    x += __builtin_bit_cast(float, __builtin_amdgcn_update_dpp(0, __builtin_bit_cast(int, x), 0x141, 0xF, 0xF, true));
    x += __builtin_bit_cast(float, __builtin_amdgcn_update_dpp(0, __builtin_bit_cast(int, x), 0x140, 0xF, 0xF, true));
    return x;
}
constexpr int SC_T = 32, SC_ARR = SC_T * 256, SC_V = 5 * SC_ARR, SC_BUF = SC_V + SC_T * 64;
__device__ __forceinline__ void scan_task(Frame& F, int task) {
    const int bh = task >> 2, quarter = task & 3, b = bh >> 4, h = bh & 15;
    const bf16* SR = (const bf16*)(F.ws + WS_SCAN);
    float* Y = (float*)(F.ws + WS_XB);
    LAS unsigned char* L = F.lds;
    const size_t mb = (size_t)b * SEQ;
    if (F.tid >= 256) {
        const int lt = F.tid - 256, pi = lt & 31, ts = lt >> 5;
        const int vt = lt >> 3, vp = lt & 7;
        unsigned reg[5][4], vreg;
        const GAS unsigned* gsrc[5];
#pragma unroll
        for (int a = 0; a < 5; ++a) { const int arr = (a < 3) ? a : a + 1;
            gsrc[a] = (const GAS unsigned*)(SR + (size_t)arr * M * RW + mb * RW + h * HD) + pi; }
        const GAS unsigned* vsrc = (const GAS unsigned*)(SR + (size_t)3 * M * RW + mb * RW + h * HD + 16 * quarter) + vp;
#define SC_LOAD(c) do { _Pragma("unroll") for (int a = 0; a < 5; ++a) _Pragma("unroll") for (int q = 0; q < 4; ++q) reg[a][q] = gsrc[a][(size_t)((c) * SC_T + ts + 8 * q) * (RW / 2)]; \
        vreg = vsrc[(size_t)((c) * SC_T + vt) * (RW / 2)]; } while (0)
#define SC_WRITE(bufo) do { _Pragma("unroll") for (int a = 0; a < 5; ++a) _Pragma("unroll") for (int q = 0; q < 4; ++q) { float lo = bflo(reg[a][q]), hi_ = bfhi(reg[a][q]); \
            if (a == 1) { lo = __expf(-lo); hi_ = __expf(-hi_); } \
            typedef float f32x2w __attribute__((ext_vector_type(2))); *(LAS f32x2w*)(L + (bufo) + a * SC_ARR + (ts + 8 * q) * 256 + pi * 8) = (f32x2w){lo, hi_}; } \
        { typedef float f32x2w __attribute__((ext_vector_type(2))); *(LAS f32x2w*)(L + (bufo) + SC_V + vt * 64 + vp * 8) = (f32x2w){bflo(vreg), bfhi(vreg)}; } } while (0)
        SC_LOAD(0); SC_WRITE(0); SC_LOAD(1);
        __syncthreads();
        for (int c = 0; c < SEQ / SC_T; ++c) {
            if (c + 1 < SEQ / SC_T) { SC_WRITE(((c + 1) & 1) * SC_BUF); if (c + 2 < SEQ / SC_T) SC_LOAD(c + 2); }
            __syncthreads();
        }
#undef SC_LOAD
#undef SC_WRITE
    } else {
        const int il = F.tid >> 4, jg = F.tid & 15;
        float S0 = 0.f, S1 = 0.f, S2 = 0.f, S3 = 0.f;
        float* yp = Y + mb * RW + h * HD + 16 * quarter + il;
        __syncthreads();
        for (int c = 0; c < SEQ / SC_T; ++c) {
            const LAS unsigned char* B = L + (c & 1) * SC_BUF;
#pragma unroll 4
            for (int tt = 0; tt < SC_T; ++tt) {
                const f32x4 r4 = *(const LAS f32x4*)(B + 0 * SC_ARR + tt * 256 + jg * 16);
                const f32x4 w4 = *(const LAS f32x4*)(B + 1 * SC_ARR + tt * 256 + jg * 16);
                const f32x4 k4 = *(const LAS f32x4*)(B + 2 * SC_ARR + tt * 256 + jg * 16);
                const f32x4 q4 = *(const LAS f32x4*)(B + 3 * SC_ARR + tt * 256 + jg * 16);
                const f32x4 b4 = *(const LAS f32x4*)(B + 4 * SC_ARR + tt * 256 + jg * 16);
                const float v = *(const LAS float*)(B + SC_V + tt * 64 + il * 4);
                float sp = (S0 * q4[0] + S1 * q4[1]) + (S2 * q4[2] + S3 * q4[3]);
                const float sa = -dpp_add16(sp);
                S0 = S0 * w4[0] + (sa * b4[0] + v * k4[0]);
                S1 = S1 * w4[1] + (sa * b4[1] + v * k4[1]);
                S2 = S2 * w4[2] + (sa * b4[2] + v * k4[2]);
                S3 = S3 * w4[3] + (sa * b4[3] + v * k4[3]);
                float y = (S0 * r4[0] + S1 * r4[1]) + (S2 * r4[2] + S3 * r4[3]);
                y = dpp_add16(y);
                if (jg == 0) yp[(size_t)(c * SC_T + tt) * RW] = y;
            }
            __syncthreads();
        }
    }
    __syncthreads();
}
__device__ __forceinline__ void rw_finalize(Frame& F) {
    const int gw = F.bid * NWAVES + F.wave, NGW = F.G * NWAVES;
    const float* Y = (const float*)(F.ws + WS_XB); const bf16* SV = (const bf16*)(F.ws + WS_SCAN) + (size_t)3 * M * RW; const bf16* SGG = (const bf16*)(F.ws + WS_SCAN) + (size_t)6 * M * RW;
    const float* bonus = (const float*)(F.ws + WS_BONUS); bf16* mix = (bf16*)(F.ws + WS_MIX);
    const float *gn_g = F.in[18], *gn_b = F.in[19];
    for (int m = gw; m < M; m += NGW) {
        for (int h = 0; h < NH; ++h) { const int c = h * HD + F.lane; const size_t o = (size_t)m * RW + c;
            const float y = Y[o]; const float mu = wave_sum(y) * (1.f / HD); const float d = y - mu; const float var = wave_sum(d * d) * (1.f / HD);
            const float yn = d * (1.f / sqrtf(var + GN_EPS)) * gn_g[c] + gn_b[c];
            const float val = (yn + bonus[(size_t)m * NH + h] * bf2f(SV[o])) * bf2f(SGG[o]);
            mix[(size_t)m * DM + AW + c] = (bf16)f2bf(val); }
    }
}

constexpr int AT_K = 0, AT_V = 16384, AT_WS = 32768, AT_GATE = 34816, AT_TAB = 51200, AT_OST = 52224, AT_BYTES = AT_OST + 8 * 4096;
__device__ __forceinline__ int rel_bucket_i(int d) {
    if (d < 16) return d;
    return 16 + (d >= 19) + (d >= 21) + (d >= 24) + (d >= 27) + (d >= 31) + (d >= 35) + (d >= 40) + (d >= 46) + (d >= 52) + (d >= 59) + (d >= 67) + (d >= 77) + (d >= 87) + (d >= 99) + (d >= 113);
}
__device__ __forceinline__ s16x4 vtr(const LAS unsigned char* p) { typedef short v4i16_t __attribute__((ext_vector_type(4))); return __builtin_bit_cast(s16x4, __builtin_amdgcn_ds_read_tr16_b64_v4i16((LAS v4i16_t*)p)); }
__device__ __forceinline__ unsigned cvtpk(float lo, float hi) { typedef float f2 __attribute__((ext_vector_type(2))); typedef __bf16 b2 __attribute__((ext_vector_type(2))); f2 v = {lo, hi}; b2 b = __builtin_convertvector(v, b2); return __builtin_bit_cast(unsigned, b); }
__device__ __forceinline__ float swapmax(float m) { auto rr = __builtin_amdgcn_permlane32_swap(__float_as_uint(m), __float_as_uint(m), false, false); return fmaxf(__uint_as_float(rr[0]), __uint_as_float(rr[1])); }
__device__ __forceinline__ float swapsum(float m) { auto rr = __builtin_amdgcn_permlane32_swap(__float_as_uint(m), __float_as_uint(m), false, false); return __uint_as_float(rr[0]) + __uint_as_float(rr[1]); }

__device__ __forceinline__ void attn_unit(Frame& F, int b, int h, int qb) {
    const bf16* ub = (const bf16*)(F.ws + WS_BIG); const bf16* km = (const bf16*)(F.ws + WS_SMALL + SM_KMEAN); bf16* mix = (bf16*)(F.ws + WS_MIX);
    const float* rel_bias = F.in[8];
    LAS unsigned char* L = F.lds;
    const int lane = F.lane, wid = F.wave, r32 = lane & 31, hi = lane >> 5;
    const size_t mb = (size_t)b * SEQ;
    const int q0 = qb * 256;
    LAS float* tab = (LAS float*)(L + AT_TAB);
    LAS float* wsf = (LAS float*)(L + AT_WS) + wid * 64;
    constexpr float C2 = 0.125f * LOG2E;
    if (F.tid < 129) tab[F.tid] = rel_bias[rel_bucket_i(F.tid) * NH + h] * LOG2E;
    bf16x8 qr[4];
    { const bf16* Qw = ub + (mb + q0 + wid * 32 + r32) * INP + UQ + h * HD;
#pragma unroll
      for (int d0 = 0; d0 < 4; ++d0) qr[d0] = *(const GAS bf16x8*)(Qw + d0 * 16 + hi * 8); }
    unsigned sel = 0u;
    if (qb > 0) {
        f32x16 g = {};
        const bf16* kmp = km + ((size_t)(b * NH + h) * 16 + (r32 & 15)) * HD;
#pragma unroll
        for (int d0 = 0; d0 < 4; ++d0) { const bf16x8 kf = *(const GAS bf16x8*)(kmp + d0 * 16 + hi * 8); g = __builtin_amdgcn_mfma_f32_32x32x16_bf16(kf, qr[d0], g, 0, 0, 0); }
        LAS float* gs = (LAS float*)(L + AT_GATE) + wid * 512;
#pragma unroll
        for (int r = 0; r < 8; ++r) gs[r32 * 16 + crow(r, hi)] = g[r];
        LDS_WAIT(); asm volatile("" ::: "memory");
        float gv[16];
#pragma unroll
        for (int i = 0; i < 4; ++i) { const f32x4 t = *(const LAS f32x4*)(gs + r32 * 16 + 4 * i); gv[4 * i] = t[0]; gv[4 * i + 1] = t[1]; gv[4 * i + 2] = t[2]; gv[4 * i + 3] = t[3]; }
#pragma unroll
        for (int pass = 0; pass < 3; ++pass) { float best = -INFINITY; int bi = -1;
#pragma unroll
            for (int n = 0; n < 16; ++n) { const bool ok = (n < qb) && !((sel >> n) & 1u) && (gv[n] > best); if (ok) { best = gv[n]; bi = n; } }
            if (bi >= 0) sel |= 1u << bi; }
    }
    const bf16* ksrc = ub + (mb + lane) * INP + UK + h * HD + wid * 8;
    const bf16* vsrc = ub + (mb + 16 * (wid & 3) + (lane >> 2)) * INP + UV + h * HD + (wid >> 2) * 32 + (lane & 3) * 8;
    const int stoff = wid * 1024 + lane * 16;
    const int NTILE = 4 * (qb + 1);
    v4u kreg, vreg;
    kreg = *(const GAS v4u*)(ksrc); vreg = *(const GAS v4u*)(vsrc);
    __syncthreads();
    *(LAS v4u*)(L + AT_K + stoff) = kreg; *(LAS v4u*)(L + AT_V + stoff) = vreg;
    __syncthreads();
    float mrun = -INFINITY, lrun = 0.f; f32x16 o[2]; o[0] = f32x16{}; o[1] = f32x16{};
    const float c31 = tab[128];
    for (int jt = 0; jt < NTILE; ++jt) {
        const int cur = jt & 1;
        if (jt + 1 < NTILE) { kreg = *(const GAS v4u*)(ksrc + (size_t)(jt + 1) * 64 * INP); vreg = *(const GAS v4u*)(vsrc + (size_t)(jt + 1) * 64 * INP); }
        const int n = jt >> 2;
        const int dbase = 256 * (qb - n) + 32 * wid - 64 * (jt & 3);
        const bool lane_ok = (n == qb) || ((sel >> n) & 1u);
        const bool wave_live = (dbase + 31 >= 0) && __any(lane_ok);
        if (wave_live) {
            f32x16 p0 = {}, p1 = {};
            const LAS unsigned char* kb = L + AT_K + cur * 8192 + hi * 1024 + r32 * 16;
#pragma unroll
            for (int d0 = 0; d0 < 4; ++d0) { const bf16x8 b0 = *(const LAS bf16x8*)(kb + d0 * 2048); const bf16x8 b1 = *(const LAS bf16x8*)(kb + d0 * 2048 + 512);
                p0 = __builtin_amdgcn_mfma_f32_32x32x16_bf16(b0, qr[d0], p0, 0, 0, 0); p1 = __builtin_amdgcn_mfma_f32_32x32x16_bf16(b1, qr[d0], p1, 0, 0, 0); }
            const bool far = (dbase - 63 >= 128);
            const int dl = dbase + r32;
            if (far) {
#pragma unroll
                for (int r = 0; r < 16; ++r) { p0[r] = lane_ok ? p0[r] * C2 + c31 : -INFINITY; p1[r] = lane_ok ? p1[r] * C2 + c31 : -INFINITY; }
            } else {
#pragma unroll
                for (int r = 0; r < 16; ++r) { const int d0_ = dl - crow(r, hi), d1_ = d0_ - 32;
                    const float b0 = tab[min(max(d0_, 0), 128)], b1 = tab[min(max(d1_, 0), 128)];
                    p0[r] = (lane_ok && d0_ >= 0) ? p0[r] * C2 + b0 : -INFINITY; p1[r] = (lane_ok && d1_ >= 0) ? p1[r] * C2 + b1 : -INFINITY; }
            }
            float rm = fmaxf(p0[0], p1[0]);
#pragma unroll
            for (int r = 1; r < 16; ++r) rm = fmaxf(rm, fmaxf(p0[r], p1[r]));
            rm = swapmax(rm);
            const float mnew = fmaxf(mrun, rm);
            const float msafe = (mnew == -INFINITY) ? 0.f : mnew;
            const float alpha = __builtin_amdgcn_exp2f(mrun - msafe);
            mrun = mnew;
            float ps = 0.f;
#pragma unroll
            for (int r = 0; r < 16; ++r) { p0[r] = __builtin_amdgcn_exp2f(p0[r] - msafe); p1[r] = __builtin_amdgcn_exp2f(p1[r] - msafe); ps += p0[r] + p1[r]; }
            lrun = lrun * alpha + ps;
            if (__any(alpha != 1.f)) {
                if (hi == 0) wsf[r32] = alpha;
                LDS_WAIT(); asm volatile("" ::: "memory");
#pragma unroll
                for (int r = 0; r < 16; ++r) { const float f = wsf[crow(r, hi)]; o[0][r] *= f; o[1][r] *= f; }
                asm volatile("" ::: "memory");
            }
            v4u pw[4];
            pw[0] = (v4u){cvtpk(p0[0], p0[1]), cvtpk(p0[2], p0[3]), cvtpk(p0[4], p0[5]), cvtpk(p0[6], p0[7])};
            pw[1] = (v4u){cvtpk(p0[8], p0[9]), cvtpk(p0[10], p0[11]), cvtpk(p0[12], p0[13]), cvtpk(p0[14], p0[15])};
            pw[2] = (v4u){cvtpk(p1[0], p1[1]), cvtpk(p1[2], p1[3]), cvtpk(p1[4], p1[5]), cvtpk(p1[6], p1[7])};
            pw[3] = (v4u){cvtpk(p1[8], p1[9]), cvtpk(p1[10], p1[11]), cvtpk(p1[12], p1[13]), cvtpk(p1[14], p1[15])};
            const LAS unsigned char* vb = L + AT_V + cur * 8192 + ((lane >> 4) & 1) * 32 + (lane & 3) * 8 + (4 * hi + ((lane & 15) >> 2)) * 64;
#pragma unroll
            for (int d0 = 0; d0 < 2; ++d0)
#pragma unroll
                for (int ks = 0; ks < 4; ++ks) { const s16x4 lo = vtr(vb + d0 * 4096 + ks * 1024), hh = vtr(vb + d0 * 4096 + ks * 1024 + 512);
                    const bf16x8 vf = (bf16x8){lo[0], lo[1], lo[2], lo[3], hh[0], hh[1], hh[2], hh[3]};
                    o[d0] = __builtin_amdgcn_mfma_f32_32x32x16_bf16(__builtin_bit_cast(bf16x8, pw[ks]), vf, o[d0], 0, 0, 0); }
        }
        if (jt + 1 < NTILE) { *(LAS v4u*)(L + AT_K + (cur ^ 1) * 8192 + stoff) = kreg; *(LAS v4u*)(L + AT_V + (cur ^ 1) * 8192 + stoff) = vreg; }
        __syncthreads();
    }
    lrun = swapsum(lrun);
    if (hi == 0) wsf[32 + r32] = lrun;
    LDS_WAIT(); asm volatile("" ::: "memory");
    LAS bf16* stg = (LAS bf16*)(L + AT_OST) + wid * 2048;
#pragma unroll
    for (int r = 0; r < 16; ++r) { const int orow = crow(r, hi); const float rl = 1.f / wsf[32 + orow];
        stg[orow * 64 + r32] = (bf16)f2bf(o[0][r] * rl); stg[orow * 64 + 32 + r32] = (bf16)f2bf(o[1][r] * rl); }
    LDS_WAIT(); asm volatile("" ::: "memory");
    bf16* Ow = mix + (mb + q0 + wid * 32) * DM + h * HD;
#pragma unroll
    for (int i = 0; i < 4; ++i) { const int row = i * 8 + (lane >> 3), ch = lane & 7; const v4u v = *(const LAS v4u*)(stg + row * 64 + ch * 8); *(GAS v4u*)(Ow + (size_t)row * DM + ch * 8) = v; }
}

#ifndef MK_PER_PHASE
#define MK_PER_PHASE 0
#endif
constexpr int NPHASE = 15;
__global__ void __launch_bounds__(NT, 2) hymba_fwd(Args args) {
    extern __shared__ __attribute__((aligned(16))) unsigned char lds[];
    Frame F;
    F.lds = (LAS unsigned char*)lds;
    F.tid = threadIdx.x; F.lane = F.tid & 63; F.wave = __builtin_amdgcn_readfirstlane(F.tid >> 6);
    F.G = gridDim.x; F.bid = blockIdx.x; F.in = args.in; F.hz = args.out; F.ws = args.ws;
    volatile LAS unsigned* MISC = (volatile LAS unsigned*)(F.lds + MISC_OFF);
    for (int u = F.tid; u < (LDS_BYTES - LDSCTL_OFF) / 4; u += NT) ((LAS unsigned*)(F.lds + LDSCTL_OFF))[u] = 0u;
    __syncthreads();
    gu32* ctl = (gu32*)(F.ws + WS_CTL);
    XcdBarrier bar; bar.bar = (unsigned*)(ctl + CW_BAR); bar.x = 0; bar.st = nullptr;
    if (!MK_PER_PHASE) bar = xcd_barrier_post((unsigned*)(ctl + CW_BAR), MISC + 8);
    const int lo = args.ph_lo, hi = args.ph_hi;
#define IN(k) (lo <= (k) && (k) < hi)
#define SEAM(k) do { if (IN(k) && IN((k) + 1)) xcd_barrier(bar); } while (0)
    bf16* const Wgu = (bf16*)(F.ws + WS_WGU); bf16* const Wd = (bf16*)(F.ws + WS_WD); bf16* const Win = (bf16*)(F.ws + WS_WIN); bf16* const Wout = (bf16*)(F.ws + WS_WOUT);
    bf16* const Wpg = (bf16*)(F.ws + WS_WPG); bf16* const Wpu = (bf16*)(F.ws + WS_WPU);
    bf16* const XB = (bf16*)(F.ws + WS_XB); bf16* const BIG = (bf16*)(F.ws + WS_BIG); bf16* const MIX = (bf16*)(F.ws + WS_MIX); bf16* const EB = (bf16*)(F.ws + WS_SCAN); bf16* const PB = (bf16*)(F.ws + WS_PB);

    if (IN(0)) {
        int base = 0;
        ffn_weights(F, 2, 3, 4, base);
        transpose_job(F, F.in[7], DM, DM, INC, Win, DM, 0, base);
        transpose_job(F, F.in[20], DM, DM, DM, Wout, DM, 0, base);
        transpose_job(F, F.in[29], DM, DM, DM, Wpg, DM, 0, base);
        transpose_job(F, F.in[28], PLE, PLE, DM, Wpu, PLE, 0, base);
        transpose_job(F, F.in[11], 64, 64, RW, (bf16*)(F.ws + WS_SMALL + SM_W2T), 64, 0, base);
        transpose_job(F, F.in[13], 64, 64, RW, (bf16*)(F.ws + WS_SMALL + SM_A2T), 64, 0, base);
        transpose_job(F, F.in[14], 160, 192, RW, (bf16*)(F.ws + WS_SMALL + SM_G2T), 192, 0, base);
        convert_bf16(F, F.in[0], XB, (size_t)M * DM);
        convert_bf16(F, F.in[1], PB, (size_t)M * PLE);
    }
    SEAM(0);
    if (IN(1)) { pg8::Gemm g{XB, Wgu, M, NGU, DM}; pg8::StaticOrder S; S.init(M, NGU, F.G, F.bid); pg8::EpiSwiGLU E{BIG, DFF};
        pg8::gemm_phase<pg8::EpiSwiGLU, pg8::StaticOrder, true, true>(F.lds, g, S, E); }
    SEAM(1);
    if (IN(2)) { pg8::Gemm g{BIG, Wd, M, DM, DFF}; pg8::StaticOrder S; S.init(M, DM, F.G, F.bid); pg8::EpiResid E{F.in[0], F.hz, DM, ALPHA, 0.5f};
        pg8::gemm_phase<pg8::EpiResid, pg8::StaticOrder, true, true>(F.lds, g, S, E); }
    SEAM(2);
    if (IN(3)) { ln_phase<true>(F, F.hz, F.in[5], F.in[6], XB); int base = 0; ffn_weights(F, 23, 24, 25, base); }
    SEAM(3);
    if (IN(4)) { pg8::Gemm g{XB, Win, M, INP, DM}; pg8::StaticOrder S; S.init(M, INP, F.G, F.bid); pg8::EpiBf16<0> E{BIG, INP, nullptr, 0, 0, 1.f};
        pg8::gemm_phase<pg8::EpiBf16<0>, pg8::StaticOrder, true, true>(F.lds, g, S, E); }
    SEAM(4);
    if (IN(5)) { kmean_tasks(F); for (int t = F.bid; t < M / 32; t += F.G) prep_tile(F, t); }
    SEAM(5);
    if (IN(6)) {
        if (F.G >= 256) {
            if (F.bid < 128) scan_task(F, F.bid);
            else if (F.bid < 256) { const int a = F.bid - 128;
                for (int i = 0; i < 2; ++i) { const int p = (a & 7) * 32 + (a >> 3) * 2 + i, bh = p >> 3, s = p & 7;
                    attn_unit(F, bh >> 4, bh & 15, s); attn_unit(F, bh >> 4, bh & 15, 15 - s); } }
        } else {
            for (int t = F.bid; t < 128 + 256; t += F.G) {
                if (t < 128) scan_task(F, t);
                else { const int p = t - 128, bh = p >> 3, s = p & 7; attn_unit(F, bh >> 4, bh & 15, s); attn_unit(F, bh >> 4, bh & 15, 15 - s); } }
        }
    }
    SEAM(6);
    if (IN(7)) rw_finalize(F);
    SEAM(7);
    if (IN(8)) { { pg8::Gemm g{MIX, Wout, M, DM, DM}; pg8::StaticOrder S; S.init(M, DM, F.G, F.bid); pg8::EpiResid E{F.hz, F.hz, DM, ALPHA, 1.0f};
          pg8::gemm_phase<pg8::EpiResid, pg8::StaticOrder, true, true>(F.lds, g, S, E); }
        { pg8::Gemm g{PB, Wpu, M, DM, PLE}; pg8::StaticOrder S; S.init(M, DM, F.G, F.bid); pg8::EpiBf16<0> E{EB, DM, nullptr, 0, 0, 1.f};
          pg8::gemm_phase<pg8::EpiBf16<0>, pg8::StaticOrder, true, true>(F.lds, g, S, E); } }
    SEAM(8);
    if (IN(9)) ln_phase<true>(F, F.hz, F.in[21], F.in[22], XB);
    SEAM(9);
    if (IN(10)) { pg8::Gemm g{XB, Wgu, M, NGU, DM}; pg8::StaticOrder S; S.init(M, NGU, F.G, F.bid); pg8::EpiSwiGLU E{BIG, DFF};
        pg8::gemm_phase<pg8::EpiSwiGLU, pg8::StaticOrder, true, true>(F.lds, g, S, E); }
    SEAM(10);
    if (IN(11)) { pg8::Gemm g{BIG, Wd, M, DM, DFF}; pg8::StaticOrder S; S.init(M, DM, F.G, F.bid); pg8::EpiResid E{F.hz, F.hz, DM, ALPHA, 0.5f};
        pg8::gemm_phase<pg8::EpiResid, pg8::StaticOrder, true, true>(F.lds, g, S, E); }
    SEAM(11);
    if (IN(12)) ln_phase<true>(F, F.hz, F.in[26], F.in[27], XB);
    SEAM(12);
    if (IN(13)) { pg8::Gemm g{XB, Wpg, M, DM, DM}; pg8::StaticOrder S; S.init(M, DM, F.G, F.bid); pg8::EpiPle E{F.hz, F.hz, EB, F.in[30], DM, ALPHA};
        pg8::gemm_phase<pg8::EpiPle, pg8::StaticOrder, true, true>(F.lds, g, S, E); }
    SEAM(13);
    if (IN(14)) {
        if (!MK_PER_PHASE && xb_ld((unsigned*)(ctl + CW_BAR) + XB_TMO) != 0u) {
            const float q = __builtin_nanf(""); for (size_t i = (size_t)F.bid * NT + F.tid; i < (size_t)M * DM; i += (size_t)F.G * NT) F.hz[i] = q;
        } else ln_phase<false>(F, F.hz, F.in[31], F.in[32], nullptr);
    }
#undef IN
#undef SEAM
}

extern "C" void kernel_launch(void* const* d_in, const int* in_sizes, int n_in, void* d_out, int out_size, void* d_ws, size_t ws_size, hipStream_t stream) {
    static int grid = 0;
    if (grid == 0) {
        if (n_in != 33 || out_size != M * DM || ws_size < WS_END) { fprintf(stderr, "kernel_launch: unexpected problem (n_in %d out %d ws %zu, need %zu); nothing launched\n", n_in, out_size, ws_size, (size_t)WS_END); grid = -1; return; }
        int dev = 0, cus = 0;
        if (hipGetDevice(&dev) != hipSuccess || hipDeviceGetAttribute(&cus, hipDeviceAttributeMultiprocessorCount, dev) != hipSuccess) { grid = -1; return; }
        if (hipFuncSetAttribute((const void*)hymba_fwd, hipFuncAttributeMaxDynamicSharedMemorySize, LDS_BYTES) != hipSuccess) { fprintf(stderr, "kernel_launch: hipFuncSetAttribute failed\n"); grid = -1; return; }
        grid = cus > 0 ? cus : 256;
        fprintf(stderr, "kernel_launch: grid %d, ws %zu\n", grid, ws_size);
    }
    if (grid < 0) return;
    (void)hipMemsetAsync((char*)d_ws + WS_CTL, 0, CTL_ZERO_BYTES, stream);
    Args a{};
    for (int i = 0; i < 33; ++i) a.in[i] = (const float*)d_in[i];
    a.out = (float*)d_out; a.ws = (unsigned char*)d_ws;
#if MK_PER_PHASE
    for (int p = 0; p < NPHASE; ++p) { a.ph_lo = p; a.ph_hi = p + 1; hipLaunchKernelGGL(hymba_fwd, dim3(grid), dim3(NT), LDS_BYTES, stream, a); }
#else
    a.ph_lo = 0; a.ph_hi = NPHASE;
    hipLaunchKernelGGL(hymba_fwd, dim3(grid), dim3(NT), LDS_BYTES, stream, a);
#endif
}
```

```cpp
#include <hip/hip_runtime.h>
#include <cstdio>
#include <cstdint>
namespace pg8 {
#define PG8_LAS __attribute__((address_space(3)))
typedef unsigned short bf16_t;
typedef short bf16x8 __attribute__((ext_vector_type(8)));
typedef float f32x4 __attribute__((ext_vector_type(4)));
typedef unsigned u32x4 __attribute__((ext_vector_type(4)));
constexpr int BM = 256, BK = 64, HALF = 128, HTB = HALF * BK * 2  , STAGE_BYTES = 8 * HTB, NXCD = 8, WGM = 8;

__host__ __device__ __forceinline__ int lds_byte(int r, int c) { const int st = (r >> 4) * 2 + (c >> 5), rr = r & 15, cc = c & 31, ob = rr * 64 + cc * 2; return st * 1024 + (ob ^ (((ob >> 9) & 1) << 5)); }
__host__ __device__ __forceinline__ void stage_rc(int b, int& R, int& C) { const int st = b / 1024, sb = b % 1024, swz = sb ^ (((sb >> 9) & 1) << 5); R = (st >> 1) * 16 + swz / 64; C = (st & 1) * 32 + (swz % 64) / 2; }
__host__ __device__ __forceinline__ int perm32(int rho) { const int n = rho >> 4, i = rho & 15; return 8 * (i >> 2) + 4 * n + (i & 3); }

struct Unit { int pm, pn; };
struct Gemm { const bf16_t* A; const bf16_t* Bt; int M, N, K; };

struct StaticOrder {
    int nM, nN, nwg, G, c;
    __host__ __device__ void init(int M, int N, int G_, int c_) { nM = M / BM; nN = N / BM; nwg = nM * nN; G = G_; c = c_; }
    __host__ __device__ bool next(int i, Unit& u) const {
        const long L = (long)i * G + c; if (L >= nwg) return false;
        int wgid = (int)L; { const int q = nwg / NXCD, r = nwg % NXCD, xcd = wgid % NXCD, off = wgid / NXCD; wgid = (xcd < r ? xcd * (q + 1) : r * (q + 1) + (xcd - r) * q) + off; }
        const int nig = WGM * nN, gid = wgid / nig, fm = gid * WGM, gsz = (nM - fm) < WGM ? (nM - fm) : WGM;
        u.pm = fm + ((wgid % nig) % gsz); u.pn = (wgid % nig) / gsz; return true;
    }
    __device__ __forceinline__ void a_ready(const Unit&) const {}
    __device__ __forceinline__ void done(const Unit&) const {}
};

__device__ __forceinline__ unsigned cvt_pk_bf16(float lo, float hi) { unsigned r; asm volatile("v_cvt_pk_bf16_f32 %0, %1, %2" : "=v"(r) : "v"(lo), "v"(hi)); return r; }
typedef float f32x2 __attribute__((ext_vector_type(2)));
__device__ __forceinline__ f32x2 gelu_pk(f32x2 v) {
    const f32x2 av = __builtin_elementwise_abs(v), d = av * 0.2316418882f + 1.0f;
    f32x2 t; t.x = __builtin_amdgcn_rcpf(d.x); t.y = __builtin_amdgcn_rcpf(d.y);
    f32x2 q = t * 0.5307027145f + (-0.7265760135f); q = q * t + 0.7107068705f; q = q * t + (-0.142248368f); q = q * t + 0.127414796f; q = q * t;
    const f32x2 s = (v * v) * (-0.72134752044f);
    f32x2 e; e.x = __builtin_amdgcn_exp2f(s.x); e.y = __builtin_amdgcn_exp2f(s.y);
    const f32x2 m = v * (q * e), r = v - m;
    f32x2 o; o.x = v.x < 0.f ? m.x : r.x; o.y = v.y < 0.f ? m.y : r.y; return o;
}

template <int ACT  > struct EpiBf16 {
    static constexpr bool PERM = true, AFTER_DRAIN = false; static_assert(ACT == 0 || ACT == 1, "EpiBf16: ACT is 0 (none) or 1 (gelu_pk)");
    bf16_t* O; int ldc; const float* bias; int split_cols; size_t split_stride; float scale0;
    __device__ __forceinline__ void operator()(const f32x4 (&acc)[2][2][4][2], const Unit& u, int wr, int wc, int fr, int fq) const {
        const int row0 = u.pm * BM + wr * 64 + fr; int colt = u.pn * BM; bf16_t* base = O;
        float sc = 1.f; if (split_cols) { const int t = colt / split_cols; base += (size_t)t * split_stride; colt -= t * split_cols; if (t == 0) sc = scale0; }
        const int col0 = colt + wc * 32 + 8 * fq, bcol0 = u.pn * BM + wc * 32 + 8 * fq;
        f32x4 bv[2][2];
#pragma unroll
        for (int bj = 0; bj < 2; ++bj)
#pragma unroll
            for (int n = 0; n < 2; ++n) bv[bj][n] = bias ? *(const f32x4*)(bias + bcol0 + bj * HALF + 4 * n) : (f32x4){0.f, 0.f, 0.f, 0.f};
#pragma unroll
        for (int ai = 0; ai < 2; ++ai)
#pragma unroll
            for (int m = 0; m < 4; ++m) { bf16_t* rowp = base + (size_t)(row0 + ai * HALF + m * 16) * ldc + col0;
#pragma unroll
                for (int bj = 0; bj < 2; ++bj) { f32x4 v0 = acc[ai][bj][m][0] + bv[bj][0], v1 = acc[ai][bj][m][1] + bv[bj][1];
                    if (ACT == 1) { f32x2 a = gelu_pk((f32x2){v0[0], v0[1]}), b = gelu_pk((f32x2){v0[2], v0[3]}), c = gelu_pk((f32x2){v1[0], v1[1]}), d = gelu_pk((f32x2){v1[2], v1[3]});
                        v0 = (f32x4){a.x, a.y, b.x, b.y}; v1 = (f32x4){c.x, c.y, d.x, d.y}; }
                    v0 = v0 * sc; v1 = v1 * sc; u32x4 w; w.x = cvt_pk_bf16(v0[0], v0[1]); w.y = cvt_pk_bf16(v0[2], v0[3]); w.z = cvt_pk_bf16(v1[0], v1[1]); w.w = cvt_pk_bf16(v1[2], v1[3]);
                    *(u32x4*)(rowp + bj * HALF) = w; } }
    }
};
__device__ __forceinline__ float sigmoid_f(float x) { return __builtin_amdgcn_rcpf(1.0f + __builtin_amdgcn_exp2f(-1.4426950408889634f * x)); }
struct EpiSwiGLU {
    static constexpr bool PERM = true, AFTER_DRAIN = false;
    bf16_t* O; int ldc;
    __device__ __forceinline__ void operator()(const f32x4 (&acc)[2][2][4][2], const Unit& u, int wr, int wc, int fr, int fq) const {
        const int row0 = u.pm * BM + wr * 64 + fr; const int col0 = u.pn * HALF + wc * 32 + 8 * fq;
#pragma unroll
        for (int ai = 0; ai < 2; ++ai)
#pragma unroll
            for (int m = 0; m < 4; ++m) { bf16_t* rowp = O + (size_t)(row0 + ai * HALF + m * 16) * ldc + col0;
                const f32x4 g0 = acc[ai][0][m][0], g1 = acc[ai][0][m][1], u0 = acc[ai][1][m][0], u1 = acc[ai][1][m][1];
                f32x4 h0, h1;
#pragma unroll
                for (int i = 0; i < 4; ++i) { h0[i] = g0[i] * sigmoid_f(g0[i]) * u0[i]; h1[i] = g1[i] * sigmoid_f(g1[i]) * u1[i]; }
                u32x4 w; w.x = cvt_pk_bf16(h0[0], h0[1]); w.y = cvt_pk_bf16(h0[2], h0[3]); w.z = cvt_pk_bf16(h1[0], h1[1]); w.w = cvt_pk_bf16(h1[2], h1[3]);
                *(u32x4*)rowp = w; }
    }
};
struct EpiResid {
    static constexpr bool PERM = false, AFTER_DRAIN = false;
    const float* base; float* out; int ldc; float alpha, s;
    __device__ __forceinline__ void operator()(const f32x4 (&acc)[2][2][4][2], const Unit& u, int wr, int wc, int fr, int fq) const {
        const int col0 = u.pn * BM + wc * 32 + 4 * fq;
#pragma unroll
        for (int ai = 0; ai < 2; ++ai)
#pragma unroll
            for (int m = 0; m < 4; ++m) { const size_t off = (size_t)(u.pm * BM + ai * HALF + wr * 64 + m * 16 + fr) * ldc + col0;
#pragma unroll
                for (int bj = 0; bj < 2; ++bj)
#pragma unroll
                    for (int n = 0; n < 2; ++n) { const f32x4 bs = *(const f32x4*)(base + off + bj * HALF + n * 16);
                        *(f32x4*)(out + off + bj * HALF + n * 16) = bs * alpha + acc[ai][bj][m][n] * s; }
                if (m & 1) asm volatile("" ::: "memory"); }
    }
};
struct EpiPle {
    static constexpr bool PERM = false, AFTER_DRAIN = false;
    const float* base; float* out; const bf16_t* e; const float* bias; int ldc; float alpha;
    __device__ __forceinline__ void operator()(const f32x4 (&acc)[2][2][4][2], const Unit& u, int wr, int wc, int fr, int fq) const {
        typedef unsigned u32x2v __attribute__((ext_vector_type(2)));
        const int col0 = u.pn * BM + wc * 32 + 4 * fq;
        f32x4 bv[2][2];
#pragma unroll
        for (int bj = 0; bj < 2; ++bj)
#pragma unroll
            for (int n = 0; n < 2; ++n) bv[bj][n] = *(const f32x4*)(bias + col0 + bj * HALF + n * 16);
#pragma unroll
        for (int ai = 0; ai < 2; ++ai)
#pragma unroll
            for (int m = 0; m < 4; ++m) { const size_t off = (size_t)(u.pm * BM + ai * HALF + wr * 64 + m * 16 + fr) * ldc + col0;
#pragma unroll
                for (int bj = 0; bj < 2; ++bj)
#pragma unroll
                    for (int n = 0; n < 2; ++n) { const f32x4 bs = *(const f32x4*)(base + off + bj * HALF + n * 16);
                        const u32x2v ew = *(const u32x2v*)(e + off + bj * HALF + n * 16);
                        f32x4 ev; ev[0] = __uint_as_float(ew.x << 16); ev[1] = __uint_as_float(ew.x & 0xffff0000u); ev[2] = __uint_as_float(ew.y << 16); ev[3] = __uint_as_float(ew.y & 0xffff0000u);
                        const f32x4 a = acc[ai][bj][m][n] + bv[bj][n]; f32x4 o;
#pragma unroll
                        for (int i = 0; i < 4; ++i) o[i] = bs[i] * alpha + sigmoid_f(a[i]) * ev[i];
                        *(f32x4*)(out + off + bj * HALF + n * 16) = o; }
                if (m & 1) asm volatile("" ::: "memory"); }
    }
};
template <class Epi, class Sched, bool ALIGN_EPI = false, bool SP2 = false>
__device__ __forceinline__ void gemm_phase(PG8_LAS unsigned char* lds, const Gemm g, const Sched& S, const Epi& E) {
    const int tid = threadIdx.x, wid = __builtin_amdgcn_readfirstlane(tid >> 6), lane = tid & 63, wr = wid >> 2, wc = wid & 3, fr = lane & 15, fq = lane >> 4;
    const int K = g.K, nt = K / BK;
    unsigned voffA[2], voffB[2];
#pragma unroll
    for (int i = 0; i < 2; ++i) { int R, C; stage_rc(tid * 16 + i * 8192, R, C); const int Rb = Epi::PERM ? ((R & ~31) + perm32(R & 31)) : R;
        voffA[i] = (unsigned)(R * K + C) * 2u; voffB[i] = (unsigned)(Rb * K + C) * 2u; }
    const size_t kstep = (size_t)(BK * 2);
    const size_t hstep = (size_t)HALF * K * 2;
    const size_t tstep = 2 * hstep;
    const unsigned ldsw = (unsigned)wid * 1024u;
    const int aoff = lds_byte(wr * 64 + fr, fq * 8), boff = lds_byte(wc * 32 + fr, fq * 8);
#define PG8_SA(b, h) (((b) * 2 + (h)) * HTB)
#define PG8_SB(b, h) ((4 + (b) * 2 + (h)) * HTB)
#define PG8_STAGE(bufoff, gbase, voff) do { _Pragma("unroll") for (int _i = 0; _i < 2; ++_i) \
        __builtin_amdgcn_global_load_lds((const unsigned*)((const char*)(gbase) + (voff)[_i]), (PG8_LAS unsigned*)(lds + (bufoff) + ldsw + _i * 8192), 16, 0, 0); } while (0)
#define PG8_LDA(dst, b, h) do { _Pragma("unroll") for (int m = 0; m < 4; ++m) _Pragma("unroll") for (int k = 0; k < 2; ++k) dst[m][k] = *(const PG8_LAS bf16x8*)(lds + PG8_SA(b, h) + aoff + m * 2048 + k * 1024); } while (0)
#define PG8_LDB(dst, b, h) do { _Pragma("unroll") for (int n = 0; n < 2; ++n) _Pragma("unroll") for (int k = 0; k < 2; ++k) dst[n][k] = *(const PG8_LAS bf16x8*)(lds + PG8_SB(b, h) + boff + n * 2048 + k * 1024); } while (0)
#define PG8_MMA(ai, bj, At, Bt) do { __builtin_amdgcn_s_setprio(1); _Pragma("unroll") for (int m = 0; m < 4; ++m) _Pragma("unroll") for (int n = 0; n < 2; ++n) _Pragma("unroll") for (int k = 0; k < 2; ++k) \
        acc[ai][bj][m][n] = __builtin_amdgcn_mfma_f32_16x16x32_bf16(Bt[n][k], At[m][k], acc[ai][bj][m][n], 0, 0, 0); __builtin_amdgcn_s_setprio(0); } while (0)
#define PG8_WAIT_V(n) asm volatile("s_waitcnt vmcnt(" #n ")" ::: "memory")
#define PG8_WAIT_L(n) asm volatile("s_waitcnt lgkmcnt(" #n ")" ::: "memory")
#define PG8_BAR __builtin_amdgcn_s_barrier()
#define PG8_SCHED __builtin_amdgcn_sched_barrier(0)
    Unit cur, nxt; int ui = 0;
    if (!S.next(0, cur)) return;
    f32x4 acc[2][2][4][2];
#pragma unroll
    for (int a = 0; a < 2; ++a)
#pragma unroll
        for (int b = 0; b < 2; ++b)
#pragma unroll
            for (int m = 0; m < 4; ++m)
#pragma unroll
                for (int n = 0; n < 2; ++n) acc[a][b][m][n] = (f32x4){0.f, 0.f, 0.f, 0.f};
    bf16x8 At[4][2], B0[2][2], B1[2][2];
    const char* cA = (const char*)g.A + (size_t)cur.pm * tstep; const char* cB = (const char*)g.Bt + (size_t)cur.pn * tstep;
    S.a_ready(cur);
    if constexpr (SP2) {
        PG8_STAGE(PG8_SB(0, 0), cB, voffB); PG8_STAGE(PG8_SB(0, 1), cB + hstep, voffB); PG8_STAGE(PG8_SA(0, 0), cA, voffA); PG8_STAGE(PG8_SA(0, 1), cA + hstep, voffA);
        if (wr == 1) PG8_BAR;
        PG8_WAIT_V(2); PG8_BAR;
        PG8_STAGE(PG8_SB(1, 0), cB + kstep, voffB); PG8_STAGE(PG8_SA(1, 0), cA + kstep, voffA); PG8_STAGE(PG8_SB(1, 1), cB + hstep + kstep, voffB);
        PG8_WAIT_V(6); PG8_BAR;
    } else {
        PG8_STAGE(PG8_SB(0, 0), cB, voffB); PG8_STAGE(PG8_SA(0, 0), cA, voffA); PG8_STAGE(PG8_SB(0, 1), cB + hstep, voffB); PG8_STAGE(PG8_SA(0, 1), cA + hstep, voffA);
        if (wr == 1) PG8_BAR;
        PG8_WAIT_V(4); PG8_BAR;
        PG8_STAGE(PG8_SB(1, 0), cB + kstep, voffB); PG8_STAGE(PG8_SA(1, 0), cA + kstep, voffA); PG8_STAGE(PG8_SB(1, 1), cB + hstep + kstep, voffB);
        PG8_WAIT_V(6); PG8_BAR;
    }
    for (;;) {
        const bool has_next = S.next(ui + 1, nxt);
        const char* nA = has_next ? (const char*)g.A + (size_t)nxt.pm * tstep : cA; const char* nB = has_next ? (const char*)g.Bt + (size_t)nxt.pn * tstep : cB;
        for (int t = 0; t < nt; t += 2) {
            const bool last = (t == nt - 2);
            const char* a1 = cA + (size_t)(t + 1) * kstep;
            const char* a2 = last ? nA : cA + (size_t)(t + 2) * kstep; const char* b2 = last ? nB : cB + (size_t)(t + 2) * kstep;
            const char* a3 = a2 + kstep; const char* b3 = b2 + kstep;
            if (last && has_next) S.a_ready(nxt);
            if constexpr (SP2) {
            PG8_LDB(B0, 0, 0); PG8_LDB(B1, 0, 1); PG8_SCHED; PG8_LDA(At, 0, 0); PG8_STAGE(PG8_SA(1, 1), a1 + hstep, voffA);
            PG8_WAIT_V(8); PG8_WAIT_L(0); PG8_BAR; PG8_MMA(0, 0, At, B0); PG8_MMA(0, 1, At, B1); PG8_BAR; PG8_SCHED;
            PG8_LDA(At, 0, 1); PG8_STAGE(PG8_SB(0, 0), b2, voffB); PG8_STAGE(PG8_SB(0, 1), b2 + hstep, voffB); PG8_STAGE(PG8_SA(0, 0), a2, voffA);
            PG8_WAIT_V(8); PG8_WAIT_L(0); PG8_BAR; PG8_MMA(1, 0, At, B0); PG8_MMA(1, 1, At, B1); PG8_BAR; PG8_SCHED;
            PG8_LDB(B0, 1, 0); PG8_LDB(B1, 1, 1); PG8_SCHED; PG8_LDA(At, 1, 0); PG8_STAGE(PG8_SA(0, 1), a2 + hstep, voffA);
            PG8_WAIT_V(8); PG8_WAIT_L(0); PG8_BAR; PG8_MMA(0, 0, At, B0); PG8_MMA(0, 1, At, B1); PG8_BAR; PG8_SCHED;
            PG8_LDA(At, 1, 1); PG8_STAGE(PG8_SB(1, 0), b3, voffB); PG8_STAGE(PG8_SB(1, 1), b3 + hstep, voffB); PG8_STAGE(PG8_SA(1, 0), a3, voffA);
            PG8_WAIT_V(8); PG8_WAIT_L(0); PG8_BAR; PG8_MMA(1, 0, At, B0); PG8_MMA(1, 1, At, B1); PG8_BAR; PG8_SCHED;
            } else {
            PG8_LDB(B0, 0, 0); PG8_SCHED; PG8_LDA(At, 0, 0); PG8_STAGE(PG8_SA(1, 1), a1 + hstep, voffA);
            PG8_WAIT_L(8); PG8_BAR; PG8_WAIT_L(0); PG8_MMA(0, 0, At, B0); PG8_BAR; PG8_SCHED;
            PG8_LDB(B1, 0, 1); PG8_STAGE(PG8_SB(0, 0), b2, voffB);
            PG8_BAR; PG8_WAIT_L(0); PG8_MMA(0, 1, At, B1); PG8_BAR;
            PG8_LDA(At, 0, 1); PG8_STAGE(PG8_SA(0, 0), a2, voffA);
            PG8_BAR; PG8_WAIT_L(0); PG8_MMA(1, 0, At, B0); PG8_BAR; PG8_SCHED;
            PG8_STAGE(PG8_SB(0, 1), b2 + hstep, voffB);
            PG8_WAIT_V(6); PG8_BAR; PG8_MMA(1, 1, At, B1); PG8_BAR;
            PG8_LDB(B0, 1, 0); PG8_SCHED; PG8_LDA(At, 1, 0); PG8_STAGE(PG8_SA(0, 1), a2 + hstep, voffA);
            PG8_WAIT_L(8); PG8_BAR; PG8_WAIT_L(0); PG8_MMA(0, 0, At, B0); PG8_BAR; PG8_SCHED;
            PG8_LDB(B1, 1, 1); PG8_STAGE(PG8_SB(1, 0), b3, voffB);
            PG8_BAR; PG8_WAIT_L(0); PG8_MMA(0, 1, At, B1); PG8_BAR;
            PG8_LDA(At, 1, 1); PG8_STAGE(PG8_SA(1, 0), a3, voffA);
            PG8_BAR; PG8_WAIT_L(0); PG8_MMA(1, 0, At, B0); PG8_BAR; PG8_SCHED;
            PG8_STAGE(PG8_SB(1, 1), b3 + hstep, voffB);
            PG8_WAIT_V(6); PG8_BAR; PG8_MMA(1, 1, At, B1); PG8_BAR;
            }
        }
        if constexpr (ALIGN_EPI) { if (wr == 0) PG8_BAR; }
        if constexpr (!Epi::AFTER_DRAIN) { E(acc, cur, wr, wc, fr, fq); S.done(cur); }
        if (!has_next) break;
#pragma unroll
        for (int a = 0; a < 2; ++a)
#pragma unroll
            for (int b = 0; b < 2; ++b)
#pragma unroll
                for (int m = 0; m < 4; ++m)
#pragma unroll
                    for (int n = 0; n < 2; ++n) acc[a][b][m][n] = (f32x4){0.f, 0.f, 0.f, 0.f};
        cur = nxt; cA = nA; cB = nB; ++ui;
        if constexpr (ALIGN_EPI) { if (wr == 1) PG8_BAR; }
    }
    PG8_WAIT_V(0);
    if constexpr (!ALIGN_EPI) { if (wr == 0) PG8_BAR; }
    PG8_BAR;
    if constexpr (Epi::AFTER_DRAIN) { E.fused(acc, cur, wr, wc, fr, fq, lds, wid, lane); S.done(cur); }
#undef PG8_SA
#undef PG8_SB
#undef PG8_STAGE
#undef PG8_LDA
#undef PG8_LDB
#undef PG8_MMA
#undef PG8_WAIT_V
#undef PG8_WAIT_L
#undef PG8_BAR
#undef PG8_SCHED
}
}

constexpr int NWAVES = 8, NT = NWAVES * 64;
constexpr int BATCH = 2, SEQ = 4096, DM = 2048, M = BATCH * SEQ;
constexpr int DFF = 5632, NGU = 2 * DFF;
constexpr int INC = 6432, INP = 6656;
constexpr int AW = 1024, RW = 1024, NH = 16, HD = 64;
constexpr int PLE = 256;
constexpr int UQ = 0, UK = 1024, UV = 2048, UR = 3072;
constexpr float LN_EPS = 1e-5f, GN_EPS = 64e-5f;
constexpr float ALPHA = 1.189207115002721f;
constexpr float LOG2E = 1.4426950408889634f;

constexpr size_t MiB = 1u << 20;
constexpr size_t WS_CTL = 0, CTL_ZERO_BYTES = 1 * MiB;
constexpr size_t WS_WGU = 2 * MiB;
constexpr size_t WS_WD = 46 * MiB;
constexpr size_t WS_WIN = 68 * MiB;
constexpr size_t WS_WOUT = 94 * MiB;
constexpr size_t WS_WPG = 102 * MiB;
constexpr size_t WS_WPU = 110 * MiB;
constexpr size_t WS_SMALL = 111 * MiB;
constexpr size_t WS_XB = 112 * MiB;
constexpr size_t WS_BIG = 144 * MiB;
constexpr size_t WS_MIX = 248 * MiB;
constexpr size_t WS_SCAN = 280 * MiB;
constexpr size_t WS_PB = 392 * MiB;
constexpr size_t WS_END = 396 * MiB;
constexpr size_t SM_W2T = 0, SM_A2T = 131072, SM_G2T = 262144, SM_KMEAN = 655360;
constexpr size_t WS_BONUS = 1 * MiB;
static_assert(SM_G2T + 1024 * 192 * 2 <= SM_KMEAN && SM_KMEAN + 2 * 16 * 16 * 64 * 2 <= MiB, "small map");
constexpr int CW_TMO = 0, CW_BAR = 4096, CW_QUEUE = 8192;

constexpr int RING_BYTES = 131072;
constexpr int LDSCTL_OFF = RING_BYTES, MISC_OFF = LDSCTL_OFF + 320;
constexpr int LDS_BYTES = 147456;

#define GAS __attribute__((address_space(1)))
#define LAS __attribute__((address_space(3)))
typedef unsigned short bf16;
typedef unsigned v4u __attribute__((ext_vector_type(4)));
typedef unsigned v2u __attribute__((ext_vector_type(2)));
typedef float f32x4 __attribute__((ext_vector_type(4)));
typedef float f32x16 __attribute__((ext_vector_type(16)));
typedef short bf16x8 __attribute__((ext_vector_type(8)));
typedef short s16x4 __attribute__((ext_vector_type(4)));
typedef GAS unsigned gu32;
#define RLX_AGENT __ATOMIC_RELAXED, __HIP_MEMORY_SCOPE_AGENT
#define LDS_WAIT() asm volatile("s_waitcnt lgkmcnt(0)" ::: "memory")
#define VM_WAIT() asm volatile("s_waitcnt vmcnt(0)" ::: "memory")
__device__ __forceinline__ unsigned f2bf(float f) { unsigned u = __builtin_bit_cast(unsigned, f); return (u + 0x7fffu + ((u >> 16) & 1u)) >> 16; }
__device__ __forceinline__ unsigned pk2(float lo, float hi) { return f2bf(lo) | (f2bf(hi) << 16); }
__device__ __forceinline__ float bf2f(unsigned short b) { return __uint_as_float((unsigned)b << 16); }
__device__ __forceinline__ float bflo(unsigned w) { return __uint_as_float(w << 16); }
__device__ __forceinline__ float bfhi(unsigned w) { return __uint_as_float(w & 0xffff0000u); }

#define XB_TMO      128
#define XB_XCNT(j)  (256  + 64 * (j))
#define XB_XSUB(j)  (1280 + 64 * (j))
#define XB_XGEN(j)  (2304 + 64 * (j))
#define XB_TOP      3328
#define XB_TOPGEN   3392
#define XCD_BAR_WORDS 3456
#define XB_SPIN_CAP (1u << 18)
__device__ __forceinline__ unsigned xb_ld(unsigned* p)              { return __hip_atomic_load(p, __ATOMIC_RELAXED, __HIP_MEMORY_SCOPE_AGENT); }
__device__ __forceinline__ unsigned xb_add(unsigned* p, unsigned v) { return __hip_atomic_fetch_add(p, v, __ATOMIC_RELAXED, __HIP_MEMORY_SCOPE_AGENT); }
__device__ __forceinline__ unsigned xb_xcc_id() { return (unsigned)__builtin_amdgcn_s_getreg((3 << 11) | 20) & 0xFu; }
#define XB_SPIN(cond, bar) do { unsigned _sp = 0; while (cond) { __builtin_amdgcn_s_sleep(1); \
    if ((++_sp & 255u) == 0u) { if (xb_ld(&(bar)[XB_TMO])) break; if (_sp > XB_SPIN_CAP) { atomicAdd(&(bar)[XB_TMO], 1u); break; } } } } while (0)
struct XcdBarrier { unsigned* bar; unsigned x; volatile LAS unsigned* st; };
__device__ __forceinline__ XcdBarrier xcd_barrier_post(unsigned* bar, volatile LAS unsigned* st) {
    XcdBarrier b; b.bar = bar; b.x = xb_xcc_id(); b.st = st;
    if (threadIdx.x == 0) (void)xb_add(&bar[XB_XCNT(b.x)], 1u);
    return b;
}
__device__ __forceinline__ void xcd_barrier_complete(unsigned* bar, unsigned x, unsigned& nloc, unsigned& nx) {
    const unsigned G = gridDim.x * gridDim.y * gridDim.z;
    unsigned sum, cnt, mine, sp = 0u;
    for (;;) {
        sum = 0u; cnt = 0u; mine = 0u;
#pragma unroll
        for (unsigned j = 0; j < 16; ++j) { const unsigned c = xb_ld(&bar[XB_XCNT(j)]); sum += c; cnt += (c > 0u) ? 1u : 0u; mine = (j == x) ? c : mine; }
        if (sum == G) break;
        __builtin_amdgcn_s_sleep(1);
        if ((++sp & 255u) == 0u) { if (xb_ld(&bar[XB_TMO])) break; if (sp > XB_SPIN_CAP) { atomicAdd(&bar[XB_TMO], 1u); break; } }
    }
    nloc = mine > 0u ? mine : 1u; nx = cnt > 0u ? cnt : 1u;
}
__device__ __forceinline__ void xcd_barrier(const XcdBarrier& b) {
    asm volatile("s_waitcnt vmcnt(0)" ::: "memory");
    __syncthreads();
    if (threadIdx.x == 0) {
        unsigned* bar = b.bar;
        __builtin_amdgcn_s_waitcnt(0);
        unsigned nloc = b.st[0], nx = b.st[1];
        if (nloc == 0u) { xcd_barrier_complete(bar, b.x, nloc, nx); b.st[0] = nloc; b.st[1] = nx; }
        const unsigned old = xb_add(&bar[XB_XSUB(b.x)], 1u);
        const unsigned gen = old / nloc;
        if (old + 1u == (gen + 1u) * nloc) {
            __builtin_amdgcn_fence(__ATOMIC_RELEASE, "agent");
            asm volatile("s_waitcnt vmcnt(0)" ::: "memory");
            const unsigned og = xb_add(&bar[XB_TOP], 1u);
            const unsigned tg = og / nx;
            if (og + 1u == (tg + 1u) * nx) xb_add(&bar[XB_TOPGEN], 1u);
            else XB_SPIN(xb_ld(&bar[XB_TOPGEN]) == tg, bar);
            __builtin_amdgcn_fence(__ATOMIC_ACQUIRE, "agent");
            xb_add(&bar[XB_XGEN(b.x)], 1u);
            asm volatile("s_waitcnt vmcnt(0)" ::: "memory");
        } else {
            XB_SPIN(xb_ld(&bar[XB_XGEN(b.x)]) == gen, bar);
            __builtin_amdgcn_fence(__ATOMIC_ACQUIRE, "agent");
            asm volatile("s_waitcnt vmcnt(0)" ::: "memory");
        }
    }
    __syncthreads();
}

struct Args { const float* in[33]; float* out; unsigned char* ws; int ph_lo, ph_hi; };
struct Frame {
    LAS unsigned char* lds;
    int tid, lane, wave, G, bid;
    const float* const* in;
    float* hz;
    unsigned char* ws;
};
__device__ __forceinline__ float wave_sum(float v) {
#pragma unroll
    for (int o = 1; o < 64; o <<= 1) v += __shfl_xor(v, o);
    return v;
}

__device__ __forceinline__ void transpose_item(const float* W, int Kvalid, int N, bf16* WT, int ldo, int orow0, LAS float* scr, int k0, int n0, int lane) {
    f32x4 v[8];
#pragma unroll
    for (int i = 0; i < 8; ++i) { const int kk = (lane >> 3) + 8 * i; v[i] = (f32x4){0.f, 0.f, 0.f, 0.f}; if (k0 + kk < Kvalid) v[i] = *(const GAS f32x4*)(W + (size_t)(k0 + kk) * N + n0 + 4 * (lane & 7)); }
#pragma unroll
    for (int i = 0; i < 8; ++i) { const int kk = (lane >> 3) + 8 * i; LAS float* d = scr + kk * 33 + 4 * (lane & 7); d[0] = v[i][0]; d[1] = v[i][1]; d[2] = v[i][2]; d[3] = v[i][3]; }
    LDS_WAIT(); asm volatile("" ::: "memory");
    const int c = lane & 7;
#pragma unroll
    for (int j = 0; j < 4; ++j) { const int n = (lane >> 3) + 8 * j; const LAS float* s = scr + (8 * c) * 33 + n;
        v4u o; o.x = pk2(s[0 * 33], s[1 * 33]); o.y = pk2(s[2 * 33], s[3 * 33]); o.z = pk2(s[4 * 33], s[5 * 33]); o.w = pk2(s[6 * 33], s[7 * 33]);
        *(GAS v4u*)(WT + (size_t)(orow0 + n) * ldo + k0 + 8 * c) = o; }
    LDS_WAIT(); asm volatile("" ::: "memory");
}
__device__ __forceinline__ void transpose_job(Frame& F, const float* W, int Kvalid, int Kpad, int N, bf16* WT, int ldo, int mode, int& base) {
    LAS float* scr = (LAS float*)(F.lds + F.wave * 16384);
    const int gw = F.bid * NWAVES + F.wave, NGW = F.G * NWAVES;
    const int nblk = N / 32, items = (Kpad / 64) * nblk;
    int first = (gw - base % NGW + NGW) % NGW;
    for (int it = first; it < items; it += NGW) {
        const int kb = it / nblk, nb = it % nblk, n0 = 32 * nb;
        const int orow0 = (mode == 0) ? n0 : ((n0 >> 7) * 256 + (mode == 2 ? 128 : 0) + (n0 & 127));
        transpose_item(W, Kvalid, N, WT, ldo, orow0, scr, 64 * kb, n0, F.lane);
    }
    base += items;
}
__device__ __forceinline__ void convert_bf16(Frame& F, const float* src, bf16* dst, size_t n) {
    const size_t gt = (size_t)F.bid * NT + F.tid, NGT = (size_t)F.G * NT, n8 = n / 8;
    for (size_t i = gt; i < n8; i += 4 * NGT) { f32x4 a[4], b[4];
#pragma unroll
        for (int u = 0; u < 4; ++u) if (i + u * NGT < n8) { a[u] = *(const GAS f32x4*)(src + (i + u * NGT) * 8); b[u] = *(const GAS f32x4*)(src + (i + u * NGT) * 8 + 4); }
#pragma unroll
        for (int u = 0; u < 4; ++u) if (i + u * NGT < n8) { v4u o; o.x = pk2(a[u][0], a[u][1]); o.y = pk2(a[u][2], a[u][3]); o.z = pk2(b[u][0], b[u][1]); o.w = pk2(b[u][2], b[u][3]); *(GAS v4u*)(dst + (i + u * NGT) * 8) = o; } }
}
__device__ __forceinline__ void ffn_weights(Frame& F, int gi, int ui, int di, int& base) {
    transpose_job(F, F.in[gi], DM, DM, DFF, (bf16*)(F.ws + WS_WGU), DM, 1, base);
    transpose_job(F, F.in[ui], DM, DM, DFF, (bf16*)(F.ws + WS_WGU), DM, 2, base);
    transpose_job(F, F.in[di], DFF, DFF, DM, (bf16*)(F.ws + WS_WD), DFF, 0, base);
}

template <bool WRITE_BF16>
__device__ __forceinline__ void ln_phase(Frame& F, float* hz, const float* g, const float* b, bf16* hb) {
    const int gw = F.bid * NWAVES + F.wave, NGW = F.G * NWAVES;
    f32x4 gv[8], bv[8];
#pragma unroll
    for (int j = 0; j < 8; ++j) { gv[j] = *(const GAS f32x4*)(g + F.lane * 4 + 256 * j); bv[j] = *(const GAS f32x4*)(b + F.lane * 4 + 256 * j); }
    for (int m = gw; m < M; m += NGW) {
        GAS f32x4* xr = (GAS f32x4*)(hz + (size_t)m * DM) + F.lane;
        f32x4 v[8]; float s = 0.f;
#pragma unroll
        for (int j = 0; j < 8; ++j) { v[j] = xr[64 * j]; s += (v[j][0] + v[j][1]) + (v[j][2] + v[j][3]); }
        const float mean = wave_sum(s) * (1.f / DM); float s2 = 0.f;
#pragma unroll
        for (int j = 0; j < 8; ++j) { v[j] = v[j] - mean; s2 += (v[j][0] * v[j][0] + v[j][1] * v[j][1]) + (v[j][2] * v[j][2] + v[j][3] * v[j][3]); }
        const float rstd = 1.f / sqrtf(wave_sum(s2) * (1.f / DM) + LN_EPS);
#pragma unroll
        for (int j = 0; j < 8; ++j) { v[j] = v[j] * rstd * gv[j] + bv[j]; xr[64 * j] = v[j]; }
        if (WRITE_BF16) { GAS v2u* o8 = (GAS v2u*)(hb + (size_t)m * DM) + F.lane;
#pragma unroll
            for (int j = 0; j < 8; ++j) { v2u w; w.x = pk2(v[j][0], v[j][1]); w.y = pk2(v[j][2], v[j][3]); o8[64 * j] = w; } }
    }
}

__device__ __forceinline__ int crow(int r, int hi) { return (r & 3) + 8 * (r >> 2) + 4 * hi; }
__device__ __forceinline__ float red32(float v) {
#pragma unroll
    for (int o = 1; o < 32; o <<= 1) v += __shfl_xor(v, o);
    return v;
}
__device__ __forceinline__ void kmean_tasks(Frame& F) {
    const bf16* ub = (const bf16*)(F.ws + WS_BIG); bf16* km = (bf16*)(F.ws + WS_SMALL + SM_KMEAN);
    const int gw = F.bid * NWAVES + F.wave, NGW = F.G * NWAVES;
    for (int task = gw; task < BATCH * 16 * NH; task += NGW) {
        const int b = task >> 8, blk = (task >> 4) & 15, h = task & 15;
        const bf16* p = ub + (size_t)(b * SEQ + blk * 256) * INP + UK + h * HD + F.lane;
        float s0 = 0.f, s1 = 0.f, s2 = 0.f, s3 = 0.f;
#pragma unroll 4
        for (int i = 0; i < 256; i += 4) { s0 += bf2f(p[(size_t)i * INP]); s1 += bf2f(p[(size_t)(i + 1) * INP]); s2 += bf2f(p[(size_t)(i + 2) * INP]); s3 += bf2f(p[(size_t)(i + 3) * INP]); }
        km[((b * NH + h) * 16 + blk) * HD + F.lane] = (bf16)f2bf(((s0 + s1) + (s2 + s3)) * (1.f / 256.f));
    }
}
__device__ __forceinline__ void shifted4(const bf16* ucol  , bool first_is_seq_start, float mix, float (&o)[4]) {
    float pv = first_is_seq_start ? 0.f : bf2f(*(ucol - INP));
#pragma unroll
    for (int i = 0; i < 4; ++i) { const float c = bf2f(ucol[(size_t)i * INP]); o[i] = c + (pv - c) * mix; pv = c; }
}
constexpr int PA_W = 0, PA_A = 4608, PA_G = 9216, PA_PITCH = 144, PG_PITCH = 400;
__device__ __forceinline__ void prep_tile(Frame& F, int tile) {
    const bf16* ub = (const bf16*)(F.ws + WS_BIG);
    const int m0 = tile * 32;
    const float* shift_mix = F.in[9];
    LAS unsigned char* L = F.lds;
    for (int idx = F.tid; idx < 32 * 288; idx += NT) {
        const int t = idx / 288, k = idx - t * 288, m = m0 + t;
        const bf16* up = ub + (size_t)m * INP + UR + 3072 + k;
        const float cur = bf2f(*up), prev = ((m & (SEQ - 1)) == 0) ? 0.f : bf2f(*(up - INP));
        const float us = cur + (prev - cur) * shift_mix[3072 + k];
        if (k < 64) { const float e2 = __expf(2.f * us); *(LAS bf16*)(L + PA_W + t * PA_PITCH + k * 2) = (bf16)f2bf(1.f - 2.f / (e2 + 1.f)); }
        else if (k < 128) *(LAS bf16*)(L + PA_A + t * PA_PITCH + (k - 64) * 2) = (bf16)f2bf(us);
        else *(LAS bf16*)(L + PA_G + t * PG_PITCH + (k - 128) * 2) = (bf16)f2bf(1.f / (1.f + __expf(-us)));
    }
    for (int idx = F.tid; idx < 32 * 32; idx += NT) *(LAS bf16*)(L + PA_G + (idx >> 5) * PG_PITCH + (160 + (idx & 31)) * 2) = 0;
    __syncthreads();
    const bf16* w2t = (const bf16*)(F.ws + WS_SMALL + SM_W2T); const bf16* a2t = (const bf16*)(F.ws + WS_SMALL + SM_A2T); const bf16* g2t = (const bf16*)(F.ws + WS_SMALL + SM_G2T);
    const float *w0 = F.in[10], *a0 = F.in[12], *k_k = F.in[15], *k_a = F.in[16], *r_k = F.in[17];
    bf16* SR = (bf16*)(F.ws + WS_SCAN); bf16* SE = SR + (size_t)M * RW; bf16* SKP = SE + (size_t)M * RW; bf16* SV = SKP + (size_t)M * RW;
    bf16* SKK = SV + (size_t)M * RW; bf16* SBB = SKK + (size_t)M * RW; bf16* SGG = SBB + (size_t)M * RW;
    float* bonus = (float*)(F.ws + WS_BONUS);
    const int r32 = F.lane & 31, hi = F.lane >> 5;
    const bool seq0 = (m0 & (SEQ - 1)) == 0;
    for (int hp = 0; hp < 2; ++hp) {
        const int head = 2 * F.wave + hp;
        float n2[16], bon[16];
#pragma unroll
        for (int r = 0; r < 16; ++r) { n2[r] = 0.f; bon[r] = 0.f; }
        for (int nt = 0; nt < 2; ++nt) {
            const int c = head * 64 + 32 * nt + r32;
            f32x16 accA = {};
#pragma unroll
            for (int ks = 0; ks < 4; ++ks) { const bf16x8 af = *(const LAS bf16x8*)(L + PA_A + r32 * PA_PITCH + (16 * ks + 8 * hi) * 2); const bf16x8 bfr = *(const GAS bf16x8*)(a2t + c * 64 + 16 * ks + 8 * hi);
                accA = __builtin_amdgcn_mfma_f32_32x32x16_bf16(af, bfr, accA, 0, 0, 0); }
            const float a0c = a0[c], kkc = k_k[c], kac = k_a[c], rkc = r_k[c], mixr = shift_mix[c], mixk = shift_mix[1024 + c];
#pragma unroll
            for (int g = 0; g < 4; ++g) { const int tb = 8 * g + 4 * hi; float rr[4], kr[4];
                shifted4(ub + (size_t)(m0 + tb) * INP + UR + c, seq0 && tb == 0, mixr, rr);
                shifted4(ub + (size_t)(m0 + tb) * INP + UR + 1024 + c, seq0 && tb == 0, mixk, kr);
#pragma unroll
                for (int i = 0; i < 4; ++i) { const int r = 4 * g + i; const float a = 1.f / (1.f + __expf(-(a0c + accA[r])));
                    const float kq = kr[i] * kkc; n2[r] += kq * kq; bon[r] += rr[i] * kr[i] * (1.f + (a - 1.f) * kac) * rkc; } }
        }
        float inv[16];
#pragma unroll
        for (int r = 0; r < 16; ++r) { const float s = red32(n2[r]); inv[r] = 1.f / fmaxf(sqrtf(s), 1e-12f); bon[r] = red32(bon[r]); }
        if (r32 == 0) {
#pragma unroll
            for (int r = 0; r < 16; ++r) bonus[(size_t)(m0 + crow(r, hi)) * NH + head] = bon[r]; }
        for (int nt = 0; nt < 2; ++nt) {
            const int c = head * 64 + 32 * nt + r32;
            f32x16 accA = {}, accW = {}, accG = {};
#pragma unroll
            for (int ks = 0; ks < 4; ++ks) { const bf16x8 af = *(const LAS bf16x8*)(L + PA_A + r32 * PA_PITCH + (16 * ks + 8 * hi) * 2); const bf16x8 bfr = *(const GAS bf16x8*)(a2t + c * 64 + 16 * ks + 8 * hi);
                accA = __builtin_amdgcn_mfma_f32_32x32x16_bf16(af, bfr, accA, 0, 0, 0);
                const bf16x8 wf = *(const LAS bf16x8*)(L + PA_W + r32 * PA_PITCH + (16 * ks + 8 * hi) * 2); const bf16x8 bw = *(const GAS bf16x8*)(w2t + c * 64 + 16 * ks + 8 * hi);
                accW = __builtin_amdgcn_mfma_f32_32x32x16_bf16(wf, bw, accW, 0, 0, 0); }
#pragma unroll
            for (int ks = 0; ks < 12; ++ks) { const bf16x8 gf = *(const LAS bf16x8*)(L + PA_G + r32 * PG_PITCH + (16 * ks + 8 * hi) * 2); const bf16x8 bg = *(const GAS bf16x8*)(g2t + c * 192 + 16 * ks + 8 * hi);
                accG = __builtin_amdgcn_mfma_f32_32x32x16_bf16(gf, bg, accG, 0, 0, 0); }
            const float a0c = a0[c], w0c = w0[c], kkc = k_k[c], kac = k_a[c], mixr = shift_mix[c], mixk = shift_mix[1024 + c], mixv = shift_mix[2048 + c];
#pragma unroll
            for (int g = 0; g < 4; ++g) { const int tb = 8 * g + 4 * hi; float rr[4], kr[4], vr[4];
                shifted4(ub + (size_t)(m0 + tb) * INP + UR + c, seq0 && tb == 0, mixr, rr);
                shifted4(ub + (size_t)(m0 + tb) * INP + UR + 1024 + c, seq0 && tb == 0, mixk, kr);
                shifted4(ub + (size_t)(m0 + tb) * INP + UR + 2048 + c, seq0 && tb == 0, mixv, vr);
#pragma unroll
                for (int i = 0; i < 4; ++i) { const int r = 4 * g + i; const size_t o = (size_t)(m0 + tb + i) * RW + c;
                    const float a = 1.f / (1.f + __expf(-(a0c + accA[r])));
                    const float x = -(w0c + accW[r]);
                    const float sp = fmaxf(x, 0.f) + __logf(1.f + __expf(-fabsf(x)));
                    const float e = __expf(-sp - 0.5f);
                    const float kk = kr[i] * kkc * inv[r], kp = kr[i] * (1.f + (a - 1.f) * kac);
                    SR[o] = (bf16)f2bf(rr[i]); SE[o] = (bf16)f2bf(e); SKP[o] = (bf16)f2bf(kp); SV[o] = (bf16)f2bf(vr[i]);
                    SKK[o] = (bf16)f2bf(kk); SBB[o] = (bf16)f2bf(kk * a); SGG[o] = (bf16)f2bf(accG[r]); } }
        }
    }
    __syncthreads();
}

#define DPP_ADD(x, ctrl) ((x) + __builtin_bit_cast(float, __builtin_amdgcn_update_dpp(0, __builtin_bit_cast(int, (x)), (ctrl), 0xF, 0xF, true)))
constexpr int SC_T = 32, SC_ARR = SC_T * 256, SC_V = 5 * SC_ARR, SC_BUF = SC_V + SC_T * 64;
struct ScanIn { f32x4 r, w, k, q, b; float v; };
__device__ __forceinline__ void scan_task(Frame& F, int task) {
    const int bh = task >> 2, quarter = task & 3, b = bh >> 4, h = bh & 15;
    const bf16* SR = (const bf16*)(F.ws + WS_SCAN);
    float* Y = (float*)(F.ws + WS_XB);
    LAS unsigned char* L = F.lds;
    const size_t mb = (size_t)b * SEQ;
    if (F.tid >= 256) {
        const int lt = F.tid - 256, pi = lt & 31, ts = lt >> 5;
        const int vt = lt >> 3, vp = lt & 7;
        unsigned reg[5][4], vreg;
        const GAS unsigned* gsrc[5];
#pragma unroll
        for (int a = 0; a < 5; ++a) { const int arr = (a < 3) ? a : a + 1;
            gsrc[a] = (const GAS unsigned*)(SR + (size_t)arr * M * RW + mb * RW + h * HD) + pi; }
        const GAS unsigned* vsrc = (const GAS unsigned*)(SR + (size_t)3 * M * RW + mb * RW + h * HD + 16 * quarter) + vp;
#define SC_LOAD(c) do { _Pragma("unroll") for (int a = 0; a < 5; ++a) _Pragma("unroll") for (int q = 0; q < 4; ++q) reg[a][q] = gsrc[a][(size_t)((c) * SC_T + ts + 8 * q) * (RW / 2)]; \
        vreg = vsrc[(size_t)((c) * SC_T + vt) * (RW / 2)]; } while (0)
#define SC_WRITE(bufo) do { _Pragma("unroll") for (int a = 0; a < 5; ++a) _Pragma("unroll") for (int q = 0; q < 4; ++q) { float lo = bflo(reg[a][q]), hi_ = bfhi(reg[a][q]); \
            if (a == 1) { lo = __expf(-lo); hi_ = __expf(-hi_); } \
            typedef float f32x2w __attribute__((ext_vector_type(2))); *(LAS f32x2w*)(L + (bufo) + a * SC_ARR + (ts + 8 * q) * 256 + pi * 8) = (f32x2w){lo, hi_}; } \
        { typedef float f32x2w __attribute__((ext_vector_type(2))); *(LAS f32x2w*)(L + (bufo) + SC_V + vt * 64 + vp * 8) = (f32x2w){bflo(vreg), bfhi(vreg)}; } } while (0)
        SC_LOAD(0); SC_WRITE(0); SC_LOAD(1);
        __syncthreads();
        for (int c = 0; c < SEQ / SC_T; ++c) {
            if (c + 1 < SEQ / SC_T) { SC_WRITE(((c + 1) & 1) * SC_BUF); if (c + 2 < SEQ / SC_T) SC_LOAD(c + 2); }
            __syncthreads();
        }
#undef SC_LOAD
#undef SC_WRITE
    } else {
        const int il = F.tid >> 4, jg = F.tid & 15;
        float S0 = 0.f, S1 = 0.f, S2 = 0.f, S3 = 0.f, yq = 0.f, ykeep = 0.f;
        float* yp = Y + mb * RW + h * HD + 16 * quarter + il;
#define SC_LD(X, tt) do { X.r = *(const LAS f32x4*)(B + 0 * SC_ARR + (tt) * 256 + jg * 16); X.w = *(const LAS f32x4*)(B + 1 * SC_ARR + (tt) * 256 + jg * 16); \
        X.k = *(const LAS f32x4*)(B + 2 * SC_ARR + (tt) * 256 + jg * 16); X.q = *(const LAS f32x4*)(B + 3 * SC_ARR + (tt) * 256 + jg * 16); \
        X.b = *(const LAS f32x4*)(B + 4 * SC_ARR + (tt) * 256 + jg * 16); X.v = *(const LAS float*)(B + SC_V + (tt) * 64 + il * 4); } while (0)
#define SC_STEP(X, tt) do { \
        float sp = (S0 * X.q[0] + S1 * X.q[1]) + (S2 * X.q[2] + S3 * X.q[3]); \
        const float vk0 = X.v * X.k[0], vk1 = X.v * X.k[1], vk2 = X.v * X.k[2], vk3 = X.v * X.k[3]; \
        sp = DPP_ADD(sp, 0xB1); yq = DPP_ADD(yq, 0xB1); sp = DPP_ADD(sp, 0x4E); yq = DPP_ADD(yq, 0x4E); \
        sp = DPP_ADD(sp, 0x141); yq = DPP_ADD(yq, 0x141); sp = DPP_ADD(sp, 0x140); yq = DPP_ADD(yq, 0x140); \
        ykeep = (jg == (((tt) + 15) & 15)) ? yq : ykeep;                       \
        if ((((tt) & 15) == 0) && (c > 0 || (tt) > 0)) yp[(size_t)(c * SC_T + (tt) - 16 + jg) * RW] = ykeep; \
        S0 = S0 * X.w[0] + (vk0 - sp * X.b[0]); S1 = S1 * X.w[1] + (vk1 - sp * X.b[1]); S2 = S2 * X.w[2] + (vk2 - sp * X.b[2]); S3 = S3 * X.w[3] + (vk3 - sp * X.b[3]); \
        yq = (S0 * X.r[0] + S1 * X.r[1]) + (S2 * X.r[2] + S3 * X.r[3]); } while (0)
        __syncthreads();
        for (int c = 0; c < SEQ / SC_T; ++c) {
            const LAS unsigned char* B = L + (c & 1) * SC_BUF;
            ScanIn A, Bn;
            SC_LD(A, 0);
#pragma unroll
            for (int tt = 0; tt < SC_T; tt += 2) {
                SC_LD(Bn, tt + 1); __builtin_amdgcn_sched_barrier(0);
                SC_STEP(A, tt); __builtin_amdgcn_sched_barrier(0);
                if (tt + 2 < SC_T) SC_LD(A, tt + 2);
                __builtin_amdgcn_sched_barrier(0);
                SC_STEP(Bn, tt + 1); __builtin_amdgcn_sched_barrier(0);
            }
            __syncthreads();
        }
        yq = DPP_ADD(yq, 0xB1); yq = DPP_ADD(yq, 0x4E); yq = DPP_ADD(yq, 0x141); yq = DPP_ADD(yq, 0x140);
        ykeep = (jg == 15) ? yq : ykeep;
        yp[(size_t)(SEQ - 16 + jg) * RW] = ykeep;
#undef SC_LD
#undef SC_STEP
    }
    __syncthreads();
}
__device__ __forceinline__ void rw_finalize(Frame& F) {
    const int gw = F.bid * NWAVES + F.wave, NGW = F.G * NWAVES;
    const float* Y = (const float*)(F.ws + WS_XB); const bf16* SV = (const bf16*)(F.ws + WS_SCAN) + (size_t)3 * M * RW; const bf16* SGG = (const bf16*)(F.ws + WS_SCAN) + (size_t)6 * M * RW;
    const float* bonus = (const float*)(F.ws + WS_BONUS); bf16* mix = (bf16*)(F.ws + WS_MIX);
    const float *gn_g = F.in[18], *gn_b = F.in[19];
    for (int m = gw; m < M; m += NGW) {
        for (int h = 0; h < NH; ++h) { const int c = h * HD + F.lane; const size_t o = (size_t)m * RW + c;
            const float y = Y[o]; const float mu = wave_sum(y) * (1.f / HD); const float d = y - mu; const float var = wave_sum(d * d) * (1.f / HD);
            const float yn = d * (1.f / sqrtf(var + GN_EPS)) * gn_g[c] + gn_b[c];
            const float val = (yn + bonus[(size_t)m * NH + h] * bf2f(SV[o])) * bf2f(SGG[o]);
            mix[(size_t)m * DM + AW + c] = (bf16)f2bf(val); }
    }
}

constexpr int AT_K = 0, AT_V = 16384, AT_WS = 32768, AT_GATE = 34816, AT_TAB = 51200, AT_OST = 52224, AT_BYTES = AT_OST + 8 * 4096;
__device__ __forceinline__ int rel_bucket_i(int d) {
    if (d < 16) return d;
    return 16 + (d >= 19) + (d >= 21) + (d >= 24) + (d >= 27) + (d >= 31) + (d >= 35) + (d >= 40) + (d >= 46) + (d >= 52) + (d >= 59) + (d >= 67) + (d >= 77) + (d >= 87) + (d >= 99) + (d >= 113);
}
__device__ __forceinline__ s16x4 vtr(const LAS unsigned char* p) { typedef short v4i16_t __attribute__((ext_vector_type(4))); return __builtin_bit_cast(s16x4, __builtin_amdgcn_ds_read_tr16_b64_v4i16((LAS v4i16_t*)p)); }
__device__ __forceinline__ unsigned cvtpk(float lo, float hi) { typedef float f2 __attribute__((ext_vector_type(2))); typedef __bf16 b2 __attribute__((ext_vector_type(2))); f2 v = {lo, hi}; b2 b = __builtin_convertvector(v, b2); return __builtin_bit_cast(unsigned, b); }
__device__ __forceinline__ float swapmax(float m) { auto rr = __builtin_amdgcn_permlane32_swap(__float_as_uint(m), __float_as_uint(m), false, false); return fmaxf(__uint_as_float(rr[0]), __uint_as_float(rr[1])); }
__device__ __forceinline__ float swapsum(float m) { auto rr = __builtin_amdgcn_permlane32_swap(__float_as_uint(m), __float_as_uint(m), false, false); return __uint_as_float(rr[0]) + __uint_as_float(rr[1]); }

__device__ __forceinline__ void attn_unit(Frame& F, int b, int h, int qb) {
    const bf16* ub = (const bf16*)(F.ws + WS_BIG); const bf16* km = (const bf16*)(F.ws + WS_SMALL + SM_KMEAN); bf16* mix = (bf16*)(F.ws + WS_MIX);
    const float* rel_bias = F.in[8];
    LAS unsigned char* L = F.lds;
    const int lane = F.lane, wid = F.wave, r32 = lane & 31, hi = lane >> 5;
    const size_t mb = (size_t)b * SEQ;
    const int q0 = qb * 256;
    LAS float* tab = (LAS float*)(L + AT_TAB);
    LAS float* wsf = (LAS float*)(L + AT_WS) + wid * 64;
    constexpr float C2 = 0.125f * LOG2E;
    if (F.tid < 129) tab[F.tid] = rel_bias[rel_bucket_i(F.tid) * NH + h] * LOG2E;
    bf16x8 qr[4];
    { const bf16* Qw = ub + (mb + q0 + wid * 32 + r32) * INP + UQ + h * HD;
#pragma unroll
      for (int d0 = 0; d0 < 4; ++d0) qr[d0] = *(const GAS bf16x8*)(Qw + d0 * 16 + hi * 8); }
    unsigned sel = 0u;
    if (qb > 0) {
        f32x16 g = {};
        const bf16* kmp = km + ((size_t)(b * NH + h) * 16 + (r32 & 15)) * HD;
#pragma unroll
        for (int d0 = 0; d0 < 4; ++d0) { const bf16x8 kf = *(const GAS bf16x8*)(kmp + d0 * 16 + hi * 8); g = __builtin_amdgcn_mfma_f32_32x32x16_bf16(kf, qr[d0], g, 0, 0, 0); }
        LAS float* gs = (LAS float*)(L + AT_GATE) + wid * 512;
#pragma unroll
        for (int r = 0; r < 8; ++r) gs[r32 * 16 + crow(r, hi)] = g[r];
        LDS_WAIT(); asm volatile("" ::: "memory");
        float gv[16];
#pragma unroll
        for (int i = 0; i < 4; ++i) { const f32x4 t = *(const LAS f32x4*)(gs + r32 * 16 + 4 * i); gv[4 * i] = t[0]; gv[4 * i + 1] = t[1]; gv[4 * i + 2] = t[2]; gv[4 * i + 3] = t[3]; }
#pragma unroll
        for (int pass = 0; pass < 3; ++pass) { float best = -INFINITY; int bi = -1;
#pragma unroll
            for (int n = 0; n < 16; ++n) { const bool ok = (n < qb) && !((sel >> n) & 1u) && (gv[n] > best); if (ok) { best = gv[n]; bi = n; } }
            if (bi >= 0) sel |= 1u << bi; }
    }
    const bf16* ksrc = ub + (mb + lane) * INP + UK + h * HD + wid * 8;
    const bf16* vsrc = ub + (mb + 16 * (wid & 3) + (lane >> 2)) * INP + UV + h * HD + (wid >> 2) * 32 + (lane & 3) * 8;
    const int stoff = wid * 1024 + lane * 16;
    const int NTILE = 4 * (qb + 1);
    v4u kreg, vreg;
    kreg = *(const GAS v4u*)(ksrc); vreg = *(const GAS v4u*)(vsrc);
    __syncthreads();
    *(LAS v4u*)(L + AT_K + stoff) = kreg; *(LAS v4u*)(L + AT_V + stoff) = vreg;
    __syncthreads();
    float mrun = -INFINITY, lrun = 0.f; f32x16 o[2]; o[0] = f32x16{}; o[1] = f32x16{};
    const float c31 = tab[128];
    for (int jt = 0; jt < NTILE; ++jt) {
        const int cur = jt & 1;
        if (jt + 1 < NTILE) { kreg = *(const GAS v4u*)(ksrc + (size_t)(jt + 1) * 64 * INP); vreg = *(const GAS v4u*)(vsrc + (size_t)(jt + 1) * 64 * INP); }
        const int n = jt >> 2;
        const int dbase = 256 * (qb - n) + 32 * wid - 64 * (jt & 3);
        const bool lane_ok = (n == qb) || ((sel >> n) & 1u);
        const bool wave_live = (dbase + 31 >= 0) && __any(lane_ok);
        if (wave_live) {
            f32x16 p0 = {}, p1 = {};
            const LAS unsigned char* kb = L + AT_K + cur * 8192 + hi * 1024 + r32 * 16;
#pragma unroll
            for (int d0 = 0; d0 < 4; ++d0) { const bf16x8 b0 = *(const LAS bf16x8*)(kb + d0 * 2048); const bf16x8 b1 = *(const LAS bf16x8*)(kb + d0 * 2048 + 512);
                p0 = __builtin_amdgcn_mfma_f32_32x32x16_bf16(b0, qr[d0], p0, 0, 0, 0); p1 = __builtin_amdgcn_mfma_f32_32x32x16_bf16(b1, qr[d0], p1, 0, 0, 0); }
            const bool far = (dbase - 63 >= 128);
            const int dl = dbase + r32;
            if (far) {
#pragma unroll
                for (int r = 0; r < 16; ++r) { p0[r] = lane_ok ? p0[r] * C2 + c31 : -INFINITY; p1[r] = lane_ok ? p1[r] * C2 + c31 : -INFINITY; }
            } else {
#pragma unroll
                for (int r = 0; r < 16; ++r) { const int d0_ = dl - crow(r, hi), d1_ = d0_ - 32;
                    const float b0 = tab[min(max(d0_, 0), 128)], b1 = tab[min(max(d1_, 0), 128)];
                    p0[r] = (lane_ok && d0_ >= 0) ? p0[r] * C2 + b0 : -INFINITY; p1[r] = (lane_ok && d1_ >= 0) ? p1[r] * C2 + b1 : -INFINITY; }
            }
            float rm = fmaxf(p0[0], p1[0]);
#pragma unroll
            for (int r = 1; r < 16; ++r) rm = fmaxf(rm, fmaxf(p0[r], p1[r]));
            rm = swapmax(rm);
            const float mnew = fmaxf(mrun, rm);
            const float msafe = (mnew == -INFINITY) ? 0.f : mnew;
            const float alpha = __builtin_amdgcn_exp2f(mrun - msafe);
            mrun = mnew;
            float ps = 0.f;
#pragma unroll
            for (int r = 0; r < 16; ++r) { p0[r] = __builtin_amdgcn_exp2f(p0[r] - msafe); p1[r] = __builtin_amdgcn_exp2f(p1[r] - msafe); ps += p0[r] + p1[r]; }
            lrun = lrun * alpha + ps;
            if (__any(alpha != 1.f)) {
                if (hi == 0) wsf[r32] = alpha;
                LDS_WAIT(); asm volatile("" ::: "memory");
#pragma unroll
                for (int r = 0; r < 16; ++r) { const float f = wsf[crow(r, hi)]; o[0][r] *= f; o[1][r] *= f; }
                asm volatile("" ::: "memory");
            }
            v4u pw[4];
            pw[0] = (v4u){cvtpk(p0[0], p0[1]), cvtpk(p0[2], p0[3]), cvtpk(p0[4], p0[5]), cvtpk(p0[6], p0[7])};
            pw[1] = (v4u){cvtpk(p0[8], p0[9]), cvtpk(p0[10], p0[11]), cvtpk(p0[12], p0[13]), cvtpk(p0[14], p0[15])};
            pw[2] = (v4u){cvtpk(p1[0], p1[1]), cvtpk(p1[2], p1[3]), cvtpk(p1[4], p1[5]), cvtpk(p1[6], p1[7])};
            pw[3] = (v4u){cvtpk(p1[8], p1[9]), cvtpk(p1[10], p1[11]), cvtpk(p1[12], p1[13]), cvtpk(p1[14], p1[15])};
            const LAS unsigned char* vb = L + AT_V + cur * 8192 + ((lane >> 4) & 1) * 32 + (lane & 3) * 8 + (4 * hi + ((lane & 15) >> 2)) * 64;
#pragma unroll
            for (int d0 = 0; d0 < 2; ++d0)
#pragma unroll
                for (int ks = 0; ks < 4; ++ks) { const s16x4 lo = vtr(vb + d0 * 4096 + ks * 1024), hh = vtr(vb + d0 * 4096 + ks * 1024 + 512);
                    const bf16x8 vf = (bf16x8){lo[0], lo[1], lo[2], lo[3], hh[0], hh[1], hh[2], hh[3]};
                    o[d0] = __builtin_amdgcn_mfma_f32_32x32x16_bf16(__builtin_bit_cast(bf16x8, pw[ks]), vf, o[d0], 0, 0, 0); }
        }
        if (jt + 1 < NTILE) { *(LAS v4u*)(L + AT_K + (cur ^ 1) * 8192 + stoff) = kreg; *(LAS v4u*)(L + AT_V + (cur ^ 1) * 8192 + stoff) = vreg; }
        __syncthreads();
    }
    lrun = swapsum(lrun);
    if (hi == 0) wsf[32 + r32] = lrun;
    LDS_WAIT(); asm volatile("" ::: "memory");
    LAS bf16* stg = (LAS bf16*)(L + AT_OST) + wid * 2048;
#pragma unroll
    for (int r = 0; r < 16; ++r) { const int orow = crow(r, hi); const float rl = 1.f / wsf[32 + orow];
        stg[orow * 64 + r32] = (bf16)f2bf(o[0][r] * rl); stg[orow * 64 + 32 + r32] = (bf16)f2bf(o[1][r] * rl); }
    LDS_WAIT(); asm volatile("" ::: "memory");
    bf16* Ow = mix + (mb + q0 + wid * 32) * DM + h * HD;
#pragma unroll
    for (int i = 0; i < 4; ++i) { const int row = i * 8 + (lane >> 3), ch = lane & 7; const v4u v = *(const LAS v4u*)(stg + row * 64 + ch * 8); *(GAS v4u*)(Ow + (size_t)row * DM + ch * 8) = v; }
}

__device__ __forceinline__ void attn_queue(Frame& F, unsigned* head) {
    volatile LAS unsigned* slot = (volatile LAS unsigned*)(F.lds + MISC_OFF + 64);
    for (;;) {
        __syncthreads();
        if (F.tid == 0) *slot = __hip_atomic_fetch_add(head, 1u, __ATOMIC_RELAXED, __HIP_MEMORY_SCOPE_AGENT);
        __syncthreads();
        const unsigned u = *slot;
        if (u >= 512u) break;
        const int bh = (int)(u & 31u), qb = 15 - (int)(u >> 5);
        attn_unit(F, bh >> 4, bh & 15, qb);
    }
}

#ifndef REP_PHASE
#define REP_PHASE -1
#endif
#ifndef REP_EXTRA
#define REP_EXTRA 1
#endif
#ifndef MK_PER_PHASE
#define MK_PER_PHASE 0
#endif
constexpr int NPHASE = 15;
__global__ void __launch_bounds__(NT, 2) hymba_fwd(Args args) {
    extern __shared__ __attribute__((aligned(16))) unsigned char lds[];
    Frame F;
    F.lds = (LAS unsigned char*)lds;
    F.tid = threadIdx.x; F.lane = F.tid & 63; F.wave = __builtin_amdgcn_readfirstlane(F.tid >> 6);
    F.G = gridDim.x; F.bid = blockIdx.x; F.in = args.in; F.hz = args.out; F.ws = args.ws;
    volatile LAS unsigned* MISC = (volatile LAS unsigned*)(F.lds + MISC_OFF);
    for (int u = F.tid; u < (LDS_BYTES - LDSCTL_OFF) / 4; u += NT) ((LAS unsigned*)(F.lds + LDSCTL_OFF))[u] = 0u;
    __syncthreads();
    gu32* ctl = (gu32*)(F.ws + WS_CTL);
    XcdBarrier bar; bar.bar = (unsigned*)(ctl + CW_BAR); bar.x = 0; bar.st = nullptr;
    if (!MK_PER_PHASE) bar = xcd_barrier_post((unsigned*)(ctl + CW_BAR), MISC + 8);
    const int lo = args.ph_lo, hi = args.ph_hi;
#define IN(k) (lo <= (k) && (k) < hi)
#define SEAM(k) do { if (IN(k) && IN((k) + 1)) xcd_barrier(bar); } while (0)
    bf16* const Wgu = (bf16*)(F.ws + WS_WGU); bf16* const Wd = (bf16*)(F.ws + WS_WD); bf16* const Win = (bf16*)(F.ws + WS_WIN); bf16* const Wout = (bf16*)(F.ws + WS_WOUT);
    bf16* const Wpg = (bf16*)(F.ws + WS_WPG); bf16* const Wpu = (bf16*)(F.ws + WS_WPU);
    bf16* const XB = (bf16*)(F.ws + WS_XB); bf16* const BIG = (bf16*)(F.ws + WS_BIG); bf16* const MIX = (bf16*)(F.ws + WS_MIX); bf16* const EB = (bf16*)(F.ws + WS_SCAN); bf16* const PB = (bf16*)(F.ws + WS_PB);

    if (IN(0)) {
        int base = 0;
        ffn_weights(F, 2, 3, 4, base);
        transpose_job(F, F.in[7], DM, DM, INC, Win, DM, 0, base);
        transpose_job(F, F.in[20], DM, DM, DM, Wout, DM, 0, base);
        transpose_job(F, F.in[29], DM, DM, DM, Wpg, DM, 0, base);
        transpose_job(F, F.in[28], PLE, PLE, DM, Wpu, PLE, 0, base);
        transpose_job(F, F.in[11], 64, 64, RW, (bf16*)(F.ws + WS_SMALL + SM_W2T), 64, 0, base);
        transpose_job(F, F.in[13], 64, 64, RW, (bf16*)(F.ws + WS_SMALL + SM_A2T), 64, 0, base);
        transpose_job(F, F.in[14], 160, 192, RW, (bf16*)(F.ws + WS_SMALL + SM_G2T), 192, 0, base);
        convert_bf16(F, F.in[0], XB, (size_t)M * DM);
        convert_bf16(F, F.in[1], PB, (size_t)M * PLE);
    }
    SEAM(0);
    if (IN(1)) { pg8::Gemm g{XB, Wgu, M, NGU, DM}; pg8::StaticOrder S; S.init(M, NGU, F.G, F.bid); pg8::EpiSwiGLU E{BIG, DFF};
        pg8::gemm_phase<pg8::EpiSwiGLU, pg8::StaticOrder, true, true>(F.lds, g, S, E); }
    SEAM(1);
    if (IN(2)) { pg8::Gemm g{BIG, Wd, M, DM, DFF}; pg8::StaticOrder S; S.init(M, DM, F.G, F.bid); pg8::EpiResid E{F.in[0], F.hz, DM, ALPHA, 0.5f};
        pg8::gemm_phase<pg8::EpiResid, pg8::StaticOrder, true, true>(F.lds, g, S, E); }
    SEAM(2);
    if (IN(3)) { ln_phase<true>(F, F.hz, F.in[5], F.in[6], XB); int base = 0; ffn_weights(F, 23, 24, 25, base); }
    SEAM(3);
    if (IN(4)) { pg8::Gemm g{XB, Win, M, INP, DM}; pg8::StaticOrder S; S.init(M, INP, F.G, F.bid); pg8::EpiBf16<0> E{BIG, INP, nullptr, 0, 0, 1.f};
        pg8::gemm_phase<pg8::EpiBf16<0>, pg8::StaticOrder, true, true>(F.lds, g, S, E); }
    SEAM(4);
    if (IN(5)) { kmean_tasks(F); for (int t = F.bid; t < M / 32; t += F.G) prep_tile(F, t); }
    SEAM(5);
    if (IN(6)) {
        for (int t = F.bid; t < 128; t += F.G) scan_task(F, t);
        attn_queue(F, (unsigned*)(ctl + CW_QUEUE));
    }
    SEAM(6);
    if (MK_PER_PHASE && lo == 15 && F.bid < 128) scan_task(F, F.bid);
    if (MK_PER_PHASE && lo == 16) attn_queue(F, (unsigned*)(ctl + CW_QUEUE) + 64);
    if (IN(7)) rw_finalize(F);
    SEAM(7);
    if (IN(8)) { { pg8::Gemm g{MIX, Wout, M, DM, DM}; pg8::StaticOrder S; S.init(M, DM, F.G, F.bid); pg8::EpiResid E{F.hz, F.hz, DM, ALPHA, 1.0f};
          pg8::gemm_phase<pg8::EpiResid, pg8::StaticOrder, true, true>(F.lds, g, S, E); }
        { pg8::Gemm g{PB, Wpu, M, DM, PLE}; pg8::StaticOrder S; S.init(M, DM, F.G, F.bid); pg8::EpiBf16<0> E{EB, DM, nullptr, 0, 0, 1.f};
          pg8::gemm_phase<pg8::EpiBf16<0>, pg8::StaticOrder, true, true>(F.lds, g, S, E); } }
    SEAM(8);
    if (IN(9)) ln_phase<true>(F, F.hz, F.in[21], F.in[22], XB);
    SEAM(9);
    if (IN(10)) { pg8::Gemm g{XB, Wgu, M, NGU, DM}; pg8::StaticOrder S; S.init(M, NGU, F.G, F.bid); pg8::EpiSwiGLU E{BIG, DFF};
        pg8::gemm_phase<pg8::EpiSwiGLU, pg8::StaticOrder, true, true>(F.lds, g, S, E); }
    SEAM(10);
    if (IN(11)) { pg8::Gemm g{BIG, Wd, M, DM, DFF}; pg8::StaticOrder S; S.init(M, DM, F.G, F.bid); pg8::EpiResid E{F.hz, F.hz, DM, ALPHA, 0.5f};
        pg8::gemm_phase<pg8::EpiResid, pg8::StaticOrder, true, true>(F.lds, g, S, E); }
    SEAM(11);
    if (IN(12)) ln_phase<true>(F, F.hz, F.in[26], F.in[27], XB);
    SEAM(12);
    if (IN(13)) { pg8::Gemm g{XB, Wpg, M, DM, DM}; pg8::StaticOrder S; S.init(M, DM, F.G, F.bid); pg8::EpiPle E{F.hz, F.hz, EB, F.in[30], DM, ALPHA};
        pg8::gemm_phase<pg8::EpiPle, pg8::StaticOrder, true, true>(F.lds, g, S, E); }
    SEAM(13);
    if (IN(14)) {
        if (!MK_PER_PHASE && xb_ld((unsigned*)(ctl + CW_BAR) + XB_TMO) != 0u) {
            const float q = __builtin_nanf(""); for (size_t i = (size_t)F.bid * NT + F.tid; i < (size_t)M * DM; i += (size_t)F.G * NT) F.hz[i] = q;
        } else ln_phase<false>(F, F.hz, F.in[31], F.in[32], nullptr);
    }
#undef IN
#undef SEAM
}

extern "C" void kernel_launch(void* const* d_in, const int* in_sizes, int n_in, void* d_out, int out_size, void* d_ws, size_t ws_size, hipStream_t stream) {
    static int grid = 0;
    if (grid == 0) {
        if (n_in != 33 || out_size != M * DM || ws_size < WS_END) { fprintf(stderr, "kernel_launch: unexpected problem (n_in %d out %d ws %zu, need %zu); nothing launched\n", n_in, out_size, ws_size, (size_t)WS_END); grid = -1; return; }
        int dev = 0, cus = 0;
        if (hipGetDevice(&dev) != hipSuccess || hipDeviceGetAttribute(&cus, hipDeviceAttributeMultiprocessorCount, dev) != hipSuccess) { grid = -1; return; }
        if (hipFuncSetAttribute((const void*)hymba_fwd, hipFuncAttributeMaxDynamicSharedMemorySize, LDS_BYTES) != hipSuccess) { fprintf(stderr, "kernel_launch: hipFuncSetAttribute failed\n"); grid = -1; return; }
        grid = cus > 0 ? cus : 256;
        fprintf(stderr, "kernel_launch: grid %d, ws %zu\n", grid, ws_size);
    }
    if (grid < 0) return;
    (void)hipMemsetAsync((char*)d_ws + WS_CTL, 0, CTL_ZERO_BYTES, stream);
    Args a{};
    for (int i = 0; i < 33; ++i) a.in[i] = (const float*)d_in[i];
    a.out = (float*)d_out; a.ws = (unsigned char*)d_ws;
#if MK_PER_PHASE
    for (int p = 0; p < NPHASE; ++p) { a.ph_lo = p; a.ph_hi = p + 1; const int reps = (p == REP_PHASE) ? 1 + REP_EXTRA : 1;
        for (int r = 0; r < reps; ++r) hipLaunchKernelGGL(hymba_fwd, dim3(grid), dim3(NT), LDS_BYTES, stream, a);
        if (p == 6 && REP_PHASE >= 15) { a.ph_lo = REP_PHASE; a.ph_hi = REP_PHASE + 1; hipLaunchKernelGGL(hymba_fwd, dim3(grid), dim3(NT), LDS_BYTES, stream, a); } }
#else
    a.ph_lo = 0; a.ph_hi = NPHASE;
    hipLaunchKernelGGL(hymba_fwd, dim3(grid), dim3(NT), LDS_BYTES, stream, a);
#endif
}
```

```cpp
#include <hip/hip_runtime.h>
#include <cstdio>
#include <cstdint>
namespace pg8 {
#define PG8_LAS __attribute__((address_space(3)))
typedef unsigned short bf16_t;
typedef short bf16x8 __attribute__((ext_vector_type(8)));
typedef float f32x4 __attribute__((ext_vector_type(4)));
typedef unsigned u32x4 __attribute__((ext_vector_type(4)));
constexpr int BM = 256, BK = 64, HALF = 128, HTB = HALF * BK * 2  , STAGE_BYTES = 8 * HTB, NXCD = 8, WGM = 8;

__host__ __device__ __forceinline__ int lds_byte(int r, int c) { const int st = (r >> 4) * 2 + (c >> 5), rr = r & 15, cc = c & 31, ob = rr * 64 + cc * 2; return st * 1024 + (ob ^ (((ob >> 9) & 1) << 5)); }
__host__ __device__ __forceinline__ void stage_rc(int b, int& R, int& C) { const int st = b / 1024, sb = b % 1024, swz = sb ^ (((sb >> 9) & 1) << 5); R = (st >> 1) * 16 + swz / 64; C = (st & 1) * 32 + (swz % 64) / 2; }
__host__ __device__ __forceinline__ int perm32(int rho) { const int n = rho >> 4, i = rho & 15; return 8 * (i >> 2) + 4 * n + (i & 3); }

struct Unit { int pm, pn; };
struct Gemm { const bf16_t* A; const bf16_t* Bt; int M, N, K; };

struct StaticOrder {
    int nM, nN, nwg, G, c;
    __host__ __device__ void init(int M, int N, int G_, int c_) { nM = M / BM; nN = N / BM; nwg = nM * nN; G = G_; c = c_; }
    __host__ __device__ bool next(int i, Unit& u) const {
        const long L = (long)i * G + c; if (L >= nwg) return false;
        int wgid = (int)L; { const int q = nwg / NXCD, r = nwg % NXCD, xcd = wgid % NXCD, off = wgid / NXCD; wgid = (xcd < r ? xcd * (q + 1) : r * (q + 1) + (xcd - r) * q) + off; }
        const int nig = WGM * nN, gid = wgid / nig, fm = gid * WGM, gsz = (nM - fm) < WGM ? (nM - fm) : WGM;
        u.pm = fm + ((wgid % nig) % gsz); u.pn = (wgid % nig) / gsz; return true;
    }
    __device__ __forceinline__ void a_ready(const Unit&) const {}
    __device__ __forceinline__ void done(const Unit&) const {}
};

__device__ __forceinline__ unsigned cvt_pk_bf16(float lo, float hi) { unsigned r; asm volatile("v_cvt_pk_bf16_f32 %0, %1, %2" : "=v"(r) : "v"(lo), "v"(hi)); return r; }
typedef float f32x2 __attribute__((ext_vector_type(2)));
__device__ __forceinline__ f32x2 gelu_pk(f32x2 v) {
    const f32x2 av = __builtin_elementwise_abs(v), d = av * 0.2316418882f + 1.0f;
    f32x2 t; t.x = __builtin_amdgcn_rcpf(d.x); t.y = __builtin_amdgcn_rcpf(d.y);
    f32x2 q = t * 0.5307027145f + (-0.7265760135f); q = q * t + 0.7107068705f; q = q * t + (-0.142248368f); q = q * t + 0.127414796f; q = q * t;
    const f32x2 s = (v * v) * (-0.72134752044f);
    f32x2 e; e.x = __builtin_amdgcn_exp2f(s.x); e.y = __builtin_amdgcn_exp2f(s.y);
    const f32x2 m = v * (q * e), r = v - m;
    f32x2 o; o.x = v.x < 0.f ? m.x : r.x; o.y = v.y < 0.f ? m.y : r.y; return o;
}

template <int ACT  > struct EpiBf16 {
    static constexpr bool PERM = true, AFTER_DRAIN = false; static_assert(ACT == 0 || ACT == 1, "EpiBf16: ACT is 0 (none) or 1 (gelu_pk)");
    bf16_t* O; int ldc; const float* bias; int split_cols; size_t split_stride; float scale0;
    __device__ __forceinline__ void operator()(const f32x4 (&acc)[2][2][4][2], const Unit& u, int wr, int wc, int fr, int fq) const {
        const int row0 = u.pm * BM + wr * 64 + fr; int colt = u.pn * BM; bf16_t* base = O;
        float sc = 1.f; if (split_cols) { const int t = colt / split_cols; base += (size_t)t * split_stride; colt -= t * split_cols; if (t == 0) sc = scale0; }
        const int col0 = colt + wc * 32 + 8 * fq, bcol0 = u.pn * BM + wc * 32 + 8 * fq;
        f32x4 bv[2][2];
#pragma unroll
        for (int bj = 0; bj < 2; ++bj)
#pragma unroll
            for (int n = 0; n < 2; ++n) bv[bj][n] = bias ? *(const f32x4*)(bias + bcol0 + bj * HALF + 4 * n) : (f32x4){0.f, 0.f, 0.f, 0.f};
#pragma unroll
        for (int ai = 0; ai < 2; ++ai)
#pragma unroll
            for (int m = 0; m < 4; ++m) { bf16_t* rowp = base + (size_t)(row0 + ai * HALF + m * 16) * ldc + col0;
#pragma unroll
                for (int bj = 0; bj < 2; ++bj) { f32x4 v0 = acc[ai][bj][m][0] + bv[bj][0], v1 = acc[ai][bj][m][1] + bv[bj][1];
                    if (ACT == 1) { f32x2 a = gelu_pk((f32x2){v0[0], v0[1]}), b = gelu_pk((f32x2){v0[2], v0[3]}), c = gelu_pk((f32x2){v1[0], v1[1]}), d = gelu_pk((f32x2){v1[2], v1[3]});
                        v0 = (f32x4){a.x, a.y, b.x, b.y}; v1 = (f32x4){c.x, c.y, d.x, d.y}; }
                    v0 = v0 * sc; v1 = v1 * sc; u32x4 w; w.x = cvt_pk_bf16(v0[0], v0[1]); w.y = cvt_pk_bf16(v0[2], v0[3]); w.z = cvt_pk_bf16(v1[0], v1[1]); w.w = cvt_pk_bf16(v1[2], v1[3]);
                    *(u32x4*)(rowp + bj * HALF) = w; } }
    }
};
__device__ __forceinline__ float sigmoid_f(float x) { return __builtin_amdgcn_rcpf(1.0f + __builtin_amdgcn_exp2f(-1.4426950408889634f * x)); }
struct EpiSwiGLU {
    static constexpr bool PERM = true, AFTER_DRAIN = false;
    bf16_t* O; int ldc;
    __device__ __forceinline__ void operator()(const f32x4 (&acc)[2][2][4][2], const Unit& u, int wr, int wc, int fr, int fq) const {
        const int row0 = u.pm * BM + wr * 64 + fr; const int col0 = u.pn * HALF + wc * 32 + 8 * fq;
#pragma unroll
        for (int ai = 0; ai < 2; ++ai)
#pragma unroll
            for (int m = 0; m < 4; ++m) { bf16_t* rowp = O + (size_t)(row0 + ai * HALF + m * 16) * ldc + col0;
                const f32x4 g0 = acc[ai][0][m][0], g1 = acc[ai][0][m][1], u0 = acc[ai][1][m][0], u1 = acc[ai][1][m][1];
                f32x4 h0, h1;
#pragma unroll
                for (int i = 0; i < 4; ++i) { h0[i] = g0[i] * sigmoid_f(g0[i]) * u0[i]; h1[i] = g1[i] * sigmoid_f(g1[i]) * u1[i]; }
                u32x4 w; w.x = cvt_pk_bf16(h0[0], h0[1]); w.y = cvt_pk_bf16(h0[2], h0[3]); w.z = cvt_pk_bf16(h1[0], h1[1]); w.w = cvt_pk_bf16(h1[2], h1[3]);
                *(u32x4*)rowp = w; }
    }
};
struct EpiResid {
    static constexpr bool PERM = false, AFTER_DRAIN = false;
    const float* base; float* out; int ldc; float alpha, s;
    __device__ __forceinline__ void operator()(const f32x4 (&acc)[2][2][4][2], const Unit& u, int wr, int wc, int fr, int fq) const {
        const int col0 = u.pn * BM + wc * 32 + 4 * fq;
#pragma unroll
        for (int ai = 0; ai < 2; ++ai)
#pragma unroll
            for (int m = 0; m < 4; ++m) { const size_t off = (size_t)(u.pm * BM + ai * HALF + wr * 64 + m * 16 + fr) * ldc + col0;
#pragma unroll
                for (int bj = 0; bj < 2; ++bj)
#pragma unroll
                    for (int n = 0; n < 2; ++n) { const f32x4 bs = *(const f32x4*)(base + off + bj * HALF + n * 16);
                        *(f32x4*)(out + off + bj * HALF + n * 16) = bs * alpha + acc[ai][bj][m][n] * s; }
                if (m & 1) asm volatile("" ::: "memory"); }
    }
};
struct EpiPle {
    static constexpr bool PERM = false, AFTER_DRAIN = false;
    const float* base; float* out; const bf16_t* e; const float* bias; int ldc; float alpha;
    __device__ __forceinline__ void operator()(const f32x4 (&acc)[2][2][4][2], const Unit& u, int wr, int wc, int fr, int fq) const {
        typedef unsigned u32x2v __attribute__((ext_vector_type(2)));
        const int col0 = u.pn * BM + wc * 32 + 4 * fq;
        f32x4 bv[2][2];
#pragma unroll
        for (int bj = 0; bj < 2; ++bj)
#pragma unroll
            for (int n = 0; n < 2; ++n) bv[bj][n] = *(const f32x4*)(bias + col0 + bj * HALF + n * 16);
#pragma unroll
        for (int ai = 0; ai < 2; ++ai)
#pragma unroll
            for (int m = 0; m < 4; ++m) { const size_t off = (size_t)(u.pm * BM + ai * HALF + wr * 64 + m * 16 + fr) * ldc + col0;
#pragma unroll
                for (int bj = 0; bj < 2; ++bj)
#pragma unroll
                    for (int n = 0; n < 2; ++n) { const f32x4 bs = *(const f32x4*)(base + off + bj * HALF + n * 16);
                        const u32x2v ew = *(const u32x2v*)(e + off + bj * HALF + n * 16);
                        f32x4 ev; ev[0] = __uint_as_float(ew.x << 16); ev[1] = __uint_as_float(ew.x & 0xffff0000u); ev[2] = __uint_as_float(ew.y << 16); ev[3] = __uint_as_float(ew.y & 0xffff0000u);
                        const f32x4 a = acc[ai][bj][m][n] + bv[bj][n]; f32x4 o;
#pragma unroll
                        for (int i = 0; i < 4; ++i) o[i] = bs[i] * alpha + sigmoid_f(a[i]) * ev[i];
                        *(f32x4*)(out + off + bj * HALF + n * 16) = o; }
                if (m & 1) asm volatile("" ::: "memory"); }
    }
};
template <class Epi, class Sched, bool ALIGN_EPI = false, bool SP2 = false>
__device__ __forceinline__ void gemm_phase(PG8_LAS unsigned char* lds, const Gemm g, const Sched& S, const Epi& E) {
    const int tid = threadIdx.x, wid = __builtin_amdgcn_readfirstlane(tid >> 6), lane = tid & 63, wr = wid >> 2, wc = wid & 3, fr = lane & 15, fq = lane >> 4;
    const int K = g.K, nt = K / BK;
    unsigned voffA[2], voffB[2];
#pragma unroll
    for (int i = 0; i < 2; ++i) { int R, C; stage_rc(tid * 16 + i * 8192, R, C); const int Rb = Epi::PERM ? ((R & ~31) + perm32(R & 31)) : R;
        voffA[i] = (unsigned)(R * K + C) * 2u; voffB[i] = (unsigned)(Rb * K + C) * 2u; }
    const size_t kstep = (size_t)(BK * 2);
    const size_t hstep = (size_t)HALF * K * 2;
    const size_t tstep = 2 * hstep;
    const unsigned ldsw = (unsigned)wid * 1024u;
    const int aoff = lds_byte(wr * 64 + fr, fq * 8), boff = lds_byte(wc * 32 + fr, fq * 8);
#define PG8_SA(b, h) (((b) * 2 + (h)) * HTB)
#define PG8_SB(b, h) ((4 + (b) * 2 + (h)) * HTB)
#define PG8_STAGE(bufoff, gbase, voff) do { _Pragma("unroll") for (int _i = 0; _i < 2; ++_i) \
        __builtin_amdgcn_global_load_lds((const unsigned*)((const char*)(gbase) + (voff)[_i]), (PG8_LAS unsigned*)(lds + (bufoff) + ldsw + _i * 8192), 16, 0, 0); } while (0)
#define PG8_LDA(dst, b, h) do { _Pragma("unroll") for (int m = 0; m < 4; ++m) _Pragma("unroll") for (int k = 0; k < 2; ++k) dst[m][k] = *(const PG8_LAS bf16x8*)(lds + PG8_SA(b, h) + aoff + m * 2048 + k * 1024); } while (0)
#define PG8_LDB(dst, b, h) do { _Pragma("unroll") for (int n = 0; n < 2; ++n) _Pragma("unroll") for (int k = 0; k < 2; ++k) dst[n][k] = *(const PG8_LAS bf16x8*)(lds + PG8_SB(b, h) + boff + n * 2048 + k * 1024); } while (0)
#define PG8_MMA(ai, bj, At, Bt) do { __builtin_amdgcn_s_setprio(1); _Pragma("unroll") for (int m = 0; m < 4; ++m) _Pragma("unroll") for (int n = 0; n < 2; ++n) _Pragma("unroll") for (int k = 0; k < 2; ++k) \
        acc[ai][bj][m][n] = __builtin_amdgcn_mfma_f32_16x16x32_bf16(Bt[n][k], At[m][k], acc[ai][bj][m][n], 0, 0, 0); __builtin_amdgcn_s_setprio(0); } while (0)
#define PG8_WAIT_V(n) asm volatile("s_waitcnt vmcnt(" #n ")" ::: "memory")
#define PG8_WAIT_L(n) asm volatile("s_waitcnt lgkmcnt(" #n ")" ::: "memory")
#define PG8_BAR __builtin_amdgcn_s_barrier()
#define PG8_SCHED __builtin_amdgcn_sched_barrier(0)
    Unit cur, nxt; int ui = 0;
    if (!S.next(0, cur)) return;
    f32x4 acc[2][2][4][2];
#pragma unroll
    for (int a = 0; a < 2; ++a)
#pragma unroll
        for (int b = 0; b < 2; ++b)
#pragma unroll
            for (int m = 0; m < 4; ++m)
#pragma unroll
                for (int n = 0; n < 2; ++n) acc[a][b][m][n] = (f32x4){0.f, 0.f, 0.f, 0.f};
    bf16x8 At[4][2], B0[2][2], B1[2][2];
    const char* cA = (const char*)g.A + (size_t)cur.pm * tstep; const char* cB = (const char*)g.Bt + (size_t)cur.pn * tstep;
    S.a_ready(cur);
    if constexpr (SP2) {
        PG8_STAGE(PG8_SB(0, 0), cB, voffB); PG8_STAGE(PG8_SB(0, 1), cB + hstep, voffB); PG8_STAGE(PG8_SA(0, 0), cA, voffA); PG8_STAGE(PG8_SA(0, 1), cA + hstep, voffA);
        if (wr == 1) PG8_BAR;
        PG8_WAIT_V(2); PG8_BAR;
        PG8_STAGE(PG8_SB(1, 0), cB + kstep, voffB); PG8_STAGE(PG8_SA(1, 0), cA + kstep, voffA); PG8_STAGE(PG8_SB(1, 1), cB + hstep + kstep, voffB);
        PG8_WAIT_V(6); PG8_BAR;
    } else {
        PG8_STAGE(PG8_SB(0, 0), cB, voffB); PG8_STAGE(PG8_SA(0, 0), cA, voffA); PG8_STAGE(PG8_SB(0, 1), cB + hstep, voffB); PG8_STAGE(PG8_SA(0, 1), cA + hstep, voffA);
        if (wr == 1) PG8_BAR;
        PG8_WAIT_V(4); PG8_BAR;
        PG8_STAGE(PG8_SB(1, 0), cB + kstep, voffB); PG8_STAGE(PG8_SA(1, 0), cA + kstep, voffA); PG8_STAGE(PG8_SB(1, 1), cB + hstep + kstep, voffB);
        PG8_WAIT_V(6); PG8_BAR;
    }
    for (;;) {
        const bool has_next = S.next(ui + 1, nxt);
        const char* nA = has_next ? (const char*)g.A + (size_t)nxt.pm * tstep : cA; const char* nB = has_next ? (const char*)g.Bt + (size_t)nxt.pn * tstep : cB;
        for (int t = 0; t < nt; t += 2) {
            const bool last = (t == nt - 2);
            const char* a1 = cA + (size_t)(t + 1) * kstep;
            const char* a2 = last ? nA : cA + (size_t)(t + 2) * kstep; const char* b2 = last ? nB : cB + (size_t)(t + 2) * kstep;
            const char* a3 = a2 + kstep; const char* b3 = b2 + kstep;
            if (last && has_next) S.a_ready(nxt);
            if constexpr (SP2) {
            PG8_LDB(B0, 0, 0); PG8_LDB(B1, 0, 1); PG8_SCHED; PG8_LDA(At, 0, 0); PG8_STAGE(PG8_SA(1, 1), a1 + hstep, voffA);
            PG8_WAIT_V(8); PG8_WAIT_L(0); PG8_BAR; PG8_MMA(0, 0, At, B0); PG8_MMA(0, 1, At, B1); PG8_BAR; PG8_SCHED;
            PG8_LDA(At, 0, 1); PG8_STAGE(PG8_SB(0, 0), b2, voffB); PG8_STAGE(PG8_SB(0, 1), b2 + hstep, voffB); PG8_STAGE(PG8_SA(0, 0), a2, voffA);
            PG8_WAIT_V(8); PG8_WAIT_L(0); PG8_BAR; PG8_MMA(1, 0, At, B0); PG8_MMA(1, 1, At, B1); PG8_BAR; PG8_SCHED;
            PG8_LDB(B0, 1, 0); PG8_LDB(B1, 1, 1); PG8_SCHED; PG8_LDA(At, 1, 0); PG8_STAGE(PG8_SA(0, 1), a2 + hstep, voffA);
            PG8_WAIT_V(8); PG8_WAIT_L(0); PG8_BAR; PG8_MMA(0, 0, At, B0); PG8_MMA(0, 1, At, B1); PG8_BAR; PG8_SCHED;
            PG8_LDA(At, 1, 1); PG8_STAGE(PG8_SB(1, 0), b3, voffB); PG8_STAGE(PG8_SB(1, 1), b3 + hstep, voffB); PG8_STAGE(PG8_SA(1, 0), a3, voffA);
            PG8_WAIT_V(8); PG8_WAIT_L(0); PG8_BAR; PG8_MMA(1, 0, At, B0); PG8_MMA(1, 1, At, B1); PG8_BAR; PG8_SCHED;
            } else {
            PG8_LDB(B0, 0, 0); PG8_SCHED; PG8_LDA(At, 0, 0); PG8_STAGE(PG8_SA(1, 1), a1 + hstep, voffA);
            PG8_WAIT_L(8); PG8_BAR; PG8_WAIT_L(0); PG8_MMA(0, 0, At, B0); PG8_BAR; PG8_SCHED;
            PG8_LDB(B1, 0, 1); PG8_STAGE(PG8_SB(0, 0), b2, voffB);
            PG8_BAR; PG8_WAIT_L(0); PG8_MMA(0, 1, At, B1); PG8_BAR;
            PG8_LDA(At, 0, 1); PG8_STAGE(PG8_SA(0, 0), a2, voffA);
            PG8_BAR; PG8_WAIT_L(0); PG8_MMA(1, 0, At, B0); PG8_BAR; PG8_SCHED;
            PG8_STAGE(PG8_SB(0, 1), b2 + hstep, voffB);
            PG8_WAIT_V(6); PG8_BAR; PG8_MMA(1, 1, At, B1); PG8_BAR;
            PG8_LDB(B0, 1, 0); PG8_SCHED; PG8_LDA(At, 1, 0); PG8_STAGE(PG8_SA(0, 1), a2 + hstep, voffA);
            PG8_WAIT_L(8); PG8_BAR; PG8_WAIT_L(0); PG8_MMA(0, 0, At, B0); PG8_BAR; PG8_SCHED;
            PG8_LDB(B1, 1, 1); PG8_STAGE(PG8_SB(1, 0), b3, voffB);
            PG8_BAR; PG8_WAIT_L(0); PG8_MMA(0, 1, At, B1); PG8_BAR;
            PG8_LDA(At, 1, 1); PG8_STAGE(PG8_SA(1, 0), a3, voffA);
            PG8_BAR; PG8_WAIT_L(0); PG8_MMA(1, 0, At, B0); PG8_BAR; PG8_SCHED;
            PG8_STAGE(PG8_SB(1, 1), b3 + hstep, voffB);
            PG8_WAIT_V(6); PG8_BAR; PG8_MMA(1, 1, At, B1); PG8_BAR;
            }
        }
        if constexpr (ALIGN_EPI) { if (wr == 0) PG8_BAR; }
        if constexpr (!Epi::AFTER_DRAIN) { E(acc, cur, wr, wc, fr, fq); S.done(cur); }
        if (!has_next) break;
#pragma unroll
        for (int a = 0; a < 2; ++a)
#pragma unroll
            for (int b = 0; b < 2; ++b)
#pragma unroll
                for (int m = 0; m < 4; ++m)
#pragma unroll
                    for (int n = 0; n < 2; ++n) acc[a][b][m][n] = (f32x4){0.f, 0.f, 0.f, 0.f};
        cur = nxt; cA = nA; cB = nB; ++ui;
        if constexpr (ALIGN_EPI) { if (wr == 1) PG8_BAR; }
    }
    PG8_WAIT_V(0);
    if constexpr (!ALIGN_EPI) { if (wr == 0) PG8_BAR; }
    PG8_BAR;
    if constexpr (Epi::AFTER_DRAIN) { E.fused(acc, cur, wr, wc, fr, fq, lds, wid, lane); S.done(cur); }
#undef PG8_SA
#undef PG8_SB
#undef PG8_STAGE
#undef PG8_LDA
#undef PG8_LDB
#undef PG8_MMA
#undef PG8_WAIT_V
#undef PG8_WAIT_L
#undef PG8_BAR
#undef PG8_SCHED
}
}

constexpr int NWAVES = 8, NT = NWAVES * 64;
constexpr int BATCH = 2, SEQ = 4096, DM = 2048, M = BATCH * SEQ;
constexpr int DFF = 5632, NGU = 2 * DFF;
constexpr int INC = 6432, INP = 6656;
constexpr int AW = 1024, RW = 1024, NH = 16, HD = 64;
constexpr int PLE = 256;
constexpr int UQ = 0, UK = 1024, UV = 2048, UR = 3072;
constexpr float LN_EPS = 1e-5f, GN_EPS = 64e-5f;
constexpr float ALPHA = 1.189207115002721f;
constexpr float LOG2E = 1.4426950408889634f;

constexpr size_t MiB = 1u << 20;
constexpr size_t WS_CTL = 0, CTL_ZERO_BYTES = 1 * MiB;
constexpr size_t WS_WGU = 2 * MiB;
constexpr size_t WS_WD = 46 * MiB;
constexpr size_t WS_WIN = 68 * MiB;
constexpr size_t WS_WOUT = 94 * MiB;
constexpr size_t WS_WPG = 102 * MiB;
constexpr size_t WS_WPU = 110 * MiB;
constexpr size_t WS_SMALL = 111 * MiB;
constexpr size_t WS_XB = 112 * MiB;
constexpr size_t WS_BIG = 144 * MiB;
constexpr size_t WS_MIX = 248 * MiB;
constexpr size_t WS_SCAN = 280 * MiB;
constexpr size_t WS_PB = 392 * MiB;
constexpr size_t WS_END = 396 * MiB;
constexpr size_t SM_W2T = 0, SM_A2T = 131072, SM_G2T = 262144, SM_KMEAN = 655360;
constexpr size_t WS_BONUS = 1 * MiB;
static_assert(SM_G2T + 1024 * 192 * 2 <= SM_KMEAN && SM_KMEAN + 2 * 16 * 16 * 64 * 2 <= MiB, "small map");
constexpr int CW_TMO = 0, CW_BAR = 4096, CW_QUEUE = 8192;

constexpr int RING_BYTES = 131072;
constexpr int LDSCTL_OFF = RING_BYTES, MISC_OFF = LDSCTL_OFF + 320;
constexpr int LDS_BYTES = 147456;

#define GAS __attribute__((address_space(1)))
#define LAS __attribute__((address_space(3)))
typedef unsigned short bf16;
typedef unsigned v4u __attribute__((ext_vector_type(4)));
typedef unsigned v2u __attribute__((ext_vector_type(2)));
typedef float f32x4 __attribute__((ext_vector_type(4)));
typedef float f32x16 __attribute__((ext_vector_type(16)));
typedef short bf16x8 __attribute__((ext_vector_type(8)));
typedef short s16x4 __attribute__((ext_vector_type(4)));
typedef GAS unsigned gu32;
#define RLX_AGENT __ATOMIC_RELAXED, __HIP_MEMORY_SCOPE_AGENT
#define LDS_WAIT() asm volatile("s_waitcnt lgkmcnt(0)" ::: "memory")
#define VM_WAIT() asm volatile("s_waitcnt vmcnt(0)" ::: "memory")
__device__ __forceinline__ unsigned f2bf(float f) { unsigned u = __builtin_bit_cast(unsigned, f); return (u + 0x7fffu + ((u >> 16) & 1u)) >> 16; }
__device__ __forceinline__ unsigned pk2(float lo, float hi) { return f2bf(lo) | (f2bf(hi) << 16); }
__device__ __forceinline__ float bf2f(unsigned short b) { return __uint_as_float((unsigned)b << 16); }
__device__ __forceinline__ float bflo(unsigned w) { return __uint_as_float(w << 16); }
__device__ __forceinline__ float bfhi(unsigned w) { return __uint_as_float(w & 0xffff0000u); }

#define XB_TMO      128
#define XB_XCNT(j)  (256  + 64 * (j))
#define XB_XSUB(j)  (1280 + 64 * (j))
#define XB_XGEN(j)  (2304 + 64 * (j))
#define XB_TOP      3328
#define XB_TOPGEN   3392
#define XCD_BAR_WORDS 3456
#define XB_SPIN_CAP (1u << 18)
__device__ __forceinline__ unsigned xb_ld(unsigned* p)              { return __hip_atomic_load(p, __ATOMIC_RELAXED, __HIP_MEMORY_SCOPE_AGENT); }
__device__ __forceinline__ unsigned xb_add(unsigned* p, unsigned v) { return __hip_atomic_fetch_add(p, v, __ATOMIC_RELAXED, __HIP_MEMORY_SCOPE_AGENT); }
__device__ __forceinline__ unsigned xb_xcc_id() { return (unsigned)__builtin_amdgcn_s_getreg((3 << 11) | 20) & 0xFu; }
#define XB_SPIN(cond, bar) do { unsigned _sp = 0; while (cond) { __builtin_amdgcn_s_sleep(1); \
    if ((++_sp & 255u) == 0u) { if (xb_ld(&(bar)[XB_TMO])) break; if (_sp > XB_SPIN_CAP) { atomicAdd(&(bar)[XB_TMO], 1u); break; } } } } while (0)
struct XcdBarrier { unsigned* bar; unsigned x; volatile LAS unsigned* st; };
__device__ __forceinline__ XcdBarrier xcd_barrier_post(unsigned* bar, volatile LAS unsigned* st) {
    XcdBarrier b; b.bar = bar; b.x = xb_xcc_id(); b.st = st;
    if (threadIdx.x == 0) (void)xb_add(&bar[XB_XCNT(b.x)], 1u);
    return b;
}
__device__ __forceinline__ void xcd_barrier_complete(unsigned* bar, unsigned x, unsigned& nloc, unsigned& nx) {
    const unsigned G = gridDim.x * gridDim.y * gridDim.z;
    unsigned sum, cnt, mine, sp = 0u;
    for (;;) {
        sum = 0u; cnt = 0u; mine = 0u;
#pragma unroll
        for (unsigned j = 0; j < 16; ++j) { const unsigned c = xb_ld(&bar[XB_XCNT(j)]); sum += c; cnt += (c > 0u) ? 1u : 0u; mine = (j == x) ? c : mine; }
        if (sum == G) break;
        __builtin_amdgcn_s_sleep(1);
        if ((++sp & 255u) == 0u) { if (xb_ld(&bar[XB_TMO])) break; if (sp > XB_SPIN_CAP) { atomicAdd(&bar[XB_TMO], 1u); break; } }
    }
    nloc = mine > 0u ? mine : 1u; nx = cnt > 0u ? cnt : 1u;
}
__device__ __forceinline__ void xcd_barrier(const XcdBarrier& b) {
    asm volatile("s_waitcnt vmcnt(0)" ::: "memory");
    __syncthreads();
    if (threadIdx.x == 0) {
        unsigned* bar = b.bar;
        __builtin_amdgcn_s_waitcnt(0);
        unsigned nloc = b.st[0], nx = b.st[1];
        if (nloc == 0u) { xcd_barrier_complete(bar, b.x, nloc, nx); b.st[0] = nloc; b.st[1] = nx; }
        const unsigned old = xb_add(&bar[XB_XSUB(b.x)], 1u);
        const unsigned gen = old / nloc;
        if (old + 1u == (gen + 1u) * nloc) {
            __builtin_amdgcn_fence(__ATOMIC_RELEASE, "agent");
            asm volatile("s_waitcnt vmcnt(0)" ::: "memory");
            const unsigned og = xb_add(&bar[XB_TOP], 1u);
            const unsigned tg = og / nx;
            if (og + 1u == (tg + 1u) * nx) xb_add(&bar[XB_TOPGEN], 1u);
            else XB_SPIN(xb_ld(&bar[XB_TOPGEN]) == tg, bar);
            __builtin_amdgcn_fence(__ATOMIC_ACQUIRE, "agent");
            xb_add(&bar[XB_XGEN(b.x)], 1u);
            asm volatile("s_waitcnt vmcnt(0)" ::: "memory");
        } else {
            XB_SPIN(xb_ld(&bar[XB_XGEN(b.x)]) == gen, bar);
            __builtin_amdgcn_fence(__ATOMIC_ACQUIRE, "agent");
            asm volatile("s_waitcnt vmcnt(0)" ::: "memory");
        }
    }
    __syncthreads();
}

struct Args { const float* in[33]; float* out; unsigned char* ws; int ph_lo, ph_hi; };
struct Frame {
    LAS unsigned char* lds;
    int tid, lane, wave, G, bid;
    const float* const* in;
    float* hz;
    unsigned char* ws;
};
__device__ __forceinline__ float wave_sum(float v) {
#pragma unroll
    for (int o = 1; o < 64; o <<= 1) v += __shfl_xor(v, o);
    return v;
}

struct TrItem { f32x4 v[8]; };
__device__ __forceinline__ void tr_load(TrItem& T, const float* W, int Kvalid, int N, int k0, int n0, int lane) {
#pragma unroll
    for (int i = 0; i < 8; ++i) { const int kk = (lane >> 3) + 8 * i; T.v[i] = (f32x4){0.f, 0.f, 0.f, 0.f}; if (k0 + kk < Kvalid) T.v[i] = *(const GAS f32x4*)(W + (size_t)(k0 + kk) * N + n0 + 4 * (lane & 7)); }
}
__device__ __forceinline__ void tr_store(const TrItem& T, bf16* WT, int ldo, int orow0, LAS float* scr, int k0, int lane) {
#pragma unroll
    for (int i = 0; i < 8; ++i) { const int kk = (lane >> 3) + 8 * i; LAS float* d = scr + kk * 33 + 4 * (lane & 7); d[0] = T.v[i][0]; d[1] = T.v[i][1]; d[2] = T.v[i][2]; d[3] = T.v[i][3]; }
    LDS_WAIT(); asm volatile("" ::: "memory");
    const int c = lane & 7;
#pragma unroll
    for (int j = 0; j < 4; ++j) { const int n = (lane >> 3) + 8 * j; const LAS float* s = scr + (8 * c) * 33 + n;
        v4u o; o.x = pk2(s[0 * 33], s[1 * 33]); o.y = pk2(s[2 * 33], s[3 * 33]); o.z = pk2(s[4 * 33], s[5 * 33]); o.w = pk2(s[6 * 33], s[7 * 33]);
        *(GAS v4u*)(WT + (size_t)(orow0 + n) * ldo + k0 + 8 * c) = o; }
    LDS_WAIT(); asm volatile("" ::: "memory");
}
__device__ __forceinline__ void transpose_job(Frame& F, const float* W, int Kvalid, int Kpad, int N, bf16* WT, int ldo, int mode, int& base) {
    LAS float* scr = (LAS float*)(F.lds + F.wave * 16384);
    const int gw = F.bid * NWAVES + F.wave, NGW = F.G * NWAVES;
    const int nblk = N / 32, items = (Kpad / 64) * nblk;
    const int first = (gw - base % NGW + NGW) % NGW;
#define TR_DECODE(it, k0_, n0_, orow_) const int k0_ = 64 * ((it) / nblk), n0_ = 32 * ((it) % nblk), orow_ = (mode == 0) ? n0_ : ((n0_ >> 7) * 256 + (mode == 2 ? 128 : 0) + (n0_ & 127))
    TrItem A, B;
    int it = first;
    if (it < items) { TR_DECODE(it, k0, n0, orow); (void)orow; tr_load(A, W, Kvalid, N, k0, n0, F.lane); }
    while (it < items) {
        { const int nx = it + NGW; if (nx < items) { TR_DECODE(nx, k1, n1, orow1); (void)orow1; tr_load(B, W, Kvalid, N, k1, n1, F.lane); }
          TR_DECODE(it, k0, n0, orow); (void)n0; tr_store(A, WT, ldo, orow, scr, k0, F.lane); it = nx; }
        if (it >= items) break;
        { const int nx = it + NGW; if (nx < items) { TR_DECODE(nx, k1, n1, orow1); (void)orow1; tr_load(A, W, Kvalid, N, k1, n1, F.lane); }
          TR_DECODE(it, k0, n0, orow); (void)n0; tr_store(B, WT, ldo, orow, scr, k0, F.lane); it = nx; }
    }
#undef TR_DECODE
    base += items;
}
__device__ __forceinline__ void convert_bf16(Frame& F, const float* src, bf16* dst, size_t n) {
    const size_t gt = (size_t)F.bid * NT + F.tid, NGT = (size_t)F.G * NT, n8 = n / 8;
    for (size_t i = gt; i < n8; i += 4 * NGT) { f32x4 a[4], b[4];
#pragma unroll
        for (int u = 0; u < 4; ++u) if (i + u * NGT < n8) { a[u] = *(const GAS f32x4*)(src + (i + u * NGT) * 8); b[u] = *(const GAS f32x4*)(src + (i + u * NGT) * 8 + 4); }
#pragma unroll
        for (int u = 0; u < 4; ++u) if (i + u * NGT < n8) { v4u o; o.x = pk2(a[u][0], a[u][1]); o.y = pk2(a[u][2], a[u][3]); o.z = pk2(b[u][0], b[u][1]); o.w = pk2(b[u][2], b[u][3]); *(GAS v4u*)(dst + (i + u * NGT) * 8) = o; } }
}
__device__ __forceinline__ void ffn_weights(Frame& F, int gi, int ui, int di, int& base) {
    transpose_job(F, F.in[gi], DM, DM, DFF, (bf16*)(F.ws + WS_WGU), DM, 1, base);
    transpose_job(F, F.in[ui], DM, DM, DFF, (bf16*)(F.ws + WS_WGU), DM, 2, base);
    transpose_job(F, F.in[di], DFF, DFF, DM, (bf16*)(F.ws + WS_WD), DFF, 0, base);
}

template <bool WRITE_BF16>
__device__ __forceinline__ void ln_phase(Frame& F, float* hz, const float* g, const float* b, bf16* hb) {
    const int gw = F.bid * NWAVES + F.wave, NGW = F.G * NWAVES;
    f32x4 gv[8], bv[8];
#pragma unroll
    for (int j = 0; j < 8; ++j) { gv[j] = *(const GAS f32x4*)(g + F.lane * 4 + 256 * j); bv[j] = *(const GAS f32x4*)(b + F.lane * 4 + 256 * j); }
    for (int m = gw; m < M; m += NGW) {
        GAS f32x4* xr = (GAS f32x4*)(hz + (size_t)m * DM) + F.lane;
        f32x4 v[8]; float s = 0.f;
#pragma unroll
        for (int j = 0; j < 8; ++j) { v[j] = xr[64 * j]; s += (v[j][0] + v[j][1]) + (v[j][2] + v[j][3]); }
        const float mean = wave_sum(s) * (1.f / DM); float s2 = 0.f;
#pragma unroll
        for (int j = 0; j < 8; ++j) { v[j] = v[j] - mean; s2 += (v[j][0] * v[j][0] + v[j][1] * v[j][1]) + (v[j][2] * v[j][2] + v[j][3] * v[j][3]); }
        const float rstd = 1.f / sqrtf(wave_sum(s2) * (1.f / DM) + LN_EPS);
#pragma unroll
        for (int j = 0; j < 8; ++j) { v[j] = v[j] * rstd * gv[j] + bv[j]; xr[64 * j] = v[j]; }
        if (WRITE_BF16) { GAS v2u* o8 = (GAS v2u*)(hb + (size_t)m * DM) + F.lane;
#pragma unroll
            for (int j = 0; j < 8; ++j) { v2u w; w.x = pk2(v[j][0], v[j][1]); w.y = pk2(v[j][2], v[j][3]); o8[64 * j] = w; } }
    }
}

__device__ __forceinline__ int crow(int r, int hi) { return (r & 3) + 8 * (r >> 2) + 4 * hi; }
__device__ __forceinline__ float red32(float v) {
#pragma unroll
    for (int o = 1; o < 32; o <<= 1) v += __shfl_xor(v, o);
    return v;
}
__device__ __forceinline__ void kmean_tasks(Frame& F) {
    const bf16* ub = (const bf16*)(F.ws + WS_BIG); bf16* km = (bf16*)(F.ws + WS_SMALL + SM_KMEAN);
    const int gw = F.bid * NWAVES + F.wave, NGW = F.G * NWAVES;
    for (int task = gw; task < BATCH * 16 * NH; task += NGW) {
        const int b = task >> 8, blk = (task >> 4) & 15, h = task & 15;
        const bf16* p = ub + (size_t)(b * SEQ + blk * 256) * INP + UK + h * HD + F.lane;
        float s0 = 0.f, s1 = 0.f, s2 = 0.f, s3 = 0.f;
#pragma unroll 4
        for (int i = 0; i < 256; i += 4) { s0 += bf2f(p[(size_t)i * INP]); s1 += bf2f(p[(size_t)(i + 1) * INP]); s2 += bf2f(p[(size_t)(i + 2) * INP]); s3 += bf2f(p[(size_t)(i + 3) * INP]); }
        km[((b * NH + h) * 16 + blk) * HD + F.lane] = (bf16)f2bf(((s0 + s1) + (s2 + s3)) * (1.f / 256.f));
    }
}
__device__ __forceinline__ void shifted4(const bf16* ucol  , bool first_is_seq_start, float mix, float (&o)[4]) {
    float pv = first_is_seq_start ? 0.f : bf2f(*(ucol - INP));
#pragma unroll
    for (int i = 0; i < 4; ++i) { const float c = bf2f(ucol[(size_t)i * INP]); o[i] = c + (pv - c) * mix; pv = c; }
}
constexpr int PA_W = 0, PA_A = 4608, PA_G = 9216, PA_PITCH = 144, PG_PITCH = 400;
__device__ __forceinline__ void prep_tile(Frame& F, int tile) {
    const bf16* ub = (const bf16*)(F.ws + WS_BIG);
    const int m0 = tile * 32;
    const float* shift_mix = F.in[9];
    LAS unsigned char* L = F.lds;
    for (int idx = F.tid; idx < 32 * 288; idx += NT) {
        const int t = idx / 288, k = idx - t * 288, m = m0 + t;
        const bf16* up = ub + (size_t)m * INP + UR + 3072 + k;
        const float cur = bf2f(*up), prev = ((m & (SEQ - 1)) == 0) ? 0.f : bf2f(*(up - INP));
        const float us = cur + (prev - cur) * shift_mix[3072 + k];
        if (k < 64) { const float e2 = __expf(2.f * us); *(LAS bf16*)(L + PA_W + t * PA_PITCH + k * 2) = (bf16)f2bf(1.f - 2.f / (e2 + 1.f)); }
        else if (k < 128) *(LAS bf16*)(L + PA_A + t * PA_PITCH + (k - 64) * 2) = (bf16)f2bf(us);
        else *(LAS bf16*)(L + PA_G + t * PG_PITCH + (k - 128) * 2) = (bf16)f2bf(1.f / (1.f + __expf(-us)));
    }
    for (int idx = F.tid; idx < 32 * 32; idx += NT) *(LAS bf16*)(L + PA_G + (idx >> 5) * PG_PITCH + (160 + (idx & 31)) * 2) = 0;
    __syncthreads();
    const bf16* w2t = (const bf16*)(F.ws + WS_SMALL + SM_W2T); const bf16* a2t = (const bf16*)(F.ws + WS_SMALL + SM_A2T); const bf16* g2t = (const bf16*)(F.ws + WS_SMALL + SM_G2T);
    const float *w0 = F.in[10], *a0 = F.in[12], *k_k = F.in[15], *k_a = F.in[16], *r_k = F.in[17];
    bf16* SR = (bf16*)(F.ws + WS_SCAN); bf16* SE = SR + (size_t)M * RW; bf16* SKP = SE + (size_t)M * RW; bf16* SV = SKP + (size_t)M * RW;
    bf16* SKK = SV + (size_t)M * RW; bf16* SBB = SKK + (size_t)M * RW; bf16* SGG = SBB + (size_t)M * RW;
    float* bonus = (float*)(F.ws + WS_BONUS);
    const int r32 = F.lane & 31, hi = F.lane >> 5;
    const bool seq0 = (m0 & (SEQ - 1)) == 0;
    for (int hp = 0; hp < 2; ++hp) {
        const int head = 2 * F.wave + hp;
        float n2[16], bon[16];
#pragma unroll
        for (int r = 0; r < 16; ++r) { n2[r] = 0.f; bon[r] = 0.f; }
        for (int nt = 0; nt < 2; ++nt) {
            const int c = head * 64 + 32 * nt + r32;
            f32x16 accA = {};
#pragma unroll
            for (int ks = 0; ks < 4; ++ks) { const bf16x8 af = *(const LAS bf16x8*)(L + PA_A + r32 * PA_PITCH + (16 * ks + 8 * hi) * 2); const bf16x8 bfr = *(const GAS bf16x8*)(a2t + c * 64 + 16 * ks + 8 * hi);
                accA = __builtin_amdgcn_mfma_f32_32x32x16_bf16(af, bfr, accA, 0, 0, 0); }
            const float a0c = a0[c], kkc = k_k[c], kac = k_a[c], rkc = r_k[c], mixr = shift_mix[c], mixk = shift_mix[1024 + c];
#pragma unroll
            for (int g = 0; g < 4; ++g) { const int tb = 8 * g + 4 * hi; float rr[4], kr[4];
                shifted4(ub + (size_t)(m0 + tb) * INP + UR + c, seq0 && tb == 0, mixr, rr);
                shifted4(ub + (size_t)(m0 + tb) * INP + UR + 1024 + c, seq0 && tb == 0, mixk, kr);
#pragma unroll
                for (int i = 0; i < 4; ++i) { const int r = 4 * g + i; const float a = 1.f / (1.f + __expf(-(a0c + accA[r])));
                    const float kq = kr[i] * kkc; n2[r] += kq * kq; bon[r] += rr[i] * kr[i] * (1.f + (a - 1.f) * kac) * rkc; } }
        }
        float inv[16];
#pragma unroll
        for (int r = 0; r < 16; ++r) { const float s = red32(n2[r]); inv[r] = 1.f / fmaxf(sqrtf(s), 1e-12f); bon[r] = red32(bon[r]); }
        if (r32 == 0) {
#pragma unroll
            for (int r = 0; r < 16; ++r) bonus[(size_t)(m0 + crow(r, hi)) * NH + head] = bon[r]; }
        for (int nt = 0; nt < 2; ++nt) {
            const int c = head * 64 + 32 * nt + r32;
            f32x16 accA = {}, accW = {}, accG = {};
#pragma unroll
            for (int ks = 0; ks < 4; ++ks) { const bf16x8 af = *(const LAS bf16x8*)(L + PA_A + r32 * PA_PITCH + (16 * ks + 8 * hi) * 2); const bf16x8 bfr = *(const GAS bf16x8*)(a2t + c * 64 + 16 * ks + 8 * hi);
                accA = __builtin_amdgcn_mfma_f32_32x32x16_bf16(af, bfr, accA, 0, 0, 0);
                const bf16x8 wf = *(const LAS bf16x8*)(L + PA_W + r32 * PA_PITCH + (16 * ks + 8 * hi) * 2); const bf16x8 bw = *(const GAS bf16x8*)(w2t + c * 64 + 16 * ks + 8 * hi);
                accW = __builtin_amdgcn_mfma_f32_32x32x16_bf16(wf, bw, accW, 0, 0, 0); }
#pragma unroll
            for (int ks = 0; ks < 12; ++ks) { const bf16x8 gf = *(const LAS bf16x8*)(L + PA_G + r32 * PG_PITCH + (16 * ks + 8 * hi) * 2); const bf16x8 bg = *(const GAS bf16x8*)(g2t + c * 192 + 16 * ks + 8 * hi);
                accG = __builtin_amdgcn_mfma_f32_32x32x16_bf16(gf, bg, accG, 0, 0, 0); }
            const float a0c = a0[c], w0c = w0[c], kkc = k_k[c], kac = k_a[c], mixr = shift_mix[c], mixk = shift_mix[1024 + c], mixv = shift_mix[2048 + c];
#pragma unroll
            for (int g = 0; g < 4; ++g) { const int tb = 8 * g + 4 * hi; float rr[4], kr[4], vr[4];
                shifted4(ub + (size_t)(m0 + tb) * INP + UR + c, seq0 && tb == 0, mixr, rr);
                shifted4(ub + (size_t)(m0 + tb) * INP + UR + 1024 + c, seq0 && tb == 0, mixk, kr);
                shifted4(ub + (size_t)(m0 + tb) * INP + UR + 2048 + c, seq0 && tb == 0, mixv, vr);
#pragma unroll
                for (int i = 0; i < 4; ++i) { const int r = 4 * g + i; const size_t o = (size_t)(m0 + tb + i) * RW + c;
                    const float a = 1.f / (1.f + __expf(-(a0c + accA[r])));
                    const float x = -(w0c + accW[r]);
                    const float sp = fmaxf(x, 0.f) + __logf(1.f + __expf(-fabsf(x)));
                    const float e = __expf(-sp - 0.5f);
                    const float kk = kr[i] * kkc * inv[r], kp = kr[i] * (1.f + (a - 1.f) * kac);
                    SR[o] = (bf16)f2bf(rr[i]); SE[o] = (bf16)f2bf(e); SKP[o] = (bf16)f2bf(kp); SV[o] = (bf16)f2bf(vr[i]);
                    SKK[o] = (bf16)f2bf(kk); SBB[o] = (bf16)f2bf(kk * a); SGG[o] = (bf16)f2bf(accG[r]); } }
        }
    }
    __syncthreads();
}

__device__ __forceinline__ s16x4 vtr(const LAS unsigned char* p) { typedef short v4i16_t __attribute__((ext_vector_type(4))); return __builtin_bit_cast(s16x4, __builtin_amdgcn_ds_read_tr16_b64_v4i16((LAS v4i16_t*)p)); }
constexpr int CP = 144, CMB = 64 * CP;
enum { C_AT = 0, C_BT, C_KT, C_RT, C_BP, C_KP, C_VV, C_Q0, C_Q1, C_X0, C_X1, C_AK, C_BR, C_KR, C_NSLOT };
static_assert(C_NSLOT * CMB <= RING_BYTES, "chunk pre-pass LDS");
constexpr int C_SMALL = 132096;
constexpr size_t CH_UNIT = 32768, CH_TT = 0, CH_PT = 8192, CH_HT = 16384, CH_YV = 24576;
__device__ __forceinline__ bf16x8 trfrag(const LAS unsigned char* Mt, int k0, int c0, int lane) {
    const LAS unsigned char* p = Mt + (k0 + 8 * (lane >> 5) + ((lane & 15) >> 2)) * CP + (c0 + 16 * ((lane >> 4) & 1) + 4 * (lane & 3)) * 2;
    const s16x4 lo = vtr(p), hh = vtr(p + 4 * CP);
    return (bf16x8){lo[0], lo[1], lo[2], lo[3], hh[0], hh[1], hh[2], hh[3]};
}
template <bool A_TR, bool B_TR>
__device__ __forceinline__ f32x16 tile_mm(const LAS unsigned char* A, int r0, const LAS unsigned char* B, int c0, f32x16 acc, int lane) {
    const int r32 = lane & 31, hi = lane >> 5;
#pragma unroll
    for (int ks = 0; ks < 4; ++ks) {
        const bf16x8 af = A_TR ? trfrag(A, 16 * ks, r0, lane) : *(const LAS bf16x8*)(A + (r0 + r32) * CP + (16 * ks + 8 * hi) * 2);
        const bf16x8 bf = B_TR ? trfrag(B, 16 * ks, c0, lane) : *(const LAS bf16x8*)(B + (c0 + r32) * CP + (16 * ks + 8 * hi) * 2);
        acc = __builtin_amdgcn_mfma_f32_32x32x16_bf16(af, bf, acc, 0, 0, 0);
    }
    return acc;
}
__device__ __forceinline__ void tile_store_lds(LAS unsigned char* Z, int r0, int c0, const f32x16& v, int lane) {
    const int r32 = lane & 31, hi = lane >> 5;
#pragma unroll
    for (int r = 0; r < 16; ++r) *(LAS bf16*)(Z + (r0 + crow(r, hi)) * CP + (c0 + r32) * 2) = (bf16)f2bf(v[r]);
}
__device__ __forceinline__ void tile_store_glb_t(bf16* G, int r0, int c0, const f32x16& v, int lane) {
    const int r32 = lane & 31, hi = lane >> 5;
#pragma unroll
    for (int g = 0; g < 4; ++g) { v2u w; w.x = pk2(v[4 * g], v[4 * g + 1]); w.y = pk2(v[4 * g + 2], v[4 * g + 3]);
        *(GAS v2u*)(G + (size_t)(c0 + r32) * 64 + r0 + 8 * g + 4 * hi) = w; }
}
__device__ __forceinline__ void chunk_prepass(Frame& F, int unit) {
    const int bh = unit >> 6, c = unit & 63, b = bh >> 4, h = bh & 15;
    const size_t m0 = (size_t)b * SEQ + (size_t)c * 64;
    const bf16* SR = (const bf16*)(F.ws + WS_SCAN);
    LAS unsigned char* L = F.lds;
    LAS float* totals = (LAS float*)(L + C_SMALL); LAS float* gend = totals + 512;
    bf16* CH = (bf16*)(F.ws + WS_WGU + (size_t)unit * CH_UNIT);
    const int lane = F.lane, w = F.wave, r32 = lane & 31, hi = lane >> 5;
    {
        const int j = F.tid & 63, tg = F.tid >> 6;
        float r_[8], e_[8], kp_[8], v_[8], kk_[8], bb_[8];
#pragma unroll
        for (int i = 0; i < 8; ++i) { const size_t o = (m0 + 8 * tg + i) * RW + h * HD + j;
            r_[i] = bf2f(SR[o]); e_[i] = bf2f(SR[(size_t)M * RW + o]); kp_[i] = bf2f(SR[(size_t)2 * M * RW + o]); v_[i] = bf2f(SR[(size_t)3 * M * RW + o]);
            kk_[i] = bf2f(SR[(size_t)4 * M * RW + o]); bb_[i] = bf2f(SR[(size_t)5 * M * RW + o]); }
        float cs[8]; cs[0] = e_[0];
#pragma unroll
        for (int i = 1; i < 8; ++i) cs[i] = cs[i - 1] + e_[i];
        totals[tg * 64 + j] = cs[7];
        __syncthreads();
        float pre = 0.f, tot = 0.f;
#pragma unroll
        for (int g = 0; g < 8; ++g) { const float t_ = totals[g * 64 + j]; tot += t_; if (g < tg) pre += t_; }
        if (tg == 0) gend[j] = __expf(-tot);
#pragma unroll
        for (int i = 0; i < 8; ++i) { const int t = 8 * tg + i; const float ct = pre + cs[i];
            const float Gt = __expf(-ct), Gp = __expf(-(ct - e_[i])), iG = __expf(ct), gE = __expf(ct - tot);
            const int o = t * CP + j * 2;
            *(LAS bf16*)(L + C_AT * CMB + o) = (bf16)f2bf(-kk_[i] * Gp);
            *(LAS bf16*)(L + C_BT * CMB + o) = (bf16)f2bf(bb_[i] * iG);
            *(LAS bf16*)(L + C_KT * CMB + o) = (bf16)f2bf(kp_[i] * iG);
            *(LAS bf16*)(L + C_RT * CMB + o) = (bf16)f2bf(r_[i] * Gt);
            *(LAS bf16*)(L + C_BP * CMB + o) = (bf16)f2bf(bb_[i] * gE);
            *(LAS bf16*)(L + C_KP * CMB + o) = (bf16)f2bf(kp_[i] * gE);
            *(LAS bf16*)(L + C_VV * CMB + o) = (bf16)f2bf(v_[i]);
            *(LAS bf16*)(L + C_X0 * CMB + o) = (t == j) ? (bf16)0x3f80 : (bf16)0; }
        __syncthreads();
    }
    {
        const int p = w >> 1, tr = w & 1;
        const LAS unsigned char* A = L + ((p & 1) ? C_KT : C_BT) * CMB; const LAS unsigned char* B = L + ((p >> 1) ? C_RT : C_AT) * CMB;
        LAS unsigned char* Z = L + (p == 0 ? C_Q0 : p == 1 ? C_AK : p == 2 ? C_BR : C_KR) * CMB;
#pragma unroll
        for (int tc = 0; tc < 2; ++tc) { f32x16 acc = {};
            if (tr <= tc) { acc = tile_mm<false, false>(A, 32 * tr, B, 32 * tc, acc, lane);
#pragma unroll
                for (int r = 0; r < 16; ++r) { const int s_ = 32 * tr + crow(r, hi), t_ = 32 * tc + r32; const bool keep = (p < 2) ? (s_ < t_) : (s_ <= t_); acc[r] = keep ? acc[r] : 0.f; } }
            tile_store_lds(Z, 32 * tr, 32 * tc, acc, lane); }
        __syncthreads();
    }
    {
        const int tr = (w >> 1) & 1, tc = w & 1; f32x16 xacc = {};
        if (w < 4 && tr == tc) {
#pragma unroll
            for (int r = 0; r < 16; ++r) xacc[r] = (crow(r, hi) == r32) ? 1.f : 0.f; }
#pragma unroll 1
        for (int k = 0; k < 6; ++k) {
            const LAS unsigned char* Xc = L + ((k & 1) ? C_X1 : C_X0) * CMB; const LAS unsigned char* Qc = L + ((k & 1) ? C_Q1 : C_Q0) * CMB;
            LAS unsigned char* Xn = L + ((k & 1) ? C_X0 : C_X1) * CMB; LAS unsigned char* Qn = L + ((k & 1) ? C_Q0 : C_Q1) * CMB;
            if (w < 4) { if (tr <= tc) xacc = tile_mm<false, true>(Xc, 32 * tr, Qc, 32 * tc, xacc, lane);
                tile_store_lds(Xn, 32 * tr, 32 * tc, xacc, lane); }
            else if (k < 5) { f32x16 q = {}; if (tr <= tc) q = tile_mm<false, true>(Qc, 32 * tr, Qc, 32 * tc, q, lane);
                tile_store_lds(Qn, 32 * tr, 32 * tc, q, lane); }
            __syncthreads();
        }
    }
    {
        const int tr = (w >> 1) & 1, tc = w & 1; f32x16 acc = {};
        if (w < 4) { acc = tile_mm<true, true>(L + C_AT * CMB, 32 * tr, L + C_X0 * CMB, 32 * tc, acc, lane); tile_store_lds(L + C_BT * CMB, 32 * tr, 32 * tc, acc, lane); }
        else { if (tr <= tc) acc = tile_mm<false, true>(L + C_AK * CMB, 32 * tr, L + C_X0 * CMB, 32 * tc, acc, lane); tile_store_lds(L + C_KT * CMB, 32 * tr, 32 * tc, acc, lane); }
        __syncthreads();
    }
    {
        const int p = w >> 1, tr = w & 1;
        const LAS unsigned char* A = L + ((p & 1) ? C_KT : C_BT) * CMB; const LAS unsigned char* B = L + ((p >> 1) ? C_BR : C_BP) * CMB;
#pragma unroll
        for (int tc = 0; tc < 2; ++tc) { f32x16 acc = {};
            acc = tile_mm<false, true>(A, 32 * tr, B, 32 * tc, acc, lane);
            if (p == 0) {
#pragma unroll
                for (int r = 0; r < 16; ++r) if (32 * tr + crow(r, hi) == 32 * tc + r32) acc[r] += gend[32 * tc + r32];
                tile_store_glb_t(CH + CH_TT / 2, 32 * tr, 32 * tc, acc, lane);
            } else if (p == 1) {
#pragma unroll
                for (int r = 0; r < 16; ++r) acc[r] += bf2f(*(const LAS bf16*)(L + C_KP * CMB + (32 * tr + crow(r, hi)) * CP + (32 * tc + r32) * 2));
                tile_store_lds(L + C_Q0 * CMB, 32 * tr, 32 * tc, acc, lane);
            } else if (p == 2) {
#pragma unroll
                for (int g = 0; g < 4; ++g) { const v2u rw_ = *(const LAS v2u*)(L + C_RT * CMB + (32 * tc + r32) * CP + (32 * tr + 8 * g + 4 * hi) * 2);
                    acc[4 * g] += bflo(rw_.x); acc[4 * g + 1] += bfhi(rw_.x); acc[4 * g + 2] += bflo(rw_.y); acc[4 * g + 3] += bfhi(rw_.y); }
                tile_store_glb_t(CH + CH_PT / 2, 32 * tr, 32 * tc, acc, lane);
            } else {
#pragma unroll
                for (int r = 0; r < 16; ++r) acc[r] += bf2f(*(const LAS bf16*)(L + C_KR * CMB + (32 * tr + crow(r, hi)) * CP + (32 * tc + r32) * 2));
                tile_store_lds(L + C_Q1 * CMB, 32 * tr, 32 * tc, acc, lane);
            } }
        __syncthreads();
    }
    {
        const int tr = (w >> 1) & 1, tc = w & 1; f32x16 acc = {};
        acc = tile_mm<true, true>(L + C_VV * CMB, 32 * tr, L + ((w < 4) ? C_Q0 : C_Q1) * CMB, 32 * tc, acc, lane);
        tile_store_glb_t(CH + ((w < 4) ? CH_HT : CH_YV) / 2, 32 * tr, 32 * tc, acc, lane);
        __syncthreads();
    }
}
__device__ __forceinline__ void chunk_scan(Frame& F, int bh) {
    const int b = bh >> 4, h = bh & 15;
    LAS unsigned char* L = F.lds;
    float* Y = (float*)(F.ws + WS_XB);
    const int lane = F.lane, w = F.wave, r32 = lane & 31, hi = lane >> 5;
    const int tr = (w >> 1) & 1, tc = w & 1; const bool isS = w < 4;
    for (int i = F.tid; i < 2 * CMB / 4; i += NT) ((LAS unsigned*)L)[i] = 0u;
    const bf16* CHb = (const bf16*)(F.ws + WS_WGU + (size_t)(bh * 64) * CH_UNIT);
    const bf16* Bsrc = CHb + (isS ? CH_TT : CH_PT) / 2 + (size_t)(32 * tc + r32) * 64 + 8 * hi;
    const bf16* Csrc = CHb + (isS ? CH_HT : CH_YV) / 2 + (size_t)(32 * tc + r32) * 64 + 32 * tr + 4 * hi;
    bf16x8 bf0[4], bf1[4], bf2[4], bf3[4]; v2u ci0[4], ci1[4], ci2[4], ci3[4];
#define CS_LOAD(BF, CI, cc) do { _Pragma("unroll") for (int ks = 0; ks < 4; ++ks) BF[ks] = *(const GAS bf16x8*)(Bsrc + (size_t)(cc) * (CH_UNIT / 2) + 16 * ks); \
        _Pragma("unroll") for (int g = 0; g < 4; ++g) CI[g] = *(const GAS v2u*)(Csrc + (size_t)(cc) * (CH_UNIT / 2) + 8 * g); } while (0)
#define CS_STEP(BF, CI, c) do { \
        const LAS unsigned char* Sc = L + ((c) & 1) * CMB; LAS unsigned char* Sn = L + (((c) & 1) ^ 1) * CMB; \
        f32x16 acc; \
        _Pragma("unroll") for (int g = 0; g < 4; ++g) { acc[4 * g] = bflo(CI[g].x); acc[4 * g + 1] = bfhi(CI[g].x); acc[4 * g + 2] = bflo(CI[g].y); acc[4 * g + 3] = bfhi(CI[g].y); } \
        _Pragma("unroll") for (int ks = 0; ks < 4; ++ks) acc = __builtin_amdgcn_mfma_f32_32x32x16_bf16(trfrag(Sc, 16 * ks, 32 * tr, lane), BF[ks], acc, 0, 0, 0); \
        if ((c) + 4 < 64) CS_LOAD(BF, CI, (c) + 4); \
        if (isS) { \
            _Pragma("unroll") for (int g = 0; g < 4; ++g) { v2u o; o.x = pk2(acc[4 * g], acc[4 * g + 1]); o.y = pk2(acc[4 * g + 2], acc[4 * g + 3]); \
                *(LAS v2u*)(Sn + (32 * tc + r32) * CP + (32 * tr + 8 * g + 4 * hi) * 2) = o; } \
        } else { \
            float* yp = Y + ((size_t)b * SEQ + (size_t)(c) * 64 + 32 * tc + r32) * RW + h * HD + 32 * tr + 4 * hi; \
            _Pragma("unroll") for (int g = 0; g < 4; ++g) *(GAS f32x4*)(yp + 8 * g) = (f32x4){acc[4 * g], acc[4 * g + 1], acc[4 * g + 2], acc[4 * g + 3]}; \
        } \
        asm volatile("s_waitcnt lgkmcnt(0)" ::: "memory"); __builtin_amdgcn_s_barrier(); asm volatile("" ::: "memory"); } while (0)
    CS_LOAD(bf0, ci0, 0); CS_LOAD(bf1, ci1, 1); CS_LOAD(bf2, ci2, 2); CS_LOAD(bf3, ci3, 3);
    __syncthreads();
#pragma unroll 1
    for (int c = 0; c < 64; c += 4) { CS_STEP(bf0, ci0, c); CS_STEP(bf1, ci1, c + 1); CS_STEP(bf2, ci2, c + 2); CS_STEP(bf3, ci3, c + 3); }
    __syncthreads();
#undef CS_STEP
#undef CS_LOAD
}
__device__ __forceinline__ void rw_finalize(Frame& F) {
    const int gw = F.bid * NWAVES + F.wave, NGW = F.G * NWAVES;
    const float* Y = (const float*)(F.ws + WS_XB); const bf16* SV = (const bf16*)(F.ws + WS_SCAN) + (size_t)3 * M * RW; const bf16* SGG = (const bf16*)(F.ws + WS_SCAN) + (size_t)6 * M * RW;
    const float* bonus = (const float*)(F.ws + WS_BONUS); bf16* mix = (bf16*)(F.ws + WS_MIX);
    const float *gn_g = F.in[18], *gn_b = F.in[19];
    for (int m = gw; m < M; m += NGW) {
        for (int h = 0; h < NH; ++h) { const int c = h * HD + F.lane; const size_t o = (size_t)m * RW + c;
            const float y = Y[o]; const float mu = wave_sum(y) * (1.f / HD); const float d = y - mu; const float var = wave_sum(d * d) * (1.f / HD);
            const float yn = d * (1.f / sqrtf(var + GN_EPS)) * gn_g[c] + gn_b[c];
            const float val = (yn + bonus[(size_t)m * NH + h] * bf2f(SV[o])) * bf2f(SGG[o]);
            mix[(size_t)m * DM + AW + c] = (bf16)f2bf(val); }
    }
}

constexpr int AT_K = 0, AT_V = 16384, AT_WS = 32768, AT_GATE = 34816, AT_TAB = 51200, AT_OST = 52224, AT_BYTES = AT_OST + 8 * 4096;
__device__ __forceinline__ int rel_bucket_i(int d) {
    if (d < 16) return d;
    return 16 + (d >= 19) + (d >= 21) + (d >= 24) + (d >= 27) + (d >= 31) + (d >= 35) + (d >= 40) + (d >= 46) + (d >= 52) + (d >= 59) + (d >= 67) + (d >= 77) + (d >= 87) + (d >= 99) + (d >= 113);
}
__device__ __forceinline__ unsigned cvtpk(float lo, float hi) { typedef float f2 __attribute__((ext_vector_type(2))); typedef __bf16 b2 __attribute__((ext_vector_type(2))); f2 v = {lo, hi}; b2 b = __builtin_convertvector(v, b2); return __builtin_bit_cast(unsigned, b); }
__device__ __forceinline__ float swapmax(float m) { auto rr = __builtin_amdgcn_permlane32_swap(__float_as_uint(m), __float_as_uint(m), false, false); return fmaxf(__uint_as_float(rr[0]), __uint_as_float(rr[1])); }
__device__ __forceinline__ float swapsum(float m) { auto rr = __builtin_amdgcn_permlane32_swap(__float_as_uint(m), __float_as_uint(m), false, false); return __uint_as_float(rr[0]) + __uint_as_float(rr[1]); }

__device__ __forceinline__ void attn_unit(Frame& F, int b, int h, int qb) {
    const bf16* ub = (const bf16*)(F.ws + WS_BIG); const bf16* km = (const bf16*)(F.ws + WS_SMALL + SM_KMEAN); bf16* mix = (bf16*)(F.ws + WS_MIX);
    const float* rel_bias = F.in[8];
    LAS unsigned char* L = F.lds;
    const int lane = F.lane, wid = F.wave, r32 = lane & 31, hi = lane >> 5;
    const size_t mb = (size_t)b * SEQ;
    const int q0 = qb * 256;
    LAS float* tab = (LAS float*)(L + AT_TAB);
    LAS float* wsf = (LAS float*)(L + AT_WS) + wid * 64;
    constexpr float C2 = 0.125f * LOG2E;
    if (F.tid < 129) tab[F.tid] = rel_bias[rel_bucket_i(F.tid) * NH + h] * LOG2E;
    bf16x8 qr[4];
    { const bf16* Qw = ub + (mb + q0 + wid * 32 + r32) * INP + UQ + h * HD;
#pragma unroll
      for (int d0 = 0; d0 < 4; ++d0) qr[d0] = *(const GAS bf16x8*)(Qw + d0 * 16 + hi * 8); }
    unsigned sel = 0u;
    if (qb > 0) {
        f32x16 g = {};
        const bf16* kmp = km + ((size_t)(b * NH + h) * 16 + (r32 & 15)) * HD;
#pragma unroll
        for (int d0 = 0; d0 < 4; ++d0) { const bf16x8 kf = *(const GAS bf16x8*)(kmp + d0 * 16 + hi * 8); g = __builtin_amdgcn_mfma_f32_32x32x16_bf16(kf, qr[d0], g, 0, 0, 0); }
        LAS float* gs = (LAS float*)(L + AT_GATE) + wid * 512;
#pragma unroll
        for (int r = 0; r < 8; ++r) gs[r32 * 16 + crow(r, hi)] = g[r];
        LDS_WAIT(); asm volatile("" ::: "memory");
        float gv[16];
#pragma unroll
        for (int i = 0; i < 4; ++i) { const f32x4 t = *(const LAS f32x4*)(gs + r32 * 16 + 4 * i); gv[4 * i] = t[0]; gv[4 * i + 1] = t[1]; gv[4 * i + 2] = t[2]; gv[4 * i + 3] = t[3]; }
#pragma unroll
        for (int pass = 0; pass < 3; ++pass) { float best = -INFINITY; int bi = -1;
#pragma unroll
            for (int n = 0; n < 16; ++n) { const bool ok = (n < qb) && !((sel >> n) & 1u) && (gv[n] > best); if (ok) { best = gv[n]; bi = n; } }
            if (bi >= 0) sel |= 1u << bi; }
    }
    const bf16* ksrc = ub + (mb + lane) * INP + UK + h * HD + wid * 8;
    const bf16* vsrc = ub + (mb + 16 * (wid & 3) + (lane >> 2)) * INP + UV + h * HD + (wid >> 2) * 32 + (lane & 3) * 8;
    const int stoff = wid * 1024 + lane * 16;
    const int NTILE = 4 * (qb + 1);
    v4u kreg, vreg;
    kreg = *(const GAS v4u*)(ksrc); vreg = *(const GAS v4u*)(vsrc);
    __syncthreads();
    *(LAS v4u*)(L + AT_K + stoff) = kreg; *(LAS v4u*)(L + AT_V + stoff) = vreg;
    __syncthreads();
    float mrun = -INFINITY, lrun = 0.f; f32x16 o[2]; o[0] = f32x16{}; o[1] = f32x16{};
    const float c31 = tab[128];
    for (int jt = 0; jt < NTILE; ++jt) {
        const int cur = jt & 1;
        if (jt + 1 < NTILE) { kreg = *(const GAS v4u*)(ksrc + (size_t)(jt + 1) * 64 * INP); vreg = *(const GAS v4u*)(vsrc + (size_t)(jt + 1) * 64 * INP); }
        const int n = jt >> 2;
        const int dbase = 256 * (qb - n) + 32 * wid - 64 * (jt & 3);
        const bool lane_ok = (n == qb) || ((sel >> n) & 1u);
        const bool wave_live = (dbase + 31 >= 0) && __any(lane_ok);
        if (wave_live) {
            f32x16 p0 = {}, p1 = {};
            const LAS unsigned char* kb = L + AT_K + cur * 8192 + hi * 1024 + r32 * 16;
#pragma unroll
            for (int d0 = 0; d0 < 4; ++d0) { const bf16x8 b0 = *(const LAS bf16x8*)(kb + d0 * 2048); const bf16x8 b1 = *(const LAS bf16x8*)(kb + d0 * 2048 + 512);
                p0 = __builtin_amdgcn_mfma_f32_32x32x16_bf16(b0, qr[d0], p0, 0, 0, 0); p1 = __builtin_amdgcn_mfma_f32_32x32x16_bf16(b1, qr[d0], p1, 0, 0, 0); }
            const bool far = (dbase - 63 >= 128);
            const int dl = dbase + r32;
            if (far) {
#pragma unroll
                for (int r = 0; r < 16; ++r) { p0[r] = lane_ok ? p0[r] * C2 + c31 : -INFINITY; p1[r] = lane_ok ? p1[r] * C2 + c31 : -INFINITY; }
            } else {
#pragma unroll
                for (int r = 0; r < 16; ++r) { const int d0_ = dl - crow(r, hi), d1_ = d0_ - 32;
                    const float b0 = tab[min(max(d0_, 0), 128)], b1 = tab[min(max(d1_, 0), 128)];
                    p0[r] = (lane_ok && d0_ >= 0) ? p0[r] * C2 + b0 : -INFINITY; p1[r] = (lane_ok && d1_ >= 0) ? p1[r] * C2 + b1 : -INFINITY; }
            }
            float rm = fmaxf(p0[0], p1[0]);
#pragma unroll
            for (int r = 1; r < 16; ++r) rm = fmaxf(rm, fmaxf(p0[r], p1[r]));
            rm = swapmax(rm);
            const float mnew = fmaxf(mrun, rm);
            const float msafe = (mnew == -INFINITY) ? 0.f : mnew;
            const float alpha = __builtin_amdgcn_exp2f(mrun - msafe);
            mrun = mnew;
            float ps = 0.f;
#pragma unroll
            for (int r = 0; r < 16; ++r) { p0[r] = __builtin_amdgcn_exp2f(p0[r] - msafe); p1[r] = __builtin_amdgcn_exp2f(p1[r] - msafe); ps += p0[r] + p1[r]; }
            lrun = lrun * alpha + ps;
            if (__any(alpha != 1.f)) {
                if (hi == 0) wsf[r32] = alpha;
                LDS_WAIT(); asm volatile("" ::: "memory");
#pragma unroll
                for (int r = 0; r < 16; ++r) { const float f = wsf[crow(r, hi)]; o[0][r] *= f; o[1][r] *= f; }
                asm volatile("" ::: "memory");
            }
            v4u pw[4];
            pw[0] = (v4u){cvtpk(p0[0], p0[1]), cvtpk(p0[2], p0[3]), cvtpk(p0[4], p0[5]), cvtpk(p0[6], p0[7])};
            pw[1] = (v4u){cvtpk(p0[8], p0[9]), cvtpk(p0[10], p0[11]), cvtpk(p0[12], p0[13]), cvtpk(p0[14], p0[15])};
            pw[2] = (v4u){cvtpk(p1[0], p1[1]), cvtpk(p1[2], p1[3]), cvtpk(p1[4], p1[5]), cvtpk(p1[6], p1[7])};
            pw[3] = (v4u){cvtpk(p1[8], p1[9]), cvtpk(p1[10], p1[11]), cvtpk(p1[12], p1[13]), cvtpk(p1[14], p1[15])};
            const LAS unsigned char* vb = L + AT_V + cur * 8192 + ((lane >> 4) & 1) * 32 + (lane & 3) * 8 + (4 * hi + ((lane & 15) >> 2)) * 64;
#pragma unroll
            for (int d0 = 0; d0 < 2; ++d0)
#pragma unroll
                for (int ks = 0; ks < 4; ++ks) { const s16x4 lo = vtr(vb + d0 * 4096 + ks * 1024), hh = vtr(vb + d0 * 4096 + ks * 1024 + 512);
                    const bf16x8 vf = (bf16x8){lo[0], lo[1], lo[2], lo[3], hh[0], hh[1], hh[2], hh[3]};
                    o[d0] = __builtin_amdgcn_mfma_f32_32x32x16_bf16(__builtin_bit_cast(bf16x8, pw[ks]), vf, o[d0], 0, 0, 0); }
        }
        if (jt + 1 < NTILE) { *(LAS v4u*)(L + AT_K + (cur ^ 1) * 8192 + stoff) = kreg; *(LAS v4u*)(L + AT_V + (cur ^ 1) * 8192 + stoff) = vreg; }
        __syncthreads();
    }
    lrun = swapsum(lrun);
    if (hi == 0) wsf[32 + r32] = lrun;
    LDS_WAIT(); asm volatile("" ::: "memory");
    LAS bf16* stg = (LAS bf16*)(L + AT_OST) + wid * 2048;
#pragma unroll
    for (int r = 0; r < 16; ++r) { const int orow = crow(r, hi); const float rl = 1.f / wsf[32 + orow];
        stg[orow * 64 + r32] = (bf16)f2bf(o[0][r] * rl); stg[orow * 64 + 32 + r32] = (bf16)f2bf(o[1][r] * rl); }
    LDS_WAIT(); asm volatile("" ::: "memory");
    bf16* Ow = mix + (mb + q0 + wid * 32) * DM + h * HD;
#pragma unroll
    for (int i = 0; i < 4; ++i) { const int row = i * 8 + (lane >> 3), ch = lane & 7; const v4u v = *(const LAS v4u*)(stg + row * 64 + ch * 8); *(GAS v4u*)(Ow + (size_t)row * DM + ch * 8) = v; }
}

__device__ __forceinline__ void attn_queue(Frame& F, unsigned* head) {
    volatile LAS unsigned* slot = (volatile LAS unsigned*)(F.lds + MISC_OFF + 64);
    for (;;) {
        __syncthreads();
        if (F.tid == 0) *slot = __hip_atomic_fetch_add(head, 1u, __ATOMIC_RELAXED, __HIP_MEMORY_SCOPE_AGENT);
        __syncthreads();
        const unsigned u = *slot;
        if (u >= 512u) break;
        const int bh = (int)(u & 31u), qb = 15 - (int)(u >> 5);
        attn_unit(F, bh >> 4, bh & 15, qb);
    }
}

#ifndef REP_PHASE
#define REP_PHASE -1
#endif
#ifndef REP_EXTRA
#define REP_EXTRA 1
#endif
#ifndef MK_PER_PHASE
#define MK_PER_PHASE 0
#endif
constexpr int NPHASE = 16;
__global__ void __launch_bounds__(NT, 2) hymba_fwd(Args args) {
    extern __shared__ __attribute__((aligned(16))) unsigned char lds[];
    Frame F;
    F.lds = (LAS unsigned char*)lds;
    F.tid = threadIdx.x; F.lane = F.tid & 63; F.wave = __builtin_amdgcn_readfirstlane(F.tid >> 6);
    F.G = gridDim.x; F.bid = blockIdx.x; F.in = args.in; F.hz = args.out; F.ws = args.ws;
    volatile LAS unsigned* MISC = (volatile LAS unsigned*)(F.lds + MISC_OFF);
    for (int u = F.tid; u < (LDS_BYTES - LDSCTL_OFF) / 4; u += NT) ((LAS unsigned*)(F.lds + LDSCTL_OFF))[u] = 0u;
    __syncthreads();
    gu32* ctl = (gu32*)(F.ws + WS_CTL);
    XcdBarrier bar; bar.bar = (unsigned*)(ctl + CW_BAR); bar.x = 0; bar.st = nullptr;
    if (!MK_PER_PHASE) bar = xcd_barrier_post((unsigned*)(ctl + CW_BAR), MISC + 8);
    const int lo = args.ph_lo, hi = args.ph_hi;
#define IN(k) (lo <= (k) && (k) < hi)
#define SEAM(k) do { if (IN(k) && IN((k) + 1)) xcd_barrier(bar); } while (0)
    bf16* const Wgu = (bf16*)(F.ws + WS_WGU); bf16* const Wd = (bf16*)(F.ws + WS_WD); bf16* const Win = (bf16*)(F.ws + WS_WIN); bf16* const Wout = (bf16*)(F.ws + WS_WOUT);
    bf16* const Wpg = (bf16*)(F.ws + WS_WPG); bf16* const Wpu = (bf16*)(F.ws + WS_WPU);
    bf16* const XB = (bf16*)(F.ws + WS_XB); bf16* const BIG = (bf16*)(F.ws + WS_BIG); bf16* const MIX = (bf16*)(F.ws + WS_MIX); bf16* const EB = (bf16*)(F.ws + WS_SCAN); bf16* const PB = (bf16*)(F.ws + WS_PB);

    if (IN(0)) {
        int base = 0;
        ffn_weights(F, 2, 3, 4, base);
        transpose_job(F, F.in[7], DM, DM, INC, Win, DM, 0, base);
        transpose_job(F, F.in[20], DM, DM, DM, Wout, DM, 0, base);
        transpose_job(F, F.in[29], DM, DM, DM, Wpg, DM, 0, base);
        transpose_job(F, F.in[28], PLE, PLE, DM, Wpu, PLE, 0, base);
        transpose_job(F, F.in[11], 64, 64, RW, (bf16*)(F.ws + WS_SMALL + SM_W2T), 64, 0, base);
        transpose_job(F, F.in[13], 64, 64, RW, (bf16*)(F.ws + WS_SMALL + SM_A2T), 64, 0, base);
        transpose_job(F, F.in[14], 160, 192, RW, (bf16*)(F.ws + WS_SMALL + SM_G2T), 192, 0, base);
        convert_bf16(F, F.in[0], XB, (size_t)M * DM);
        convert_bf16(F, F.in[1], PB, (size_t)M * PLE);
    }
    SEAM(0);
    if (IN(1)) { pg8::Gemm g{XB, Wgu, M, NGU, DM}; pg8::StaticOrder S; S.init(M, NGU, F.G, F.bid); pg8::EpiSwiGLU E{BIG, DFF};
        pg8::gemm_phase<pg8::EpiSwiGLU, pg8::StaticOrder, true, true>(F.lds, g, S, E); }
    SEAM(1);
    if (IN(2)) { pg8::Gemm g{BIG, Wd, M, DM, DFF}; pg8::StaticOrder S; S.init(M, DM, F.G, F.bid); pg8::EpiResid E{F.in[0], F.hz, DM, ALPHA, 0.5f};
        pg8::gemm_phase<pg8::EpiResid, pg8::StaticOrder, true, true>(F.lds, g, S, E); }
    SEAM(2);
    if (IN(3)) ln_phase<true>(F, F.hz, F.in[5], F.in[6], XB);
    SEAM(3);
    if (IN(4)) { pg8::Gemm g{XB, Win, M, INP, DM}; pg8::StaticOrder S; S.init(M, INP, F.G, F.bid); pg8::EpiBf16<0> E{BIG, INP, nullptr, 0, 0, 1.f};
        pg8::gemm_phase<pg8::EpiBf16<0>, pg8::StaticOrder, true, true>(F.lds, g, S, E); }
    SEAM(4);
    if (IN(5)) { kmean_tasks(F); for (int t = F.bid; t < M / 32; t += F.G) prep_tile(F, t); }
    SEAM(5);
    if (IN(6)) for (int u = F.bid; u < BATCH * NH * 64; u += F.G) chunk_prepass(F, u);
    SEAM(6);
    if (IN(7)) {
        for (int t = F.bid; t < BATCH * NH; t += F.G) chunk_scan(F, t);
        attn_queue(F, (unsigned*)(ctl + CW_QUEUE));
    }
    SEAM(7);
    if (MK_PER_PHASE && lo == 20) for (int t = F.bid; t < BATCH * NH; t += F.G) chunk_scan(F, t);
    if (MK_PER_PHASE && lo == 21) attn_queue(F, (unsigned*)(ctl + CW_QUEUE) + 64);
    if (IN(8)) { rw_finalize(F); int base = 0; ffn_weights(F, 23, 24, 25, base); }
    SEAM(8);
    if (IN(9)) { { pg8::Gemm g{MIX, Wout, M, DM, DM}; pg8::StaticOrder S; S.init(M, DM, F.G, F.bid); pg8::EpiResid E{F.hz, F.hz, DM, ALPHA, 1.0f};
          pg8::gemm_phase<pg8::EpiResid, pg8::StaticOrder, true, true>(F.lds, g, S, E); }
        { pg8::Gemm g{PB, Wpu, M, DM, PLE}; pg8::StaticOrder S; S.init(M, DM, F.G, F.bid); pg8::EpiBf16<0> E{EB, DM, nullptr, 0, 0, 1.f};
          pg8::gemm_phase<pg8::EpiBf16<0>, pg8::StaticOrder, true, true>(F.lds, g, S, E); } }
    SEAM(9);
    if (IN(10)) ln_phase<true>(F, F.hz, F.in[21], F.in[22], XB);
    SEAM(10);
    if (IN(11)) { pg8::Gemm g{XB, Wgu, M, NGU, DM}; pg8::StaticOrder S; S.init(M, NGU, F.G, F.bid); pg8::EpiSwiGLU E{BIG, DFF};
        pg8::gemm_phase<pg8::EpiSwiGLU, pg8::StaticOrder, true, true>(F.lds, g, S, E); }
    SEAM(11);
    if (IN(12)) { pg8::Gemm g{BIG, Wd, M, DM, DFF}; pg8::StaticOrder S; S.init(M, DM, F.G, F.bid); pg8::EpiResid E{F.hz, F.hz, DM, ALPHA, 0.5f};
        pg8::gemm_phase<pg8::EpiResid, pg8::StaticOrder, true, true>(F.lds, g, S, E); }
    SEAM(12);
    if (IN(13)) ln_phase<true>(F, F.hz, F.in[26], F.in[27], XB);
    SEAM(13);
    if (IN(14)) { pg8::Gemm g{XB, Wpg, M, DM, DM}; pg8::StaticOrder S; S.init(M, DM, F.G, F.bid); pg8::EpiPle E{F.hz, F.hz, EB, F.in[30], DM, ALPHA};
        pg8::gemm_phase<pg8::EpiPle, pg8::StaticOrder, true, true>(F.lds, g, S, E); }
    SEAM(14);
    if (IN(15)) {
        if (!MK_PER_PHASE && xb_ld((unsigned*)(ctl + CW_BAR) + XB_TMO) != 0u) {
            const float q = __builtin_nanf(""); for (size_t i = (size_t)F.bid * NT + F.tid; i < (size_t)M * DM; i += (size_t)F.G * NT) F.hz[i] = q;
        } else ln_phase<false>(F, F.hz, F.in[31], F.in[32], nullptr);
    }
#undef IN
#undef SEAM
}

extern "C" void kernel_launch(void* const* d_in, const int* in_sizes, int n_in, void* d_out, int out_size, void* d_ws, size_t ws_size, hipStream_t stream) {
    static int grid = 0;
    if (grid == 0) {
        if (n_in != 33 || out_size != M * DM || ws_size < WS_END) { fprintf(stderr, "kernel_launch: unexpected problem (n_in %d out %d ws %zu, need %zu); nothing launched\n", n_in, out_size, ws_size, (size_t)WS_END); grid = -1; return; }
        int dev = 0, cus = 0;
        if (hipGetDevice(&dev) != hipSuccess || hipDeviceGetAttribute(&cus, hipDeviceAttributeMultiprocessorCount, dev) != hipSuccess) { grid = -1; return; }
        if (hipFuncSetAttribute((const void*)hymba_fwd, hipFuncAttributeMaxDynamicSharedMemorySize, LDS_BYTES) != hipSuccess) { fprintf(stderr, "kernel_launch: hipFuncSetAttribute failed\n"); grid = -1; return; }
        grid = cus > 0 ? cus : 256;
        fprintf(stderr, "kernel_launch: grid %d, ws %zu\n", grid, ws_size);
    }
    if (grid < 0) return;
    (void)hipMemsetAsync((char*)d_ws + WS_CTL, 0, CTL_ZERO_BYTES, stream);
    Args a{};
    for (int i = 0; i < 33; ++i) a.in[i] = (const float*)d_in[i];
    a.out = (float*)d_out; a.ws = (unsigned char*)d_ws;
#if MK_PER_PHASE
    for (int p = 0; p < NPHASE; ++p) { a.ph_lo = p; a.ph_hi = p + 1; const int reps = (p == REP_PHASE) ? 1 + REP_EXTRA : 1;
        for (int r = 0; r < reps; ++r) hipLaunchKernelGGL(hymba_fwd, dim3(grid), dim3(NT), LDS_BYTES, stream, a);
        if (p == 7 && REP_PHASE >= 20) { a.ph_lo = REP_PHASE; a.ph_hi = REP_PHASE + 1; hipLaunchKernelGGL(hymba_fwd, dim3(grid), dim3(NT), LDS_BYTES, stream, a); } }
#else
    a.ph_lo = 0; a.ph_hi = NPHASE;
    hipLaunchKernelGGL(hymba_fwd, dim3(grid), dim3(NT), LDS_BYTES, stream, a);
#endif
}
```

```cpp
#include <hip/hip_runtime.h>
#include <cstdio>
#include <cstdint>
namespace pg8 {
#define PG8_LAS __attribute__((address_space(3)))
typedef unsigned short bf16_t;
typedef short bf16x8 __attribute__((ext_vector_type(8)));
typedef float f32x4 __attribute__((ext_vector_type(4)));
typedef unsigned u32x4 __attribute__((ext_vector_type(4)));
constexpr int BM = 256, BK = 64, HALF = 128, HTB = HALF * BK * 2  , STAGE_BYTES = 8 * HTB, NXCD = 8, WGM = 8;

__host__ __device__ __forceinline__ int lds_byte(int r, int c) { const int st = (r >> 4) * 2 + (c >> 5), rr = r & 15, cc = c & 31, ob = rr * 64 + cc * 2; return st * 1024 + (ob ^ (((ob >> 9) & 1) << 5)); }
__host__ __device__ __forceinline__ void stage_rc(int b, int& R, int& C) { const int st = b / 1024, sb = b % 1024, swz = sb ^ (((sb >> 9) & 1) << 5); R = (st >> 1) * 16 + swz / 64; C = (st & 1) * 32 + (swz % 64) / 2; }
__host__ __device__ __forceinline__ int perm32(int rho) { const int n = rho >> 4, i = rho & 15; return 8 * (i >> 2) + 4 * n + (i & 3); }

struct Unit { int pm, pn; };
struct Gemm { const bf16_t* A; const bf16_t* Bt; int M, N, K; };

struct StaticOrder {
    int nM, nN, nwg, G, c;
    __host__ __device__ void init(int M, int N, int G_, int c_) { nM = M / BM; nN = N / BM; nwg = nM * nN; G = G_; c = c_; }
    __host__ __device__ bool next(int i, Unit& u) const {
        const long L = (long)i * G + c; if (L >= nwg) return false;
        int wgid = (int)L; { const int q = nwg / NXCD, r = nwg % NXCD, xcd = wgid % NXCD, off = wgid / NXCD; wgid = (xcd < r ? xcd * (q + 1) : r * (q + 1) + (xcd - r) * q) + off; }
        const int nig = WGM * nN, gid = wgid / nig, fm = gid * WGM, gsz = (nM - fm) < WGM ? (nM - fm) : WGM;
        u.pm = fm + ((wgid % nig) % gsz); u.pn = (wgid % nig) / gsz; return true;
    }
    __device__ __forceinline__ void a_ready(const Unit&) const {}
    __device__ __forceinline__ void done(const Unit&) const {}
};

__device__ __forceinline__ unsigned cvt_pk_bf16(float lo, float hi) { unsigned r; asm volatile("v_cvt_pk_bf16_f32 %0, %1, %2" : "=v"(r) : "v"(lo), "v"(hi)); return r; }
typedef float f32x2 __attribute__((ext_vector_type(2)));
__device__ __forceinline__ f32x2 gelu_pk(f32x2 v) {
    const f32x2 av = __builtin_elementwise_abs(v), d = av * 0.2316418882f + 1.0f;
    f32x2 t; t.x = __builtin_amdgcn_rcpf(d.x); t.y = __builtin_amdgcn_rcpf(d.y);
    f32x2 q = t * 0.5307027145f + (-0.7265760135f); q = q * t + 0.7107068705f; q = q * t + (-0.142248368f); q = q * t + 0.127414796f; q = q * t;
    const f32x2 s = (v * v) * (-0.72134752044f);
    f32x2 e; e.x = __builtin_amdgcn_exp2f(s.x); e.y = __builtin_amdgcn_exp2f(s.y);
    const f32x2 m = v * (q * e), r = v - m;
    f32x2 o; o.x = v.x < 0.f ? m.x : r.x; o.y = v.y < 0.f ? m.y : r.y; return o;
}

template <int ACT  > struct EpiBf16 {
    static constexpr bool PERM = true, AFTER_DRAIN = false; static_assert(ACT == 0 || ACT == 1, "EpiBf16: ACT is 0 (none) or 1 (gelu_pk)");
    bf16_t* O; int ldc; const float* bias; int split_cols; size_t split_stride; float scale0;
    __device__ __forceinline__ void operator()(const f32x4 (&acc)[2][2][4][2], const Unit& u, int wr, int wc, int fr, int fq) const {
        const int row0 = u.pm * BM + wr * 64 + fr; int colt = u.pn * BM; bf16_t* base = O;
        float sc = 1.f; if (split_cols) { const int t = colt / split_cols; base += (size_t)t * split_stride; colt -= t * split_cols; if (t == 0) sc = scale0; }
        const int col0 = colt + wc * 32 + 8 * fq, bcol0 = u.pn * BM + wc * 32 + 8 * fq;
        f32x4 bv[2][2];
#pragma unroll
        for (int bj = 0; bj < 2; ++bj)
#pragma unroll
            for (int n = 0; n < 2; ++n) bv[bj][n] = bias ? *(const f32x4*)(bias + bcol0 + bj * HALF + 4 * n) : (f32x4){0.f, 0.f, 0.f, 0.f};
#pragma unroll
        for (int ai = 0; ai < 2; ++ai)
#pragma unroll
            for (int m = 0; m < 4; ++m) { bf16_t* rowp = base + (size_t)(row0 + ai * HALF + m * 16) * ldc + col0;
#pragma unroll
                for (int bj = 0; bj < 2; ++bj) { f32x4 v0 = acc[ai][bj][m][0] + bv[bj][0], v1 = acc[ai][bj][m][1] + bv[bj][1];
                    if (ACT == 1) { f32x2 a = gelu_pk((f32x2){v0[0], v0[1]}), b = gelu_pk((f32x2){v0[2], v0[3]}), c = gelu_pk((f32x2){v1[0], v1[1]}), d = gelu_pk((f32x2){v1[2], v1[3]});
                        v0 = (f32x4){a.x, a.y, b.x, b.y}; v1 = (f32x4){c.x, c.y, d.x, d.y}; }
                    v0 = v0 * sc; v1 = v1 * sc; u32x4 w; w.x = cvt_pk_bf16(v0[0], v0[1]); w.y = cvt_pk_bf16(v0[2], v0[3]); w.z = cvt_pk_bf16(v1[0], v1[1]); w.w = cvt_pk_bf16(v1[2], v1[3]);
                    *(u32x4*)(rowp + bj * HALF) = w; } }
    }
};
__device__ __forceinline__ float sigmoid_f(float x) { return __builtin_amdgcn_rcpf(1.0f + __builtin_amdgcn_exp2f(-1.4426950408889634f * x)); }
struct EpiSwiGLU {
    static constexpr bool PERM = true, AFTER_DRAIN = false;
    bf16_t* O; int ldc;
    __device__ __forceinline__ void operator()(const f32x4 (&acc)[2][2][4][2], const Unit& u, int wr, int wc, int fr, int fq) const {
        const int row0 = u.pm * BM + wr * 64 + fr; const int col0 = u.pn * HALF + wc * 32 + 8 * fq;
#pragma unroll
        for (int ai = 0; ai < 2; ++ai)
#pragma unroll
            for (int m = 0; m < 4; ++m) { bf16_t* rowp = O + (size_t)(row0 + ai * HALF + m * 16) * ldc + col0;
                const f32x4 g0 = acc[ai][0][m][0], g1 = acc[ai][0][m][1], u0 = acc[ai][1][m][0], u1 = acc[ai][1][m][1];
                f32x4 h0, h1;
#pragma unroll
                for (int i = 0; i < 4; ++i) { h0[i] = g0[i] * sigmoid_f(g0[i]) * u0[i]; h1[i] = g1[i] * sigmoid_f(g1[i]) * u1[i]; }
                u32x4 w; w.x = cvt_pk_bf16(h0[0], h0[1]); w.y = cvt_pk_bf16(h0[2], h0[3]); w.z = cvt_pk_bf16(h1[0], h1[1]); w.w = cvt_pk_bf16(h1[2], h1[3]);
                *(u32x4*)rowp = w; }
    }
};
struct EpiResid {
    static constexpr bool PERM = false, AFTER_DRAIN = false;
    const float* base; float* out; int ldc; float alpha, s;
    __device__ __forceinline__ void operator()(const f32x4 (&acc)[2][2][4][2], const Unit& u, int wr, int wc, int fr, int fq) const {
        const int col0 = u.pn * BM + wc * 32 + 4 * fq;
#pragma unroll
        for (int ai = 0; ai < 2; ++ai)
#pragma unroll
            for (int m = 0; m < 4; ++m) { const size_t off = (size_t)(u.pm * BM + ai * HALF + wr * 64 + m * 16 + fr) * ldc + col0;
#pragma unroll
                for (int bj = 0; bj < 2; ++bj)
#pragma unroll
                    for (int n = 0; n < 2; ++n) { const f32x4 bs = *(const f32x4*)(base + off + bj * HALF + n * 16);
                        *(f32x4*)(out + off + bj * HALF + n * 16) = bs * alpha + acc[ai][bj][m][n] * s; }
                if (m & 1) asm volatile("" ::: "memory"); }
    }
};
struct EpiPle {
    static constexpr bool PERM = false, AFTER_DRAIN = false;
    const float* base; float* out; const bf16_t* e; const float* bias; int ldc; float alpha;
    __device__ __forceinline__ void operator()(const f32x4 (&acc)[2][2][4][2], const Unit& u, int wr, int wc, int fr, int fq) const {
        typedef unsigned u32x2v __attribute__((ext_vector_type(2)));
        const int col0 = u.pn * BM + wc * 32 + 4 * fq;
        f32x4 bv[2][2];
#pragma unroll
        for (int bj = 0; bj < 2; ++bj)
#pragma unroll
            for (int n = 0; n < 2; ++n) bv[bj][n] = *(const f32x4*)(bias + col0 + bj * HALF + n * 16);
#pragma unroll
        for (int ai = 0; ai < 2; ++ai)
#pragma unroll
            for (int m = 0; m < 4; ++m) { const size_t off = (size_t)(u.pm * BM + ai * HALF + wr * 64 + m * 16 + fr) * ldc + col0;
#pragma unroll
                for (int bj = 0; bj < 2; ++bj)
#pragma unroll
                    for (int n = 0; n < 2; ++n) { const f32x4 bs = *(const f32x4*)(base + off + bj * HALF + n * 16);
                        const u32x2v ew = *(const u32x2v*)(e + off + bj * HALF + n * 16);
                        f32x4 ev; ev[0] = __uint_as_float(ew.x << 16); ev[1] = __uint_as_float(ew.x & 0xffff0000u); ev[2] = __uint_as_float(ew.y << 16); ev[3] = __uint_as_float(ew.y & 0xffff0000u);
                        const f32x4 a = acc[ai][bj][m][n] + bv[bj][n]; f32x4 o;
#pragma unroll
                        for (int i = 0; i < 4; ++i) o[i] = bs[i] * alpha + sigmoid_f(a[i]) * ev[i];
                        *(f32x4*)(out + off + bj * HALF + n * 16) = o; }
                if (m & 1) asm volatile("" ::: "memory"); }
    }
};

struct RowStats { const float* st; float inv_n, eps;
    __device__ __forceinline__ void get(int row, float& mu, float& rstd) const { const float s = st[2 * row], q = st[2 * row + 1]; mu = s * inv_n; const float var = q * inv_n - mu * mu; rstd = __builtin_amdgcn_rsqf(fmaxf(var, 0.f) + eps); } };
template <bool LNB>
struct EpiResidLN {
    static constexpr bool PERM = false, AFTER_DRAIN = false;
    const float* base; float* out; bf16_t* zb; int ldc; float alpha, s; RowStats bst; const float* bg; const float* bb; float* stats_out;
    __device__ __forceinline__ void operator()(const f32x4 (&acc)[2][2][4][2], const Unit& u, int wr, int wc, int fr, int fq) const {
        typedef unsigned u32x2v __attribute__((ext_vector_type(2)));
        const int col0 = u.pn * BM + wc * 32 + 4 * fq;
#pragma unroll
        for (int ai = 0; ai < 2; ++ai)
#pragma unroll
            for (int m = 0; m < 4; ++m) { const int row = u.pm * BM + ai * HALF + wr * 64 + m * 16 + fr; const size_t off = (size_t)row * ldc + col0;
                float mu = 0.f, rstd = 1.f; if (LNB) bst.get(row, mu, rstd);
                float rs = 0.f, rq = 0.f;
#pragma unroll
                for (int bj = 0; bj < 2; ++bj)
#pragma unroll
                    for (int n = 0; n < 2; ++n) { f32x4 bs = *(const f32x4*)(base + off + bj * HALF + n * 16);
                        if (LNB) bs = (bs - mu) * rstd * *(const f32x4*)(bg + col0 + bj * HALF + n * 16) + *(const f32x4*)(bb + col0 + bj * HALF + n * 16);
                        const f32x4 o = bs * alpha + acc[ai][bj][m][n] * s;
                        *(f32x4*)(out + off + bj * HALF + n * 16) = o;
                        u32x2v w; w.x = cvt_pk_bf16(o[0], o[1]); w.y = cvt_pk_bf16(o[2], o[3]); *(u32x2v*)(zb + off + bj * HALF + n * 16) = w;
                        rs += (o[0] + o[1]) + (o[2] + o[3]); rq += (o[0] * o[0] + o[1] * o[1]) + (o[2] * o[2] + o[3] * o[3]); }
                rs += __shfl_xor(rs, 16); rq += __shfl_xor(rq, 16); rs += __shfl_xor(rs, 32); rq += __shfl_xor(rq, 32);
                if (fq == 0) { atomicAdd(stats_out + 2 * row, rs); atomicAdd(stats_out + 2 * row + 1, rq); }
                asm volatile("" ::: "memory"); }
    }
};
struct EpiBf16LN {
    static constexpr bool PERM = true, AFTER_DRAIN = false;
    bf16_t* O; int ldc; RowStats st; const float* c1; const float* c2;
    __device__ __forceinline__ void operator()(const f32x4 (&acc)[2][2][4][2], const Unit& u, int wr, int wc, int fr, int fq) const {
        const int row0 = u.pm * BM + wr * 64 + fr; const int col0 = u.pn * BM + wc * 32 + 8 * fq;
#pragma unroll
        for (int ai = 0; ai < 2; ++ai)
#pragma unroll
            for (int m = 0; m < 4; ++m) { const int row = row0 + ai * HALF + m * 16; bf16_t* rowp = O + (size_t)row * ldc + col0;
                float mu, rstd; st.get(row, mu, rstd); const float rm = rstd * mu;
#pragma unroll
                for (int bj = 0; bj < 2; ++bj) { const float* c1p = c1 + col0 + bj * HALF; const float* c2p = c2 + col0 + bj * HALF;
                    const f32x4 v0 = acc[ai][bj][m][0] * rstd - *(const f32x4*)(c1p) * rm + *(const f32x4*)(c2p), v1 = acc[ai][bj][m][1] * rstd - *(const f32x4*)(c1p + 4) * rm + *(const f32x4*)(c2p + 4);
                    u32x4 w; w.x = cvt_pk_bf16(v0[0], v0[1]); w.y = cvt_pk_bf16(v0[2], v0[3]); w.z = cvt_pk_bf16(v1[0], v1[1]); w.w = cvt_pk_bf16(v1[2], v1[3]);
                    *(u32x4*)(rowp + bj * HALF) = w; }
                asm volatile("" ::: "memory"); }
    }
};
struct EpiSwiGLULN {
    static constexpr bool PERM = true, AFTER_DRAIN = false;
    bf16_t* O; int ldc; RowStats st; const float* c1; const float* c2;
    __device__ __forceinline__ void operator()(const f32x4 (&acc)[2][2][4][2], const Unit& u, int wr, int wc, int fr, int fq) const {
        const int row0 = u.pm * BM + wr * 64 + fr; const int col0 = u.pn * HALF + wc * 32 + 8 * fq; const int ci = u.pn * BM + wc * 32 + 8 * fq;
#pragma unroll
        for (int ai = 0; ai < 2; ++ai)
#pragma unroll
            for (int m = 0; m < 4; ++m) { const int row = row0 + ai * HALF + m * 16; bf16_t* rowp = O + (size_t)row * ldc + col0;
                float mu, rstd; st.get(row, mu, rstd); const float rm = rstd * mu;
                const f32x4 g0 = acc[ai][0][m][0] * rstd - *(const f32x4*)(c1 + ci) * rm + *(const f32x4*)(c2 + ci), g1 = acc[ai][0][m][1] * rstd - *(const f32x4*)(c1 + ci + 4) * rm + *(const f32x4*)(c2 + ci + 4);
                const f32x4 u0 = acc[ai][1][m][0] * rstd - *(const f32x4*)(c1 + ci + HALF) * rm + *(const f32x4*)(c2 + ci + HALF), u1 = acc[ai][1][m][1] * rstd - *(const f32x4*)(c1 + ci + HALF + 4) * rm + *(const f32x4*)(c2 + ci + HALF + 4);
                f32x4 h0, h1;
#pragma unroll
                for (int i = 0; i < 4; ++i) { h0[i] = g0[i] * sigmoid_f(g0[i]) * u0[i]; h1[i] = g1[i] * sigmoid_f(g1[i]) * u1[i]; }
                u32x4 w; w.x = cvt_pk_bf16(h0[0], h0[1]); w.y = cvt_pk_bf16(h0[2], h0[3]); w.z = cvt_pk_bf16(h1[0], h1[1]); w.w = cvt_pk_bf16(h1[2], h1[3]);
                *(u32x4*)rowp = w; asm volatile("" ::: "memory"); }
    }
};
struct EpiPleLN {
    static constexpr bool PERM = false, AFTER_DRAIN = false;
    const float* base; float* out; const bf16_t* e; const float* bias; int ldc; float alpha; RowStats st; const float* bg; const float* bb; const float* c1; const float* c2;
    __device__ __forceinline__ void operator()(const f32x4 (&acc)[2][2][4][2], const Unit& u, int wr, int wc, int fr, int fq) const {
        typedef unsigned u32x2v __attribute__((ext_vector_type(2)));
        const int col0 = u.pn * BM + wc * 32 + 4 * fq;
#pragma unroll
        for (int bj = 0; bj < 2; ++bj)
#pragma unroll
            for (int n = 0; n < 2; ++n) { const int cc = col0 + bj * HALF + n * 16;
                const f32x4 bv = *(const f32x4*)(bias + cc), gv = *(const f32x4*)(bg + cc), bbv = *(const f32x4*)(bb + cc), c1v = *(const f32x4*)(c1 + cc), c2v = *(const f32x4*)(c2 + cc);
#pragma unroll
                for (int ai = 0; ai < 2; ++ai)
#pragma unroll
                    for (int m = 0; m < 4; ++m) { const int row = u.pm * BM + ai * HALF + wr * 64 + m * 16 + fr; const size_t off = (size_t)row * ldc + cc;
                        float mu, rstd; st.get(row, mu, rstd); const float rm = rstd * mu;
                        const f32x4 bs = (*(const f32x4*)(base + off) - mu) * rstd * gv + bbv;
                        const u32x2v ew = *(const u32x2v*)(e + off);
                        f32x4 ev; ev[0] = __uint_as_float(ew.x << 16); ev[1] = __uint_as_float(ew.x & 0xffff0000u); ev[2] = __uint_as_float(ew.y << 16); ev[3] = __uint_as_float(ew.y & 0xffff0000u);
                        const f32x4 a = acc[ai][bj][m][n] * rstd - c1v * rm + c2v + bv; f32x4 o;
#pragma unroll
                        for (int i = 0; i < 4; ++i) o[i] = bs[i] * alpha + sigmoid_f(a[i]) * ev[i];
                        *(f32x4*)(out + off) = o; }
                asm volatile("" ::: "memory"); }
    }
};

struct EpiResidLNip {
    static constexpr bool PERM = false, AFTER_DRAIN = false;
    float* io; bf16_t* zb; float* st; const float* gb; int ldc, nrows; float alpha, s, inv_n, eps;
    __device__ __forceinline__ void operator()(const f32x4 (&acc)[2][2][4][2], const Unit& u, int wr, int wc, int fr, int fq) const {
        typedef unsigned u32x2v __attribute__((ext_vector_type(2)));
        const int col0 = u.pn * BM + wc * 32 + 4 * fq;
#pragma unroll
        for (int ai = 0; ai < 2; ++ai)
#pragma unroll
            for (int m = 0; m < 4; ++m) { const int row = u.pm * BM + ai * HALF + wr * 64 + m * 16 + fr; const size_t off = (size_t)row * ldc + col0;
                const float sm = st[2 * row], sq = st[2 * row + 1]; const float mu = sm * inv_n; const float rstd = __builtin_amdgcn_rsqf(fmaxf(sq * inv_n - mu * mu, 0.f) + eps);
                float rs = 0.f, rq = 0.f;
#pragma unroll
                for (int bj = 0; bj < 2; ++bj)
#pragma unroll
                    for (int n = 0; n < 2; ++n) { const int cc = col0 + bj * HALF + n * 16; f32x4 bs = *(const f32x4*)(io + off + bj * HALF + n * 16);
                        bs = (bs - mu) * rstd * *(const f32x4*)(gb + cc) + *(const f32x4*)(gb + ldc + cc);
                        const f32x4 o = bs * alpha + acc[ai][bj][m][n] * s;
                        *(f32x4*)(io + off + bj * HALF + n * 16) = o;
                        u32x2v w; w.x = cvt_pk_bf16(o[0], o[1]); w.y = cvt_pk_bf16(o[2], o[3]); *(u32x2v*)(zb + off + bj * HALF + n * 16) = w;
                        rs += (o[0] + o[1]) + (o[2] + o[3]); rq += (o[0] * o[0] + o[1] * o[1]) + (o[2] * o[2] + o[3] * o[3]); }
                rs += __shfl_xor(rs, 16); rq += __shfl_xor(rq, 16); rs += __shfl_xor(rs, 32); rq += __shfl_xor(rq, 32);
                if (fq == 0) { atomicAdd(st + 2 * nrows + 2 * row, rs); atomicAdd(st + 2 * nrows + 2 * row + 1, rq); }
                asm volatile("" ::: "memory"); }
    }
};
template <class Epi, class Sched, bool ALIGN_EPI = false, bool SP2 = false>
__device__ __forceinline__ void gemm_phase(PG8_LAS unsigned char* lds, const Gemm g, const Sched& S, const Epi& E) {
    const int tid = threadIdx.x, wid = __builtin_amdgcn_readfirstlane(tid >> 6), lane = tid & 63, wr = wid >> 2, wc = wid & 3, fr = lane & 15, fq = lane >> 4;
    const int K = g.K, nt = K / BK;
    unsigned voffA[2], voffB[2];
#pragma unroll
    for (int i = 0; i < 2; ++i) { int R, C; stage_rc(tid * 16 + i * 8192, R, C); const int Rb = Epi::PERM ? ((R & ~31) + perm32(R & 31)) : R;
        voffA[i] = (unsigned)(R * K + C) * 2u; voffB[i] = (unsigned)(Rb * K + C) * 2u; }
    const size_t kstep = (size_t)(BK * 2);
    const size_t hstep = (size_t)HALF * K * 2;
    const size_t tstep = 2 * hstep;
    const unsigned ldsw = (unsigned)wid * 1024u;
    const int aoff = lds_byte(wr * 64 + fr, fq * 8), boff = lds_byte(wc * 32 + fr, fq * 8);
#define PG8_SA(b, h) (((b) * 2 + (h)) * HTB)
#define PG8_SB(b, h) ((4 + (b) * 2 + (h)) * HTB)
#define PG8_STAGE(bufoff, gbase, voff) do { _Pragma("unroll") for (int _i = 0; _i < 2; ++_i) \
        __builtin_amdgcn_global_load_lds((const unsigned*)((const char*)(gbase) + (voff)[_i]), (PG8_LAS unsigned*)(lds + (bufoff) + ldsw + _i * 8192), 16, 0, 0); } while (0)
#define PG8_LDA(dst, b, h) do { _Pragma("unroll") for (int m = 0; m < 4; ++m) _Pragma("unroll") for (int k = 0; k < 2; ++k) dst[m][k] = *(const PG8_LAS bf16x8*)(lds + PG8_SA(b, h) + aoff + m * 2048 + k * 1024); } while (0)
#define PG8_LDB(dst, b, h) do { _Pragma("unroll") for (int n = 0; n < 2; ++n) _Pragma("unroll") for (int k = 0; k < 2; ++k) dst[n][k] = *(const PG8_LAS bf16x8*)(lds + PG8_SB(b, h) + boff + n * 2048 + k * 1024); } while (0)
#define PG8_MMA(ai, bj, At, Bt) do { __builtin_amdgcn_s_setprio(1); _Pragma("unroll") for (int m = 0; m < 4; ++m) _Pragma("unroll") for (int n = 0; n < 2; ++n) _Pragma("unroll") for (int k = 0; k < 2; ++k) \
        acc[ai][bj][m][n] = __builtin_amdgcn_mfma_f32_16x16x32_bf16(Bt[n][k], At[m][k], acc[ai][bj][m][n], 0, 0, 0); __builtin_amdgcn_s_setprio(0); } while (0)
#define PG8_WAIT_V(n) asm volatile("s_waitcnt vmcnt(" #n ")" ::: "memory")
#define PG8_WAIT_L(n) asm volatile("s_waitcnt lgkmcnt(" #n ")" ::: "memory")
#define PG8_BAR __builtin_amdgcn_s_barrier()
#define PG8_SCHED __builtin_amdgcn_sched_barrier(0)
    Unit cur, nxt; int ui = 0;
    if (!S.next(0, cur)) return;
    f32x4 acc[2][2][4][2];
#pragma unroll
    for (int a = 0; a < 2; ++a)
#pragma unroll
        for (int b = 0; b < 2; ++b)
#pragma unroll
            for (int m = 0; m < 4; ++m)
#pragma unroll
                for (int n = 0; n < 2; ++n) acc[a][b][m][n] = (f32x4){0.f, 0.f, 0.f, 0.f};
    bf16x8 At[4][2], B0[2][2], B1[2][2];
    const char* cA = (const char*)g.A + (size_t)cur.pm * tstep; const char* cB = (const char*)g.Bt + (size_t)cur.pn * tstep;
    S.a_ready(cur);
    if constexpr (SP2) {
        PG8_STAGE(PG8_SB(0, 0), cB, voffB); PG8_STAGE(PG8_SB(0, 1), cB + hstep, voffB); PG8_STAGE(PG8_SA(0, 0), cA, voffA); PG8_STAGE(PG8_SA(0, 1), cA + hstep, voffA);
        if (wr == 1) PG8_BAR;
        PG8_WAIT_V(2); PG8_BAR;
        PG8_STAGE(PG8_SB(1, 0), cB + kstep, voffB); PG8_STAGE(PG8_SA(1, 0), cA + kstep, voffA); PG8_STAGE(PG8_SB(1, 1), cB + hstep + kstep, voffB);
        PG8_WAIT_V(6); PG8_BAR;
    } else {
        PG8_STAGE(PG8_SB(0, 0), cB, voffB); PG8_STAGE(PG8_SA(0, 0), cA, voffA); PG8_STAGE(PG8_SB(0, 1), cB + hstep, voffB); PG8_STAGE(PG8_SA(0, 1), cA + hstep, voffA);
        if (wr == 1) PG8_BAR;
        PG8_WAIT_V(4); PG8_BAR;
        PG8_STAGE(PG8_SB(1, 0), cB + kstep, voffB); PG8_STAGE(PG8_SA(1, 0), cA + kstep, voffA); PG8_STAGE(PG8_SB(1, 1), cB + hstep + kstep, voffB);
        PG8_WAIT_V(6); PG8_BAR;
    }
    for (;;) {
        const bool has_next = S.next(ui + 1, nxt);
        const char* nA = has_next ? (const char*)g.A + (size_t)nxt.pm * tstep : cA; const char* nB = has_next ? (const char*)g.Bt + (size_t)nxt.pn * tstep : cB;
        for (int t = 0; t < nt; t += 2) {
            const bool last = (t == nt - 2);
            const char* a1 = cA + (size_t)(t + 1) * kstep;
            const char* a2 = last ? nA : cA + (size_t)(t + 2) * kstep; const char* b2 = last ? nB : cB + (size_t)(t + 2) * kstep;
            const char* a3 = a2 + kstep; const char* b3 = b2 + kstep;
            if (last && has_next) S.a_ready(nxt);
            if constexpr (SP2) {
            PG8_LDB(B0, 0, 0); PG8_LDB(B1, 0, 1); PG8_SCHED; PG8_LDA(At, 0, 0); PG8_STAGE(PG8_SA(1, 1), a1 + hstep, voffA);
            PG8_WAIT_V(8); PG8_WAIT_L(0); PG8_BAR; PG8_MMA(0, 0, At, B0); PG8_MMA(0, 1, At, B1); PG8_BAR; PG8_SCHED;
            PG8_LDA(At, 0, 1); PG8_STAGE(PG8_SB(0, 0), b2, voffB); PG8_STAGE(PG8_SB(0, 1), b2 + hstep, voffB); PG8_STAGE(PG8_SA(0, 0), a2, voffA);
            PG8_WAIT_V(8); PG8_WAIT_L(0); PG8_BAR; PG8_MMA(1, 0, At, B0); PG8_MMA(1, 1, At, B1); PG8_BAR; PG8_SCHED;
            PG8_LDB(B0, 1, 0); PG8_LDB(B1, 1, 1); PG8_SCHED; PG8_LDA(At, 1, 0); PG8_STAGE(PG8_SA(0, 1), a2 + hstep, voffA);
            PG8_WAIT_V(8); PG8_WAIT_L(0); PG8_BAR; PG8_MMA(0, 0, At, B0); PG8_MMA(0, 1, At, B1); PG8_BAR; PG8_SCHED;
            PG8_LDA(At, 1, 1); PG8_STAGE(PG8_SB(1, 0), b3, voffB); PG8_STAGE(PG8_SB(1, 1), b3 + hstep, voffB); PG8_STAGE(PG8_SA(1, 0), a3, voffA);
            PG8_WAIT_V(8); PG8_WAIT_L(0); PG8_BAR; PG8_MMA(1, 0, At, B0); PG8_MMA(1, 1, At, B1); PG8_BAR; PG8_SCHED;
            } else {
            PG8_LDB(B0, 0, 0); PG8_SCHED; PG8_LDA(At, 0, 0); PG8_STAGE(PG8_SA(1, 1), a1 + hstep, voffA);
            PG8_WAIT_L(8); PG8_BAR; PG8_WAIT_L(0); PG8_MMA(0, 0, At, B0); PG8_BAR; PG8_SCHED;
            PG8_LDB(B1, 0, 1); PG8_STAGE(PG8_SB(0, 0), b2, voffB);
            PG8_BAR; PG8_WAIT_L(0); PG8_MMA(0, 1, At, B1); PG8_BAR;
            PG8_LDA(At, 0, 1); PG8_STAGE(PG8_SA(0, 0), a2, voffA);
            PG8_BAR; PG8_WAIT_L(0); PG8_MMA(1, 0, At, B0); PG8_BAR; PG8_SCHED;
            PG8_STAGE(PG8_SB(0, 1), b2 + hstep, voffB);
            PG8_WAIT_V(6); PG8_BAR; PG8_MMA(1, 1, At, B1); PG8_BAR;
            PG8_LDB(B0, 1, 0); PG8_SCHED; PG8_LDA(At, 1, 0); PG8_STAGE(PG8_SA(0, 1), a2 + hstep, voffA);
            PG8_WAIT_L(8); PG8_BAR; PG8_WAIT_L(0); PG8_MMA(0, 0, At, B0); PG8_BAR; PG8_SCHED;
            PG8_LDB(B1, 1, 1); PG8_STAGE(PG8_SB(1, 0), b3, voffB);
            PG8_BAR; PG8_WAIT_L(0); PG8_MMA(0, 1, At, B1); PG8_BAR;
            PG8_LDA(At, 1, 1); PG8_STAGE(PG8_SA(1, 0), a3, voffA);
            PG8_BAR; PG8_WAIT_L(0); PG8_MMA(1, 0, At, B0); PG8_BAR; PG8_SCHED;
            PG8_STAGE(PG8_SB(1, 1), b3 + hstep, voffB);
            PG8_WAIT_V(6); PG8_BAR; PG8_MMA(1, 1, At, B1); PG8_BAR;
            }
        }
        if constexpr (ALIGN_EPI) { if (wr == 0) PG8_BAR; }
        if constexpr (!Epi::AFTER_DRAIN) { E(acc, cur, wr, wc, fr, fq); S.done(cur); }
        if (!has_next) break;
#pragma unroll
        for (int a = 0; a < 2; ++a)
#pragma unroll
            for (int b = 0; b < 2; ++b)
#pragma unroll
                for (int m = 0; m < 4; ++m)
#pragma unroll
                    for (int n = 0; n < 2; ++n) acc[a][b][m][n] = (f32x4){0.f, 0.f, 0.f, 0.f};
        cur = nxt; cA = nA; cB = nB; ++ui;
        if constexpr (ALIGN_EPI) { if (wr == 1) PG8_BAR; }
    }
    PG8_WAIT_V(0);
    if constexpr (!ALIGN_EPI) { if (wr == 0) PG8_BAR; }
    PG8_BAR;
    if constexpr (Epi::AFTER_DRAIN) { E.fused(acc, cur, wr, wc, fr, fq, lds, wid, lane); S.done(cur); }
#undef PG8_SA
#undef PG8_SB
#undef PG8_STAGE
#undef PG8_LDA
#undef PG8_LDB
#undef PG8_MMA
#undef PG8_WAIT_V
#undef PG8_WAIT_L
#undef PG8_BAR
#undef PG8_SCHED
}
}

constexpr int NWAVES = 8, NT = NWAVES * 64;
constexpr int BATCH = 2, SEQ = 4096, DM = 2048, M = BATCH * SEQ;
constexpr int DFF = 5632, NGU = 2 * DFF;
constexpr int INC = 6432, INP = 6656;
constexpr int AW = 1024, RW = 1024, NH = 16, HD = 64;
constexpr int PLE = 256;
constexpr int UQ = 0, UK = 1024, UV = 2048, UR = 3072;
constexpr float LN_EPS = 1e-5f, GN_EPS = 64e-5f;
constexpr float ALPHA = 1.189207115002721f;
constexpr float LOG2E = 1.4426950408889634f;

constexpr size_t MiB = 1u << 20;
constexpr size_t WS_CTL = 0, CTL_ZERO_BYTES = 1 * MiB;
constexpr size_t WS_WGU = 2 * MiB;
constexpr size_t WS_WD = 46 * MiB;
constexpr size_t WS_WIN = 68 * MiB;
constexpr size_t WS_WOUT = 94 * MiB;
constexpr size_t WS_WPG = 102 * MiB;
constexpr size_t WS_WPU = 110 * MiB;
constexpr size_t WS_SMALL = 111 * MiB;
constexpr size_t WS_XB = 112 * MiB;
constexpr size_t WS_BIG = 144 * MiB;
constexpr size_t WS_MIX = 248 * MiB;
constexpr size_t WS_SCAN = 280 * MiB;
constexpr size_t WS_PB = 392 * MiB;
constexpr size_t WS_END = 396 * MiB;
constexpr size_t SM_W2T = 0, SM_A2T = 131072, SM_G2T = 262144, SM_KMEAN = 655360;
constexpr size_t WS_BONUS = 1 * MiB;
static_assert(SM_G2T + 1024 * 192 * 2 <= SM_KMEAN && SM_KMEAN + 2 * 16 * 16 * 64 * 2 <= MiB, "small map");
constexpr int CW_TMO = 0, CW_BAR = 4096, CW_QUEUE = 8192;
constexpr size_t WS_STATS = 65536, WS_CVEC = 262144, WS_GB = 425984;
static_assert(WS_STATS + 3 * 2 * (size_t)M * 4 <= WS_CVEC && WS_CVEC + 2 * (size_t)(INP + NGU + DM) * 4 <= CTL_ZERO_BYTES, "control region map");

constexpr int RING_BYTES = 131072;
constexpr int LDSCTL_OFF = RING_BYTES, MISC_OFF = LDSCTL_OFF + 320;
constexpr int LDS_BYTES = 147456;

#define GAS __attribute__((address_space(1)))
#define LAS __attribute__((address_space(3)))
typedef unsigned short bf16;
typedef unsigned v4u __attribute__((ext_vector_type(4)));
typedef unsigned v2u __attribute__((ext_vector_type(2)));
typedef float f32x4 __attribute__((ext_vector_type(4)));
typedef float f32x16 __attribute__((ext_vector_type(16)));
typedef short bf16x8 __attribute__((ext_vector_type(8)));
typedef short s16x4 __attribute__((ext_vector_type(4)));
typedef GAS unsigned gu32;
#define RLX_AGENT __ATOMIC_RELAXED, __HIP_MEMORY_SCOPE_AGENT
#define LDS_WAIT() asm volatile("s_waitcnt lgkmcnt(0)" ::: "memory")
#define VM_WAIT() asm volatile("s_waitcnt vmcnt(0)" ::: "memory")
__device__ __forceinline__ unsigned f2bf(float f) { unsigned u = __builtin_bit_cast(unsigned, f); return (u + 0x7fffu + ((u >> 16) & 1u)) >> 16; }
__device__ __forceinline__ unsigned pk2(float lo, float hi) { return f2bf(lo) | (f2bf(hi) << 16); }
__device__ __forceinline__ float bf2f(unsigned short b) { return __uint_as_float((unsigned)b << 16); }
__device__ __forceinline__ float bflo(unsigned w) { return __uint_as_float(w << 16); }
__device__ __forceinline__ float bfhi(unsigned w) { return __uint_as_float(w & 0xffff0000u); }

#define XB_TMO      128
#define XB_XCNT(j)  (256  + 64 * (j))
#define XB_XSUB(j)  (1280 + 64 * (j))
#define XB_XGEN(j)  (2304 + 64 * (j))
#define XB_TOP      3328
#define XB_TOPGEN   3392
#define XCD_BAR_WORDS 3456
#define XB_SPIN_CAP (1u << 18)
__device__ __forceinline__ unsigned xb_ld(unsigned* p)              { return __hip_atomic_load(p, __ATOMIC_RELAXED, __HIP_MEMORY_SCOPE_AGENT); }
__device__ __forceinline__ unsigned xb_add(unsigned* p, unsigned v) { return __hip_atomic_fetch_add(p, v, __ATOMIC_RELAXED, __HIP_MEMORY_SCOPE_AGENT); }
__device__ __forceinline__ unsigned xb_xcc_id() { return (unsigned)__builtin_amdgcn_s_getreg((3 << 11) | 20) & 0xFu; }
#define XB_SPIN(cond, bar) do { unsigned _sp = 0; while (cond) { __builtin_amdgcn_s_sleep(1); \
    if ((++_sp & 255u) == 0u) { if (xb_ld(&(bar)[XB_TMO])) break; if (_sp > XB_SPIN_CAP) { atomicAdd(&(bar)[XB_TMO], 1u); break; } } } } while (0)
struct XcdBarrier { unsigned* bar; unsigned x; volatile LAS unsigned* st; };
__device__ __forceinline__ XcdBarrier xcd_barrier_post(unsigned* bar, volatile LAS unsigned* st) {
    XcdBarrier b; b.bar = bar; b.x = xb_xcc_id(); b.st = st;
    if (threadIdx.x == 0) (void)xb_add(&bar[XB_XCNT(b.x)], 1u);
    return b;
}
__device__ __forceinline__ void xcd_barrier_complete(unsigned* bar, unsigned x, unsigned& nloc, unsigned& nx) {
    const unsigned G = gridDim.x * gridDim.y * gridDim.z;
    unsigned sum, cnt, mine, sp = 0u;
    for (;;) {
        sum = 0u; cnt = 0u; mine = 0u;
#pragma unroll
        for (unsigned j = 0; j < 16; ++j) { const unsigned c = xb_ld(&bar[XB_XCNT(j)]); sum += c; cnt += (c > 0u) ? 1u : 0u; mine = (j == x) ? c : mine; }
        if (sum == G) break;
        __builtin_amdgcn_s_sleep(1);
        if ((++sp & 255u) == 0u) { if (xb_ld(&bar[XB_TMO])) break; if (sp > XB_SPIN_CAP) { atomicAdd(&bar[XB_TMO], 1u); break; } }
    }
    nloc = mine > 0u ? mine : 1u; nx = cnt > 0u ? cnt : 1u;
}
__device__ __forceinline__ void xcd_barrier(const XcdBarrier& b) {
    asm volatile("s_waitcnt vmcnt(0)" ::: "memory");
    __syncthreads();
    if (threadIdx.x == 0) {
        unsigned* bar = b.bar;
        __builtin_amdgcn_s_waitcnt(0);
        unsigned nloc = b.st[0], nx = b.st[1];
        if (nloc == 0u) { xcd_barrier_complete(bar, b.x, nloc, nx); b.st[0] = nloc; b.st[1] = nx; }
        const unsigned old = xb_add(&bar[XB_XSUB(b.x)], 1u);
        const unsigned gen = old / nloc;
        if (old + 1u == (gen + 1u) * nloc) {
            __builtin_amdgcn_fence(__ATOMIC_RELEASE, "agent");
            asm volatile("s_waitcnt vmcnt(0)" ::: "memory");
            const unsigned og = xb_add(&bar[XB_TOP], 1u);
            const unsigned tg = og / nx;
            if (og + 1u == (tg + 1u) * nx) xb_add(&bar[XB_TOPGEN], 1u);
            else XB_SPIN(xb_ld(&bar[XB_TOPGEN]) == tg, bar);
            __builtin_amdgcn_fence(__ATOMIC_ACQUIRE, "agent");
            xb_add(&bar[XB_XGEN(b.x)], 1u);
            asm volatile("s_waitcnt vmcnt(0)" ::: "memory");
        } else {
            XB_SPIN(xb_ld(&bar[XB_XGEN(b.x)]) == gen, bar);
            __builtin_amdgcn_fence(__ATOMIC_ACQUIRE, "agent");
            asm volatile("s_waitcnt vmcnt(0)" ::: "memory");
        }
    }
    __syncthreads();
}

struct Args { const float* in[33]; float* out; unsigned char* ws; int ph_lo, ph_hi; };
struct Frame {
    LAS unsigned char* lds;
    int tid, lane, wave, G, bid;
    const float* const* in;
    float* hz;
    unsigned char* ws;
};
__device__ __forceinline__ float wave_sum(float v) {
#pragma unroll
    for (int o = 1; o < 64; o <<= 1) v += __shfl_xor(v, o);
    return v;
}
__device__ __forceinline__ unsigned cvtpk(float lo, float hi) { typedef float f2 __attribute__((ext_vector_type(2))); typedef __bf16 b2 __attribute__((ext_vector_type(2))); f2 v = {lo, hi}; b2 b = __builtin_convertvector(v, b2); return __builtin_bit_cast(unsigned, b); }
__device__ __forceinline__ float swapmax(float m) { auto rr = __builtin_amdgcn_permlane32_swap(__float_as_uint(m), __float_as_uint(m), false, false); return fmaxf(__uint_as_float(rr[0]), __uint_as_float(rr[1])); }
__device__ __forceinline__ float swapsum(float m) { auto rr = __builtin_amdgcn_permlane32_swap(__float_as_uint(m), __float_as_uint(m), false, false); return __uint_as_float(rr[0]) + __uint_as_float(rr[1]); }

struct TrItem { f32x4 v[8]; };
__device__ __forceinline__ void tr_load(TrItem& T, const float* W, int Kvalid, int N, int k0, int n0, int lane) {
#pragma unroll
    for (int i = 0; i < 8; ++i) { const int kk = (lane >> 3) + 8 * i; T.v[i] = (f32x4){0.f, 0.f, 0.f, 0.f}; if (k0 + kk < Kvalid) T.v[i] = *(const GAS f32x4*)(W + (size_t)(k0 + kk) * N + n0 + 4 * (lane & 7)); }
}
template <bool LNF>
__device__ __forceinline__ void tr_store(const TrItem& T, bf16* WT, int ldo, int orow0, LAS float* scr, int k0, int lane, const float* gk, const float* bk, float* c1, float* c2) {
#pragma unroll
    for (int i = 0; i < 8; ++i) { const int kk = (lane >> 3) + 8 * i; LAS float* d = scr + kk * 33 + 4 * (lane & 7); d[0] = T.v[i][0]; d[1] = T.v[i][1]; d[2] = T.v[i][2]; d[3] = T.v[i][3]; }
    LDS_WAIT(); asm volatile("" ::: "memory");
    const int c = lane & 7;
    float gg[8], bb[8];
    if (LNF) { const f32x4 g0 = *(const GAS f32x4*)(gk + k0 + 8 * c), g1 = *(const GAS f32x4*)(gk + k0 + 8 * c + 4), b0 = *(const GAS f32x4*)(bk + k0 + 8 * c), b1 = *(const GAS f32x4*)(bk + k0 + 8 * c + 4);
#pragma unroll
        for (int i = 0; i < 4; ++i) { gg[i] = g0[i]; gg[4 + i] = g1[i]; bb[i] = b0[i]; bb[4 + i] = b1[i]; } }
#pragma unroll
    for (int j = 0; j < 4; ++j) { const int n = (lane >> 3) + 8 * j; const LAS float* s = scr + (8 * c) * 33 + n;
        float w[8];
#pragma unroll
        for (int i = 0; i < 8; ++i) w[i] = s[i * 33];
        float s1 = 0.f, s2 = 0.f;
        if (LNF) {
#pragma unroll
            for (int i = 0; i < 8; ++i) { s2 += bb[i] * w[i]; w[i] *= gg[i]; } }
        v4u o; o.x = pk2(w[0], w[1]); o.y = pk2(w[2], w[3]); o.z = pk2(w[4], w[5]); o.w = pk2(w[6], w[7]);
        *(GAS v4u*)(WT + (size_t)(orow0 + n) * ldo + k0 + 8 * c) = o;
        if (LNF) { s1 = (bflo(o.x) + bfhi(o.x)) + (bflo(o.y) + bfhi(o.y)) + (bflo(o.z) + bfhi(o.z)) + (bflo(o.w) + bfhi(o.w));
            s1 += __shfl_xor(s1, 1); s2 += __shfl_xor(s2, 1); s1 += __shfl_xor(s1, 2); s2 += __shfl_xor(s2, 2); s1 += __shfl_xor(s1, 4); s2 += __shfl_xor(s2, 4);
            if (c == 0) { atomicAdd(c1 + orow0 + n, s1); atomicAdd(c2 + orow0 + n, s2); } } }
    LDS_WAIT(); asm volatile("" ::: "memory");
}
template <bool LNF = false>
__device__ __forceinline__ void transpose_job(Frame& F, const float* W, int Kvalid, int Kpad, int N, bf16* WT, int ldo, int mode, int& base, const float* gk = nullptr, const float* bk = nullptr, float* c1 = nullptr, float* c2 = nullptr) {
    LAS float* scr = (LAS float*)(F.lds + F.wave * 16384);
    const int gw = F.bid * NWAVES + F.wave, NGW = F.G * NWAVES;
    const int nblk = N / 32, items = (Kpad / 64) * nblk;
    const int first = (gw - base % NGW + NGW) % NGW;
#define TR_DECODE(it, k0_, n0_, orow_) const int k0_ = 64 * ((it) / nblk), n0_ = 32 * ((it) % nblk), orow_ = (mode == 0) ? n0_ : ((n0_ >> 7) * 256 + (mode == 2 ? 128 : 0) + (n0_ & 127))
    TrItem A, B;
    int it = first;
    if (it < items) { TR_DECODE(it, k0, n0, orow); (void)orow; tr_load(A, W, Kvalid, N, k0, n0, F.lane); }
    while (it < items) {
        { const int nx = it + NGW; if (nx < items) { TR_DECODE(nx, k1, n1, orow1); (void)orow1; tr_load(B, W, Kvalid, N, k1, n1, F.lane); }
          TR_DECODE(it, k0, n0, orow); (void)n0; tr_store<LNF>(A, WT, ldo, orow, scr, k0, F.lane, gk, bk, c1, c2); it = nx; }
        if (it >= items) break;
        { const int nx = it + NGW; if (nx < items) { TR_DECODE(nx, k1, n1, orow1); (void)orow1; tr_load(A, W, Kvalid, N, k1, n1, F.lane); }
          TR_DECODE(it, k0, n0, orow); (void)n0; tr_store<LNF>(B, WT, ldo, orow, scr, k0, F.lane, gk, bk, c1, c2); it = nx; }
    }
#undef TR_DECODE
    base += items;
}
__device__ __forceinline__ void convert_bf16(Frame& F, const float* src, bf16* dst, size_t n) {
    const size_t gt = (size_t)F.bid * NT + F.tid, NGT = (size_t)F.G * NT, n8 = n / 8;
    for (size_t i = gt; i < n8; i += 4 * NGT) { f32x4 a[4], b[4];
#pragma unroll
        for (int u = 0; u < 4; ++u) if (i + u * NGT < n8) { a[u] = *(const GAS f32x4*)(src + (i + u * NGT) * 8); b[u] = *(const GAS f32x4*)(src + (i + u * NGT) * 8 + 4); }
#pragma unroll
        for (int u = 0; u < 4; ++u) if (i + u * NGT < n8) { v4u o; o.x = pk2(a[u][0], a[u][1]); o.y = pk2(a[u][2], a[u][3]); o.z = pk2(b[u][0], b[u][1]); o.w = pk2(b[u][2], b[u][3]); *(GAS v4u*)(dst + (i + u * NGT) * 8) = o; } }
}
template <bool LNF>
__device__ __forceinline__ void ffn_weights(Frame& F, int gi, int ui, int di, int& base, const float* gk = nullptr, const float* bk = nullptr, float* c1 = nullptr, float* c2 = nullptr) {
    transpose_job<LNF>(F, F.in[gi], DM, DM, DFF, (bf16*)(F.ws + WS_WGU), DM, 1, base, gk, bk, c1, c2);
    transpose_job<LNF>(F, F.in[ui], DM, DM, DFF, (bf16*)(F.ws + WS_WGU), DM, 2, base, gk, bk, c1, c2);
    transpose_job<false>(F, F.in[di], DFF, DFF, DM, (bf16*)(F.ws + WS_WD), DFF, 0, base);
}

template <bool WRITE_BF16>
__device__ __forceinline__ void ln_phase(Frame& F, float* hz, const float* g, const float* b, bf16* hb) {
    const int gw = F.bid * NWAVES + F.wave, NGW = F.G * NWAVES;
    f32x4 gv[8], bv[8];
#pragma unroll
    for (int j = 0; j < 8; ++j) { gv[j] = *(const GAS f32x4*)(g + F.lane * 4 + 256 * j); bv[j] = *(const GAS f32x4*)(b + F.lane * 4 + 256 * j); }
    for (int m = gw; m < M; m += NGW) {
        GAS f32x4* xr = (GAS f32x4*)(hz + (size_t)m * DM) + F.lane;
        f32x4 v[8]; float s = 0.f;
#pragma unroll
        for (int j = 0; j < 8; ++j) { v[j] = xr[64 * j]; s += (v[j][0] + v[j][1]) + (v[j][2] + v[j][3]); }
        const float mean = wave_sum(s) * (1.f / DM); float s2 = 0.f;
#pragma unroll
        for (int j = 0; j < 8; ++j) { v[j] = v[j] - mean; s2 += (v[j][0] * v[j][0] + v[j][1] * v[j][1]) + (v[j][2] * v[j][2] + v[j][3] * v[j][3]); }
        const float rstd = 1.f / sqrtf(wave_sum(s2) * (1.f / DM) + LN_EPS);
#pragma unroll
        for (int j = 0; j < 8; ++j) { v[j] = v[j] * rstd * gv[j] + bv[j]; xr[64 * j] = v[j]; }
        if (WRITE_BF16) { GAS v2u* o8 = (GAS v2u*)(hb + (size_t)m * DM) + F.lane;
#pragma unroll
            for (int j = 0; j < 8; ++j) { v2u w; w.x = pk2(v[j][0], v[j][1]); w.y = pk2(v[j][2], v[j][3]); o8[64 * j] = w; } }
    }
}

__device__ __forceinline__ int crow(int r, int hi) { return (r & 3) + 8 * (r >> 2) + 4 * hi; }
__device__ __forceinline__ float red32(float v) {
#pragma unroll
    for (int o = 1; o < 32; o <<= 1) v += __shfl_xor(v, o);
    return v;
}
__device__ __forceinline__ void kmean_tasks(Frame& F) {
    const bf16* ub = (const bf16*)(F.ws + WS_BIG); bf16* km = (bf16*)(F.ws + WS_SMALL + SM_KMEAN);
    if (F.wave >= 2) return;
    for (int task = F.bid * 2 + F.wave; task < BATCH * 16 * NH; task += F.G * 2) {
        const int b = task >> 8, blk = (task >> 4) & 15, h = task & 15;
        const int par = F.lane >> 5, dp = F.lane & 31;
        const GAS unsigned* p = (const GAS unsigned*)(ub + (size_t)(b * SEQ + blk * 256 + par) * INP + UK + h * HD) + dp;
        float lo[16], hi_[16];
#pragma unroll
        for (int u = 0; u < 16; ++u) { lo[u] = 0.f; hi_[u] = 0.f; }
#pragma unroll 1
        for (int i = 0; i < 128; i += 16) {
            unsigned wv[16];
#pragma unroll
            for (int u = 0; u < 16; ++u) wv[u] = p[(size_t)(2 * (i + u)) * (INP / 2)];
#pragma unroll
            for (int u = 0; u < 16; ++u) { lo[u] += bflo(wv[u]); hi_[u] += bfhi(wv[u]); }
        }
        float sl = 0.f, sh = 0.f;
#pragma unroll
        for (int u = 0; u < 16; ++u) { sl += lo[u]; sh += hi_[u]; }
        sl += __shfl_xor(sl, 32); sh += __shfl_xor(sh, 32);
        if (par == 0) *(GAS unsigned*)(km + ((b * NH + h) * 16 + blk) * HD + 2 * dp) = pk2(sl * (1.f / 256.f), sh * (1.f / 256.f));
    }
}
__device__ __forceinline__ void shifted4(const bf16* ucol  , bool first_is_seq_start, float mix, float (&o)[4]) {
    float pv = first_is_seq_start ? 0.f : bf2f(*(ucol - INP));
#pragma unroll
    for (int i = 0; i < 4; ++i) { const float c = bf2f(ucol[(size_t)i * INP]); o[i] = c + (pv - c) * mix; pv = c; }
}
constexpr int PA_W = 0, PA_A = 4608, PA_G = 9216, PA_PITCH = 144, PG_PITCH = 400;
__device__ __forceinline__ void prep_tile(Frame& F, int tile) {
    const bf16* ub = (const bf16*)(F.ws + WS_BIG);
    const int m0 = tile * 32;
    const float* shift_mix = F.in[9];
    LAS unsigned char* L = F.lds;
    for (int idx = F.tid; idx < 32 * 288; idx += NT) {
        const int t = idx / 288, k = idx - t * 288, m = m0 + t;
        const bf16* up = ub + (size_t)m * INP + UR + 3072 + k;
        const float cur = bf2f(*up), prev = ((m & (SEQ - 1)) == 0) ? 0.f : bf2f(*(up - INP));
        const float us = cur + (prev - cur) * shift_mix[3072 + k];
        if (k < 64) { const float e2 = __expf(2.f * us); *(LAS bf16*)(L + PA_W + t * PA_PITCH + k * 2) = (bf16)f2bf(1.f - 2.f / (e2 + 1.f)); }
        else if (k < 128) *(LAS bf16*)(L + PA_A + t * PA_PITCH + (k - 64) * 2) = (bf16)f2bf(us);
        else *(LAS bf16*)(L + PA_G + t * PG_PITCH + (k - 128) * 2) = (bf16)f2bf(1.f / (1.f + __expf(-us)));
    }
    for (int idx = F.tid; idx < 32 * 32; idx += NT) *(LAS bf16*)(L + PA_G + (idx >> 5) * PG_PITCH + (160 + (idx & 31)) * 2) = 0;
    __syncthreads();
    const bf16* w2t = (const bf16*)(F.ws + WS_SMALL + SM_W2T); const bf16* a2t = (const bf16*)(F.ws + WS_SMALL + SM_A2T); const bf16* g2t = (const bf16*)(F.ws + WS_SMALL + SM_G2T);
    const float *w0 = F.in[10], *a0 = F.in[12], *k_k = F.in[15], *k_a = F.in[16], *r_k = F.in[17];
    bf16* SR = (bf16*)(F.ws + WS_SCAN); bf16* SE = SR + (size_t)M * RW; bf16* SKP = SE + (size_t)M * RW; bf16* SV = SKP + (size_t)M * RW;
    bf16* SKK = SV + (size_t)M * RW; bf16* SBB = SKK + (size_t)M * RW; bf16* SGG = SBB + (size_t)M * RW;
    float* bonus = (float*)(F.ws + WS_BONUS);
    const int r32 = F.lane & 31, hi = F.lane >> 5;
    const bool seq0 = (m0 & (SEQ - 1)) == 0;
    for (int hp = 0; hp < 2; ++hp) {
        const int head = 2 * F.wave + hp;
        float n2[16], bon[16];
#pragma unroll
        for (int r = 0; r < 16; ++r) { n2[r] = 0.f; bon[r] = 0.f; }
        for (int nt = 0; nt < 2; ++nt) {
            const int c = head * 64 + 32 * nt + r32;
            f32x16 accA = {};
#pragma unroll
            for (int ks = 0; ks < 4; ++ks) { const bf16x8 af = *(const LAS bf16x8*)(L + PA_A + r32 * PA_PITCH + (16 * ks + 8 * hi) * 2); const bf16x8 bfr = *(const GAS bf16x8*)(a2t + c * 64 + 16 * ks + 8 * hi);
                accA = __builtin_amdgcn_mfma_f32_32x32x16_bf16(af, bfr, accA, 0, 0, 0); }
            const float a0c = a0[c], kkc = k_k[c], kac = k_a[c], rkc = r_k[c], mixr = shift_mix[c], mixk = shift_mix[1024 + c];
#pragma unroll
            for (int g = 0; g < 4; ++g) { const int tb = 8 * g + 4 * hi; float rr[4], kr[4];
                shifted4(ub + (size_t)(m0 + tb) * INP + UR + c, seq0 && tb == 0, mixr, rr);
                shifted4(ub + (size_t)(m0 + tb) * INP + UR + 1024 + c, seq0 && tb == 0, mixk, kr);
#pragma unroll
                for (int i = 0; i < 4; ++i) { const int r = 4 * g + i; const float a = 1.f / (1.f + __expf(-(a0c + accA[r])));
                    const float kq = kr[i] * kkc; n2[r] += kq * kq; bon[r] += rr[i] * kr[i] * (1.f + (a - 1.f) * kac) * rkc; } }
        }
        float inv[16];
#pragma unroll
        for (int r = 0; r < 16; ++r) { const float s = red32(n2[r]); inv[r] = 1.f / fmaxf(sqrtf(s), 1e-12f); bon[r] = red32(bon[r]); }
        if (r32 == 0) {
#pragma unroll
            for (int r = 0; r < 16; ++r) bonus[(size_t)(m0 + crow(r, hi)) * NH + head] = bon[r]; }
        for (int nt = 0; nt < 2; ++nt) {
            const int c = head * 64 + 32 * nt + r32;
            f32x16 accA = {}, accW = {}, accG = {};
#pragma unroll
            for (int ks = 0; ks < 4; ++ks) { const bf16x8 af = *(const LAS bf16x8*)(L + PA_A + r32 * PA_PITCH + (16 * ks + 8 * hi) * 2); const bf16x8 bfr = *(const GAS bf16x8*)(a2t + c * 64 + 16 * ks + 8 * hi);
                accA = __builtin_amdgcn_mfma_f32_32x32x16_bf16(af, bfr, accA, 0, 0, 0);
                const bf16x8 wf = *(const LAS bf16x8*)(L + PA_W + r32 * PA_PITCH + (16 * ks + 8 * hi) * 2); const bf16x8 bw = *(const GAS bf16x8*)(w2t + c * 64 + 16 * ks + 8 * hi);
                accW = __builtin_amdgcn_mfma_f32_32x32x16_bf16(wf, bw, accW, 0, 0, 0); }
#pragma unroll
            for (int ks = 0; ks < 12; ++ks) { const bf16x8 gf = *(const LAS bf16x8*)(L + PA_G + r32 * PG_PITCH + (16 * ks + 8 * hi) * 2); const bf16x8 bg = *(const GAS bf16x8*)(g2t + c * 192 + 16 * ks + 8 * hi);
                accG = __builtin_amdgcn_mfma_f32_32x32x16_bf16(gf, bg, accG, 0, 0, 0); }
            const float a0c = a0[c], w0c = w0[c], kkc = k_k[c], kac = k_a[c], mixr = shift_mix[c], mixk = shift_mix[1024 + c], mixv = shift_mix[2048 + c];
#pragma unroll
            for (int g = 0; g < 4; ++g) { const int tb = 8 * g + 4 * hi; float rr[4], kr[4], vr[4];
                shifted4(ub + (size_t)(m0 + tb) * INP + UR + c, seq0 && tb == 0, mixr, rr);
                shifted4(ub + (size_t)(m0 + tb) * INP + UR + 1024 + c, seq0 && tb == 0, mixk, kr);
                shifted4(ub + (size_t)(m0 + tb) * INP + UR + 2048 + c, seq0 && tb == 0, mixv, vr);
#pragma unroll
                for (int i = 0; i < 4; ++i) { const int r = 4 * g + i; const size_t o = (size_t)(m0 + tb + i) * RW + c;
                    const float a = 1.f / (1.f + __expf(-(a0c + accA[r])));
                    const float x = -(w0c + accW[r]);
                    const float sp = fmaxf(x, 0.f) + __logf(1.f + __expf(-fabsf(x)));
                    const float e = __expf(-sp - 0.5f);
                    const float kk = kr[i] * kkc * inv[r], kp = kr[i] * (1.f + (a - 1.f) * kac);
                    SR[o] = (bf16)f2bf(rr[i]); SE[o] = (bf16)f2bf(e); SKP[o] = (bf16)f2bf(kp); SV[o] = (bf16)f2bf(vr[i]);
                    SKK[o] = (bf16)f2bf(kk); SBB[o] = (bf16)f2bf(kk * a); SGG[o] = (bf16)f2bf(accG[r]); } }
        }
    }
    __syncthreads();
}

__device__ __forceinline__ s16x4 vtr(const LAS unsigned char* p) { typedef short v4i16_t __attribute__((ext_vector_type(4))); return __builtin_bit_cast(s16x4, __builtin_amdgcn_ds_read_tr16_b64_v4i16((LAS v4i16_t*)p)); }
constexpr int CP = 144, CMB = 64 * CP;
enum { C_AT = 0, C_BT, C_KT, C_RT, C_BP, C_KP, C_VV, C_Q0, C_Q1, C_X0, C_X1, C_AK, C_BR, C_KR, C_NSLOT };
static_assert(C_NSLOT * CMB <= RING_BYTES, "chunk pre-pass LDS");
constexpr int C_SMALL = 132096;
constexpr size_t CH_UNIT = 32768, CH_TT = 0, CH_PT = 8192, CH_HT = 16384, CH_YV = 24576;
__device__ __forceinline__ bf16x8 trfrag(const LAS unsigned char* Mt, int k0, int c0, int lane) {
    const LAS unsigned char* p = Mt + (k0 + 8 * (lane >> 5) + ((lane & 15) >> 2)) * CP + (c0 + 16 * ((lane >> 4) & 1) + 4 * (lane & 3)) * 2;
    const s16x4 lo = vtr(p), hh = vtr(p + 4 * CP);
    return (bf16x8){lo[0], lo[1], lo[2], lo[3], hh[0], hh[1], hh[2], hh[3]};
}
template <bool A_TR, bool B_TR>
__device__ __forceinline__ f32x16 tile_mm(const LAS unsigned char* A, int r0, const LAS unsigned char* B, int c0, f32x16 acc, int lane) {
    const int r32 = lane & 31, hi = lane >> 5;
#pragma unroll
    for (int ks = 0; ks < 4; ++ks) {
        const bf16x8 af = A_TR ? trfrag(A, 16 * ks, r0, lane) : *(const LAS bf16x8*)(A + (r0 + r32) * CP + (16 * ks + 8 * hi) * 2);
        const bf16x8 bf = B_TR ? trfrag(B, 16 * ks, c0, lane) : *(const LAS bf16x8*)(B + (c0 + r32) * CP + (16 * ks + 8 * hi) * 2);
        acc = __builtin_amdgcn_mfma_f32_32x32x16_bf16(af, bf, acc, 0, 0, 0);
    }
    return acc;
}
__device__ __forceinline__ void tile_store_lds(LAS unsigned char* Z, int r0, int c0, const f32x16& v, int lane) {
    const int r32 = lane & 31, hi = lane >> 5;
#pragma unroll
    for (int r = 0; r < 16; ++r) *(LAS bf16*)(Z + (r0 + crow(r, hi)) * CP + (c0 + r32) * 2) = (bf16)f2bf(v[r]);
}
__device__ __forceinline__ void tile_store_glb_t(bf16* G, int r0, int c0, const f32x16& v, int lane) {
    const int r32 = lane & 31, hi = lane >> 5;
#pragma unroll
    for (int g = 0; g < 4; ++g) { v2u w; w.x = pk2(v[4 * g], v[4 * g + 1]); w.y = pk2(v[4 * g + 2], v[4 * g + 3]);
        *(GAS v2u*)(G + (size_t)(c0 + r32) * 64 + r0 + 8 * g + 4 * hi) = w; }
}
constexpr int RAW_R = C_AT, RAW_K = C_BT, RAW_V = C_KT, RAW_E = C_RT, RAW_KK = C_BP, RAW_BB = C_KP, RAW_KP = C_VV, ACT_W = C_Q0, ACT_A = C_Q1, ACT_G = C_X0;
constexpr int GPITCH = 400, C_PART = C_SMALL + 2048 + 256;
static_assert(64 * GPITCH <= 3 * CMB, "gate activations fit three slots");
constexpr size_t VG_UNIT = 16384, VG_VS = 0, VG_GG = 8192;
#define LBAR() do { asm volatile("s_waitcnt lgkmcnt(0)" ::: "memory"); __builtin_amdgcn_s_barrier(); asm volatile("" ::: "memory"); } while (0)
#ifndef DUP_U1
#define DUP_U1 1
#endif
#ifndef DUP_U2
#define DUP_U2 1
#endif
#ifndef DUP_S1
#define DUP_S1 1
#endif
#ifndef DUP_S3
#define DUP_S3 1
#endif
#ifndef DUP_S4
#define DUP_S4 1
#endif
#ifndef DUP_S5
#define DUP_S5 1
#endif
__device__ __forceinline__ void chunk_prepass(Frame& F, int unit) {
    const int bh = unit >> 6, c = unit & 63, b = bh >> 4, h = bh & 15;
    const size_t m0 = (size_t)b * SEQ + (size_t)c * 64;
    const bf16* ub = (const bf16*)(F.ws + WS_BIG);
    LAS unsigned char* L = F.lds;
    LAS float* totals = (LAS float*)(L + C_SMALL); LAS float* gend = totals + 512; LAS float* part = (LAS float*)(L + C_PART);
    bf16* CH = (bf16*)(F.ws + WS_WGU + (size_t)unit * CH_UNIT);
    bf16* VG = (bf16*)(F.ws + WS_SCAN + (size_t)unit * VG_UNIT);
    const int lane = F.lane, w = F.wave, r32 = lane & 31, hi = lane >> 5;
    const float* shift_mix = F.in[9];
_Pragma("unroll 1") for (int rep_ = 0; rep_ < DUP_U1; ++rep_)
    {
        const int p = F.tid & 31, t16 = F.tid >> 5;
        const GAS unsigned* ubase = (const GAS unsigned*)(ub + m0 * INP + UR);
        const int prev0 = (c == 0) ? 0 : -(INP / 2);
        unsigned cu[4][3], pv[4][3];
#pragma unroll
        for (int pass = 0; pass < 4; ++pass) { const int t = t16 + 16 * pass; const int ro = t * (INP / 2), rp = (t == 0) ? prev0 : ro - (INP / 2);
#pragma unroll
            for (int a = 0; a < 3; ++a) { const int co = (a * 1024 + h * HD) / 2 + p; cu[pass][a] = ubase[ro + co]; pv[pass][a] = ubase[rp + co]; } }
        float mx[3][2];
#pragma unroll
        for (int a = 0; a < 3; ++a) { mx[a][0] = shift_mix[a * 1024 + h * HD + 2 * p]; mx[a][1] = shift_mix[a * 1024 + h * HD + 2 * p + 1]; }
#pragma unroll 1
        for (int half = 0; half < 2; ++half) {
            unsigned cl[9], pl[9];
#pragma unroll
            for (int n = 0; n < 9; ++n) { const int idx = F.tid + NT * (9 * half + n), t = idx / 144, pp = idx - 144 * t; const int ro = t * (INP / 2), rp = (t == 0) ? prev0 : ro - (INP / 2);
                cl[n] = ubase[ro + 1536 + pp]; pl[n] = ubase[rp + 1536 + pp]; }
            if (half == 0) {
#pragma unroll
                for (int pass = 0; pass < 4; ++pass) { const int t = t16 + 16 * pass; const bool first = (c == 0 && t == 0);
#pragma unroll
                    for (int a = 0; a < 3; ++a) { const unsigned cu_ = cu[pass][a], pv_ = first ? 0u : pv[pass][a];
                        const float lo = bflo(cu_) + (bflo(pv_) - bflo(cu_)) * mx[a][0], hi_ = bfhi(cu_) + (bfhi(pv_) - bfhi(cu_)) * mx[a][1];
                        *(LAS unsigned*)(L + (a == 0 ? RAW_R : a == 1 ? RAW_K : RAW_V) * CMB + t * CP + p * 4) = cvtpk(lo, hi_); } } }
#pragma unroll
            for (int n = 0; n < 9; ++n) { const int idx = F.tid + NT * (9 * half + n), t = idx / 144, pp = idx - 144 * t; const bool first = (c == 0 && t == 0);
                const unsigned cu_ = cl[n], pv_ = first ? 0u : pl[n];
                const float m0_ = shift_mix[3072 + 2 * pp], m1_ = shift_mix[3072 + 2 * pp + 1];
                float lo = bflo(cu_) + (bflo(pv_) - bflo(cu_)) * m0_, hi_ = bfhi(cu_) + (bfhi(pv_) - bfhi(cu_)) * m1_;
                if (pp < 32) { lo = 1.f - 2.f / (__expf(2.f * lo) + 1.f); hi_ = 1.f - 2.f / (__expf(2.f * hi_) + 1.f); *(LAS unsigned*)(L + ACT_W * CMB + t * CP + pp * 4) = cvtpk(lo, hi_); }
                else if (pp < 64) *(LAS unsigned*)(L + ACT_A * CMB + t * CP + (pp - 32) * 4) = cvtpk(lo, hi_);
                else { lo = 1.f / (1.f + __expf(-lo)); hi_ = 1.f / (1.f + __expf(-hi_)); *(LAS unsigned*)(L + ACT_G * CMB + t * GPITCH + (pp - 64) * 4) = cvtpk(lo, hi_); } }
        }
        for (int idx = F.tid; idx < 64 * 16; idx += NT) *(LAS unsigned*)(L + ACT_G * CMB + (idx >> 4) * GPITCH + (80 + (idx & 15)) * 4) = 0u;
        LBAR();
    }
_Pragma("unroll 1") for (int rep_ = 0; rep_ < DUP_U2; ++rep_)
    {
        const int tr = (w >> 1) & 1, tc = w & 1, t = 32 * tc + r32;
        const bf16* w2t = (const bf16*)(F.ws + WS_SMALL + SM_W2T); const bf16* a2t = (const bf16*)(F.ws + WS_SMALL + SM_A2T); const bf16* g2t = (const bf16*)(F.ws + WS_SMALL + SM_G2T);
        float a_[16], kq_[16];
        if (w < 4) {
            f32x16 accW = {}, accA = {};
#pragma unroll
            for (int ks = 0; ks < 4; ++ks) { const bf16x8 bw = *(const LAS bf16x8*)(L + ACT_W * CMB + t * CP + (16 * ks + 8 * hi) * 2), ba = *(const LAS bf16x8*)(L + ACT_A * CMB + t * CP + (16 * ks + 8 * hi) * 2);
                const bf16x8 aw = *(const GAS bf16x8*)(w2t + (h * HD + 32 * tr + r32) * 64 + 16 * ks + 8 * hi), aa = *(const GAS bf16x8*)(a2t + (h * HD + 32 * tr + r32) * 64 + 16 * ks + 8 * hi);
                accW = __builtin_amdgcn_mfma_f32_32x32x16_bf16(aw, bw, accW, 0, 0, 0); accA = __builtin_amdgcn_mfma_f32_32x32x16_bf16(aa, ba, accA, 0, 0, 0); }
            const float *w0 = F.in[10], *a0 = F.in[12], *k_k = F.in[15], *k_a = F.in[16], *r_k = F.in[17];
            float n2 = 0.f, bon = 0.f;
#pragma unroll
            for (int g = 0; g < 4; ++g) { const int jb = 32 * tr + 8 * g + 4 * hi;
                const v2u rw_ = *(const LAS v2u*)(L + RAW_R * CMB + t * CP + jb * 2), kw_ = *(const LAS v2u*)(L + RAW_K * CMB + t * CP + jb * 2);
                const float rr[4] = {bflo(rw_.x), bfhi(rw_.x), bflo(rw_.y), bfhi(rw_.y)}, kr[4] = {bflo(kw_.x), bfhi(kw_.x), bflo(kw_.y), bfhi(kw_.y)};
                const f32x4 w0v = *(const GAS f32x4*)(w0 + h * HD + jb), a0v = *(const GAS f32x4*)(a0 + h * HD + jb), kkv = *(const GAS f32x4*)(k_k + h * HD + jb), kav = *(const GAS f32x4*)(k_a + h * HD + jb), rkv = *(const GAS f32x4*)(r_k + h * HD + jb);
                float e4[4], kp4[4];
#pragma unroll
                for (int i = 0; i < 4; ++i) { const int r = 4 * g + i;
                    const float a = 1.f / (1.f + __expf(-(a0v[i] + accA[r])));
                    const float x = -(w0v[i] + accW[r]); const float sp = fmaxf(x, 0.f) + __logf(1.f + __expf(-fabsf(x)));
                    e4[i] = __expf(-sp - 0.5f);
                    const float kq = kr[i] * kkv[i]; kp4[i] = kr[i] * (1.f + (a - 1.f) * kav[i]);
                    n2 += kq * kq; bon += rr[i] * kp4[i] * rkv[i]; a_[r] = a; kq_[r] = kq; }
                v2u ew, kw2; ew.x = cvtpk(e4[0], e4[1]); ew.y = cvtpk(e4[2], e4[3]); kw2.x = cvtpk(kp4[0], kp4[1]); kw2.y = cvtpk(kp4[2], kp4[3]);
                *(LAS v2u*)(L + RAW_E * CMB + t * CP + jb * 2) = ew; *(LAS v2u*)(L + RAW_KP * CMB + t * CP + jb * 2) = kw2; }
            n2 = swapsum(n2); bon = swapsum(bon);
            if (hi == 0) { part[tr * 64 + t] = n2; part[128 + tr * 64 + t] = bon; }
        } else {
            f32x16 accG = {};
#pragma unroll
            for (int ks = 0; ks < 12; ++ks) { const bf16x8 bg = *(const LAS bf16x8*)(L + ACT_G * CMB + t * GPITCH + (16 * ks + 8 * hi) * 2);
                const bf16x8 ag = *(const GAS bf16x8*)(g2t + (h * HD + 32 * tr + r32) * 192 + 16 * ks + 8 * hi);
                accG = __builtin_amdgcn_mfma_f32_32x32x16_bf16(ag, bg, accG, 0, 0, 0); }
            tile_store_glb_t(VG + VG_GG / 2, 32 * tr, 32 * tc, accG, lane);
        }
        LBAR();
        if (w < 4) {
            const float n2t = part[t] + part[64 + t], bont = part[128 + t] + part[192 + t];
            const float inv = 1.f / fmaxf(sqrtf(n2t), 1e-12f);
            if (tr == 0 && hi == 0) ((float*)(F.ws + WS_BONUS))[(m0 + t) * NH + h] = bont;
#pragma unroll
            for (int g = 0; g < 4; ++g) { const int jb = 32 * tr + 8 * g + 4 * hi; float kk4[4], bb4[4];
#pragma unroll
                for (int i = 0; i < 4; ++i) { kk4[i] = kq_[4 * g + i] * inv; bb4[i] = kk4[i] * a_[4 * g + i]; }
                v2u kw_, bw_; kw_.x = cvtpk(kk4[0], kk4[1]); kw_.y = cvtpk(kk4[2], kk4[3]); bw_.x = cvtpk(bb4[0], bb4[1]); bw_.y = cvtpk(bb4[2], bb4[3]);
                *(LAS v2u*)(L + RAW_KK * CMB + t * CP + jb * 2) = kw_; *(LAS v2u*)(L + RAW_BB * CMB + t * CP + jb * 2) = bw_; }
        }
        LBAR();
    }
    {
        const int j = F.tid & 63, tg = F.tid >> 6;
        float r_[8], e_[8], kp_[8], v_[8], kk_[8], bb_[8];
#pragma unroll
        for (int i = 0; i < 8; ++i) { const int o = (8 * tg + i) * CP + j * 2;
            r_[i] = bf2f(*(const LAS bf16*)(L + RAW_R * CMB + o)); e_[i] = bf2f(*(const LAS bf16*)(L + RAW_E * CMB + o)); kp_[i] = bf2f(*(const LAS bf16*)(L + RAW_KP * CMB + o));
            v_[i] = bf2f(*(const LAS bf16*)(L + RAW_V * CMB + o)); kk_[i] = bf2f(*(const LAS bf16*)(L + RAW_KK * CMB + o)); bb_[i] = bf2f(*(const LAS bf16*)(L + RAW_BB * CMB + o)); }
        float cs[8]; cs[0] = e_[0];
#pragma unroll
        for (int i = 1; i < 8; ++i) cs[i] = cs[i - 1] + e_[i];
        totals[tg * 64 + j] = cs[7];
        LBAR();
        float pre = 0.f, tot = 0.f;
#pragma unroll
        for (int g = 0; g < 8; ++g) { const float t_ = totals[g * 64 + j]; tot += t_; if (g < tg) pre += t_; }
        if (tg == 0) gend[j] = __expf(-tot);
#pragma unroll
        for (int i = 0; i < 8; ++i) { const int t = 8 * tg + i; const float ct = pre + cs[i];
            const float Gt = __expf(-ct), Gp = __expf(-(ct - e_[i])), iG = __expf(ct), gE = __expf(ct - tot);
            const int o = t * CP + j * 2;
            *(LAS bf16*)(L + C_AT * CMB + o) = (bf16)f2bf(-kk_[i] * Gp);
            *(LAS bf16*)(L + C_BT * CMB + o) = (bf16)f2bf(bb_[i] * iG);
            *(LAS bf16*)(L + C_KT * CMB + o) = (bf16)f2bf(kp_[i] * iG);
            *(LAS bf16*)(L + C_RT * CMB + o) = (bf16)f2bf(r_[i] * Gt);
            *(LAS bf16*)(L + C_BP * CMB + o) = (bf16)f2bf(bb_[i] * gE);
            *(LAS bf16*)(L + C_KP * CMB + o) = (bf16)f2bf(kp_[i] * gE);
            *(LAS bf16*)(L + C_VV * CMB + o) = (bf16)f2bf(v_[i]);
            *(LAS bf16*)(L + C_X0 * CMB + o) = (t == j) ? (bf16)0x3f80 : (bf16)0;
            VG[VG_VS / 2 + t * 64 + j] = (bf16)f2bf(v_[i]); }
        LBAR();
    }
_Pragma("unroll 1") for (int rep_ = 0; rep_ < DUP_S1; ++rep_)
    {
        const int p = w >> 1, tr = w & 1;
        const LAS unsigned char* A = L + ((p & 1) ? C_KT : C_BT) * CMB; const LAS unsigned char* B = L + ((p >> 1) ? C_RT : C_AT) * CMB;
        LAS unsigned char* Z = L + (p == 0 ? C_Q0 : p == 1 ? C_AK : p == 2 ? C_BR : C_KR) * CMB;
#pragma unroll
        for (int tc = 0; tc < 2; ++tc) { f32x16 acc = {};
            if (tr <= tc) { acc = tile_mm<false, false>(A, 32 * tr, B, 32 * tc, acc, lane);
#pragma unroll
                for (int r = 0; r < 16; ++r) { const int s_ = 32 * tr + crow(r, hi), t_ = 32 * tc + r32; const bool keep = (p < 2) ? (s_ < t_) : (s_ <= t_); acc[r] = keep ? acc[r] : 0.f; } }
            tile_store_lds(Z, 32 * tr, 32 * tc, acc, lane); }
        LBAR();
    }
    {
        const int tr = (w >> 1) & 1, tc = w & 1; f32x16 xacc = {};
        if (w < 4 && tr == tc) {
#pragma unroll
            for (int r = 0; r < 16; ++r) xacc[r] = (crow(r, hi) == r32) ? 1.f : 0.f; }
#pragma unroll 1
        for (int k = 0; k < 6; ++k) {
            const LAS unsigned char* Xc = L + ((k & 1) ? C_X1 : C_X0) * CMB; const LAS unsigned char* Qc = L + ((k & 1) ? C_Q1 : C_Q0) * CMB;
            LAS unsigned char* Xn = L + ((k & 1) ? C_X0 : C_X1) * CMB; LAS unsigned char* Qn = L + ((k & 1) ? C_Q0 : C_Q1) * CMB;
            if (w < 4) { if (tr <= tc) xacc = tile_mm<false, true>(Xc, 32 * tr, Qc, 32 * tc, xacc, lane);
                tile_store_lds(Xn, 32 * tr, 32 * tc, xacc, lane); }
            else if (k < 5) { f32x16 q = {}; if (tr <= tc) q = tile_mm<false, true>(Qc, 32 * tr, Qc, 32 * tc, q, lane);
                tile_store_lds(Qn, 32 * tr, 32 * tc, q, lane); }
            LBAR();
        }
    }
_Pragma("unroll 1") for (int rep_ = 0; rep_ < DUP_S3; ++rep_)
    {
        const int tr = (w >> 1) & 1, tc = w & 1; f32x16 acc = {};
        if (w < 4) { acc = tile_mm<true, true>(L + C_AT * CMB, 32 * tr, L + C_X0 * CMB, 32 * tc, acc, lane); tile_store_lds(L + C_BT * CMB, 32 * tr, 32 * tc, acc, lane); }
        else { if (tr <= tc) acc = tile_mm<false, true>(L + C_AK * CMB, 32 * tr, L + C_X0 * CMB, 32 * tc, acc, lane); tile_store_lds(L + C_KT * CMB, 32 * tr, 32 * tc, acc, lane); }
        LBAR();
    }
_Pragma("unroll 1") for (int rep_ = 0; rep_ < DUP_S4; ++rep_)
    {
        const int p = w >> 1, tr = w & 1;
        const LAS unsigned char* A = L + ((p & 1) ? C_KT : C_BT) * CMB; const LAS unsigned char* B = L + ((p >> 1) ? C_BR : C_BP) * CMB;
#pragma unroll
        for (int tc = 0; tc < 2; ++tc) { f32x16 acc = {};
            acc = tile_mm<false, true>(A, 32 * tr, B, 32 * tc, acc, lane);
            if (p == 0) {
#pragma unroll
                for (int r = 0; r < 16; ++r) if (32 * tr + crow(r, hi) == 32 * tc + r32) acc[r] += gend[32 * tc + r32];
                tile_store_glb_t(CH + CH_TT / 2, 32 * tr, 32 * tc, acc, lane);
            } else if (p == 1) {
#pragma unroll
                for (int r = 0; r < 16; ++r) acc[r] += bf2f(*(const LAS bf16*)(L + C_KP * CMB + (32 * tr + crow(r, hi)) * CP + (32 * tc + r32) * 2));
                tile_store_lds(L + C_Q0 * CMB, 32 * tr, 32 * tc, acc, lane);
            } else if (p == 2) {
#pragma unroll
                for (int g = 0; g < 4; ++g) { const v2u rw_ = *(const LAS v2u*)(L + C_RT * CMB + (32 * tc + r32) * CP + (32 * tr + 8 * g + 4 * hi) * 2);
                    acc[4 * g] += bflo(rw_.x); acc[4 * g + 1] += bfhi(rw_.x); acc[4 * g + 2] += bflo(rw_.y); acc[4 * g + 3] += bfhi(rw_.y); }
                tile_store_glb_t(CH + CH_PT / 2, 32 * tr, 32 * tc, acc, lane);
            } else {
#pragma unroll
                for (int r = 0; r < 16; ++r) acc[r] += bf2f(*(const LAS bf16*)(L + C_KR * CMB + (32 * tr + crow(r, hi)) * CP + (32 * tc + r32) * 2));
                tile_store_lds(L + C_Q1 * CMB, 32 * tr, 32 * tc, acc, lane);
            } }
        LBAR();
    }
_Pragma("unroll 1") for (int rep_ = 0; rep_ < DUP_S5; ++rep_)
    {
        const int tr = (w >> 1) & 1, tc = w & 1; f32x16 acc = {};
        acc = tile_mm<true, true>(L + C_VV * CMB, 32 * tr, L + ((w < 4) ? C_Q0 : C_Q1) * CMB, 32 * tc, acc, lane);
        tile_store_glb_t(CH + ((w < 4) ? CH_HT : CH_YV) / 2, 32 * tr, 32 * tc, acc, lane);
        LBAR();
    }
}
__device__ __forceinline__ void chunk_scan(Frame& F, int bh) {
    const int b = bh >> 4, h = bh & 15;
    LAS unsigned char* L = F.lds;
    float* Y = (float*)(F.ws + WS_XB);
    const int lane = F.lane, w = F.wave, r32 = lane & 31, hi = lane >> 5;
    const int tr = (w >> 1) & 1, tc = w & 1; const bool isS = w < 4;
    for (int i = F.tid; i < 2 * CMB / 4; i += NT) ((LAS unsigned*)L)[i] = 0u;
    const bf16* CHb = (const bf16*)(F.ws + WS_WGU + (size_t)(bh * 64) * CH_UNIT);
    const bf16* Bsrc = CHb + (isS ? CH_TT : CH_PT) / 2 + (size_t)(32 * tc + r32) * 64 + 8 * hi;
    const bf16* Csrc = CHb + (isS ? CH_HT : CH_YV) / 2 + (size_t)(32 * tc + r32) * 64 + 32 * tr + 4 * hi;
    bf16x8 bf0[4], bf1[4], bf2[4], bf3[4]; v2u ci0[4], ci1[4], ci2[4], ci3[4];
#define CS_LOAD(BF, CI, cc) do { _Pragma("unroll") for (int ks = 0; ks < 4; ++ks) BF[ks] = *(const GAS bf16x8*)(Bsrc + (size_t)(cc) * (CH_UNIT / 2) + 16 * ks); \
        _Pragma("unroll") for (int g = 0; g < 4; ++g) CI[g] = *(const GAS v2u*)(Csrc + (size_t)(cc) * (CH_UNIT / 2) + 8 * g); } while (0)
#define CS_STEP(BF, CI, c) do { \
        const LAS unsigned char* Sc = L + ((c) & 1) * CMB; LAS unsigned char* Sn = L + (((c) & 1) ^ 1) * CMB; \
        f32x16 acc; \
        _Pragma("unroll") for (int g = 0; g < 4; ++g) { acc[4 * g] = bflo(CI[g].x); acc[4 * g + 1] = bfhi(CI[g].x); acc[4 * g + 2] = bflo(CI[g].y); acc[4 * g + 3] = bfhi(CI[g].y); } \
        _Pragma("unroll") for (int ks = 0; ks < 4; ++ks) acc = __builtin_amdgcn_mfma_f32_32x32x16_bf16(trfrag(Sc, 16 * ks, 32 * tr, lane), BF[ks], acc, 0, 0, 0); \
        if ((c) + 4 < 64) CS_LOAD(BF, CI, (c) + 4); \
        if (isS) { \
            _Pragma("unroll") for (int g = 0; g < 4; ++g) { v2u o; o.x = pk2(acc[4 * g], acc[4 * g + 1]); o.y = pk2(acc[4 * g + 2], acc[4 * g + 3]); \
                *(LAS v2u*)(Sn + (32 * tc + r32) * CP + (32 * tr + 8 * g + 4 * hi) * 2) = o; } \
        } else { \
            float* yp = Y + ((size_t)b * SEQ + (size_t)(c) * 64 + 32 * tc + r32) * RW + h * HD + 32 * tr + 4 * hi; \
            _Pragma("unroll") for (int g = 0; g < 4; ++g) *(GAS f32x4*)(yp + 8 * g) = (f32x4){acc[4 * g], acc[4 * g + 1], acc[4 * g + 2], acc[4 * g + 3]}; \
        } \
        asm volatile("s_waitcnt lgkmcnt(0)" ::: "memory"); __builtin_amdgcn_s_barrier(); asm volatile("" ::: "memory"); } while (0)
    CS_LOAD(bf0, ci0, 0); CS_LOAD(bf1, ci1, 1); CS_LOAD(bf2, ci2, 2); CS_LOAD(bf3, ci3, 3);
    __syncthreads();
#pragma unroll 1
    for (int c = 0; c < 64; c += 4) { CS_STEP(bf0, ci0, c); CS_STEP(bf1, ci1, c + 1); CS_STEP(bf2, ci2, c + 2); CS_STEP(bf3, ci3, c + 3); }
    __syncthreads();
#undef CS_STEP
#undef CS_LOAD
}
__device__ __forceinline__ void rw_finalize(Frame& F) {
    const int gw = F.bid * NWAVES + F.wave, NGW = F.G * NWAVES;
    const float* Y = (const float*)(F.ws + WS_XB); const bf16* VGb = (const bf16*)(F.ws + WS_SCAN);
    const float* bonus = (const float*)(F.ws + WS_BONUS); bf16* mix = (bf16*)(F.ws + WS_MIX);
    const float *gn_g = F.in[18], *gn_b = F.in[19];
    for (int m = gw; m < M; m += NGW) { const int b = m / SEQ, ts = m % SEQ;
        for (int h = 0; h < NH; ++h) { const int c = h * HD + F.lane; const size_t o = (size_t)m * RW + c;
            const bf16* vg = VGb + ((size_t)((b * NH + h) * 64 + (ts >> 6)) * VG_UNIT) / 2 + (ts & 63) * 64 + F.lane;
            const float y = Y[o]; const float mu = wave_sum(y) * (1.f / HD); const float d = y - mu; const float var = wave_sum(d * d) * (1.f / HD);
            const float yn = d * (1.f / sqrtf(var + GN_EPS)) * gn_g[c] + gn_b[c];
            const float val = (yn + bonus[(size_t)m * NH + h] * bf2f(vg[VG_VS / 2])) * bf2f(vg[VG_GG / 2]);
            mix[(size_t)m * DM + AW + c] = (bf16)f2bf(val); }
    }
}

constexpr int AT_K = 0, AT_V = 16384, AT_WS = 32768, AT_GATE = 34816, AT_TAB = 51200, AT_OST = 52224, AT_BYTES = AT_OST + 8 * 4096;
__device__ __forceinline__ int rel_bucket_i(int d) {
    if (d < 16) return d;
    return 16 + (d >= 19) + (d >= 21) + (d >= 24) + (d >= 27) + (d >= 31) + (d >= 35) + (d >= 40) + (d >= 46) + (d >= 52) + (d >= 59) + (d >= 67) + (d >= 77) + (d >= 87) + (d >= 99) + (d >= 113);
}

__device__ __forceinline__ void attn_unit(Frame& F, int b, int h, int qb) {
    const bf16* ub = (const bf16*)(F.ws + WS_BIG); const bf16* km = (const bf16*)(F.ws + WS_SMALL + SM_KMEAN); bf16* mix = (bf16*)(F.ws + WS_MIX);
    const float* rel_bias = F.in[8];
    LAS unsigned char* L = F.lds;
    const int lane = F.lane, wid = F.wave, r32 = lane & 31, hi = lane >> 5;
    const size_t mb = (size_t)b * SEQ;
    const int q0 = qb * 256;
    LAS float* tab = (LAS float*)(L + AT_TAB);
    LAS float* wsf = (LAS float*)(L + AT_WS) + wid * 64;
    constexpr float C2 = 0.125f * LOG2E;
    if (F.tid < 129) tab[F.tid] = rel_bias[rel_bucket_i(F.tid) * NH + h] * LOG2E;
    bf16x8 qr[4];
    { const bf16* Qw = ub + (mb + q0 + wid * 32 + r32) * INP + UQ + h * HD;
#pragma unroll
      for (int d0 = 0; d0 < 4; ++d0) qr[d0] = *(const GAS bf16x8*)(Qw + d0 * 16 + hi * 8); }
    unsigned sel = 0u;
    if (qb > 0) {
        f32x16 g = {};
        const bf16* kmp = km + ((size_t)(b * NH + h) * 16 + (r32 & 15)) * HD;
#pragma unroll
        for (int d0 = 0; d0 < 4; ++d0) { const bf16x8 kf = *(const GAS bf16x8*)(kmp + d0 * 16 + hi * 8); g = __builtin_amdgcn_mfma_f32_32x32x16_bf16(kf, qr[d0], g, 0, 0, 0); }
        LAS float* gs = (LAS float*)(L + AT_GATE) + wid * 512;
#pragma unroll
        for (int r = 0; r < 8; ++r) gs[r32 * 16 + crow(r, hi)] = g[r];
        LDS_WAIT(); asm volatile("" ::: "memory");
        float gv[16];
#pragma unroll
        for (int i = 0; i < 4; ++i) { const f32x4 t = *(const LAS f32x4*)(gs + r32 * 16 + 4 * i); gv[4 * i] = t[0]; gv[4 * i + 1] = t[1]; gv[4 * i + 2] = t[2]; gv[4 * i + 3] = t[3]; }
#pragma unroll
        for (int pass = 0; pass < 3; ++pass) { float best = -INFINITY; int bi = -1;
#pragma unroll
            for (int n = 0; n < 16; ++n) { const bool ok = (n < qb) && !((sel >> n) & 1u) && (gv[n] > best); if (ok) { best = gv[n]; bi = n; } }
            if (bi >= 0) sel |= 1u << bi; }
    }
    const bf16* ksrc = ub + (mb + lane) * INP + UK + h * HD + wid * 8;
    const bf16* vsrc = ub + (mb + 16 * (wid & 3) + (lane >> 2)) * INP + UV + h * HD + (wid >> 2) * 32 + (lane & 3) * 8;
    const int stoff = wid * 1024 + lane * 16;
    const int NTILE = 4 * (qb + 1);
    v4u kreg, vreg;
    kreg = *(const GAS v4u*)(ksrc); vreg = *(const GAS v4u*)(vsrc);
    __syncthreads();
    *(LAS v4u*)(L + AT_K + stoff) = kreg; *(LAS v4u*)(L + AT_V + stoff) = vreg;
    __syncthreads();
    float mrun = -INFINITY, lrun = 0.f; f32x16 o[2]; o[0] = f32x16{}; o[1] = f32x16{};
    const float c31 = tab[128];
    for (int jt = 0; jt < NTILE; ++jt) {
        const int cur = jt & 1;
        if (jt + 1 < NTILE) { kreg = *(const GAS v4u*)(ksrc + (size_t)(jt + 1) * 64 * INP); vreg = *(const GAS v4u*)(vsrc + (size_t)(jt + 1) * 64 * INP); }
        const int n = jt >> 2;
        const int dbase = 256 * (qb - n) + 32 * wid - 64 * (jt & 3);
        const bool lane_ok = (n == qb) || ((sel >> n) & 1u);
        const bool wave_live = (dbase + 31 >= 0) && __any(lane_ok);
        if (wave_live) {
            f32x16 p0 = {}, p1 = {};
            const LAS unsigned char* kb = L + AT_K + cur * 8192 + hi * 1024 + r32 * 16;
#pragma unroll
            for (int d0 = 0; d0 < 4; ++d0) { const bf16x8 b0 = *(const LAS bf16x8*)(kb + d0 * 2048); const bf16x8 b1 = *(const LAS bf16x8*)(kb + d0 * 2048 + 512);
                p0 = __builtin_amdgcn_mfma_f32_32x32x16_bf16(b0, qr[d0], p0, 0, 0, 0); p1 = __builtin_amdgcn_mfma_f32_32x32x16_bf16(b1, qr[d0], p1, 0, 0, 0); }
            const bool far = (dbase - 63 >= 128);
            const int dl = dbase + r32;
            if (far) {
#pragma unroll
                for (int r = 0; r < 16; ++r) { p0[r] = lane_ok ? p0[r] * C2 + c31 : -INFINITY; p1[r] = lane_ok ? p1[r] * C2 + c31 : -INFINITY; }
            } else {
#pragma unroll
                for (int r = 0; r < 16; ++r) { const int d0_ = dl - crow(r, hi), d1_ = d0_ - 32;
                    const float b0 = tab[min(max(d0_, 0), 128)], b1 = tab[min(max(d1_, 0), 128)];
                    p0[r] = (lane_ok && d0_ >= 0) ? p0[r] * C2 + b0 : -INFINITY; p1[r] = (lane_ok && d1_ >= 0) ? p1[r] * C2 + b1 : -INFINITY; }
            }
            float rm = fmaxf(p0[0], p1[0]);
#pragma unroll
            for (int r = 1; r < 16; ++r) rm = fmaxf(rm, fmaxf(p0[r], p1[r]));
            rm = swapmax(rm);
            const float mnew = fmaxf(mrun, rm);
            const float msafe = (mnew == -INFINITY) ? 0.f : mnew;
            const float alpha = __builtin_amdgcn_exp2f(mrun - msafe);
            mrun = mnew;
            float ps = 0.f;
#pragma unroll
            for (int r = 0; r < 16; ++r) { p0[r] = __builtin_amdgcn_exp2f(p0[r] - msafe); p1[r] = __builtin_amdgcn_exp2f(p1[r] - msafe); ps += p0[r] + p1[r]; }
            lrun = lrun * alpha + ps;
            if (__any(alpha != 1.f)) {
                if (hi == 0) wsf[r32] = alpha;
                LDS_WAIT(); asm volatile("" ::: "memory");
#pragma unroll
                for (int r = 0; r < 16; ++r) { const float f = wsf[crow(r, hi)]; o[0][r] *= f; o[1][r] *= f; }
                asm volatile("" ::: "memory");
            }
            v4u pw[4];
            pw[0] = (v4u){cvtpk(p0[0], p0[1]), cvtpk(p0[2], p0[3]), cvtpk(p0[4], p0[5]), cvtpk(p0[6], p0[7])};
            pw[1] = (v4u){cvtpk(p0[8], p0[9]), cvtpk(p0[10], p0[11]), cvtpk(p0[12], p0[13]), cvtpk(p0[14], p0[15])};
            pw[2] = (v4u){cvtpk(p1[0], p1[1]), cvtpk(p1[2], p1[3]), cvtpk(p1[4], p1[5]), cvtpk(p1[6], p1[7])};
            pw[3] = (v4u){cvtpk(p1[8], p1[9]), cvtpk(p1[10], p1[11]), cvtpk(p1[12], p1[13]), cvtpk(p1[14], p1[15])};
            const LAS unsigned char* vb = L + AT_V + cur * 8192 + ((lane >> 4) & 1) * 32 + (lane & 3) * 8 + (4 * hi + ((lane & 15) >> 2)) * 64;
#pragma unroll
            for (int d0 = 0; d0 < 2; ++d0)
#pragma unroll
                for (int ks = 0; ks < 4; ++ks) { const s16x4 lo = vtr(vb + d0 * 4096 + ks * 1024), hh = vtr(vb + d0 * 4096 + ks * 1024 + 512);
                    const bf16x8 vf = (bf16x8){lo[0], lo[1], lo[2], lo[3], hh[0], hh[1], hh[2], hh[3]};
                    o[d0] = __builtin_amdgcn_mfma_f32_32x32x16_bf16(__builtin_bit_cast(bf16x8, pw[ks]), vf, o[d0], 0, 0, 0); }
        }
        if (jt + 1 < NTILE) { *(LAS v4u*)(L + AT_K + (cur ^ 1) * 8192 + stoff) = kreg; *(LAS v4u*)(L + AT_V + (cur ^ 1) * 8192 + stoff) = vreg; }
        __syncthreads();
    }
    lrun = swapsum(lrun);
    if (hi == 0) wsf[32 + r32] = lrun;
    LDS_WAIT(); asm volatile("" ::: "memory");
    LAS bf16* stg = (LAS bf16*)(L + AT_OST) + wid * 2048;
#pragma unroll
    for (int r = 0; r < 16; ++r) { const int orow = crow(r, hi); const float rl = 1.f / wsf[32 + orow];
        stg[orow * 64 + r32] = (bf16)f2bf(o[0][r] * rl); stg[orow * 64 + 32 + r32] = (bf16)f2bf(o[1][r] * rl); }
    LDS_WAIT(); asm volatile("" ::: "memory");
    bf16* Ow = mix + (mb + q0 + wid * 32) * DM + h * HD;
#pragma unroll
    for (int i = 0; i < 4; ++i) { const int row = i * 8 + (lane >> 3), ch = lane & 7; const v4u v = *(const LAS v4u*)(stg + row * 64 + ch * 8); *(GAS v4u*)(Ow + (size_t)row * DM + ch * 8) = v; }
}

__device__ __forceinline__ void attn_queue(Frame& F, unsigned* head) {
    volatile LAS unsigned* slot = (volatile LAS unsigned*)(F.lds + MISC_OFF + 64);
    for (;;) {
        __syncthreads();
        if (F.tid == 0) *slot = __hip_atomic_fetch_add(head, 1u, __ATOMIC_RELAXED, __HIP_MEMORY_SCOPE_AGENT);
        __syncthreads();
        const unsigned u = *slot;
        if (u >= 512u) break;
        const int bh = (int)(u & 31u), qb = 15 - (int)(u >> 5);
        attn_unit(F, bh >> 4, bh & 15, qb);
    }
}

#ifndef REP_PHASE
#define REP_PHASE -1
#endif
#ifndef REP_EXTRA
#define REP_EXTRA 1
#endif
#ifndef MK_PER_PHASE
#define MK_PER_PHASE 0
#endif
constexpr int NPHASE = 12;
__global__ void __launch_bounds__(NT, 2) hymba_fwd(Args args) {
    extern __shared__ __attribute__((aligned(16))) unsigned char lds[];
    Frame F;
    F.lds = (LAS unsigned char*)lds;
    F.tid = threadIdx.x; F.lane = F.tid & 63; F.wave = __builtin_amdgcn_readfirstlane(F.tid >> 6);
    F.G = gridDim.x; F.bid = blockIdx.x; F.in = args.in; F.hz = args.out; F.ws = args.ws;
    volatile LAS unsigned* MISC = (volatile LAS unsigned*)(F.lds + MISC_OFF);
    for (int u = F.tid; u < (LDS_BYTES - LDSCTL_OFF) / 4; u += NT) ((LAS unsigned*)(F.lds + LDSCTL_OFF))[u] = 0u;
    __syncthreads();
    gu32* ctl = (gu32*)(F.ws + WS_CTL);
    XcdBarrier bar; bar.bar = (unsigned*)(ctl + CW_BAR); bar.x = 0; bar.st = nullptr;
    if (!MK_PER_PHASE) bar = xcd_barrier_post((unsigned*)(ctl + CW_BAR), MISC + 8);
    const int lo = args.ph_lo, hi = args.ph_hi;
#define IN(k) (lo <= (k) && (k) < hi)
#define SEAM(k) do { if (IN(k) && IN((k) + 1)) xcd_barrier(bar); } while (0)
    bf16* const Wgu = (bf16*)(F.ws + WS_WGU); bf16* const Wd = (bf16*)(F.ws + WS_WD); bf16* const Win = (bf16*)(F.ws + WS_WIN); bf16* const Wout = (bf16*)(F.ws + WS_WOUT);
    bf16* const Wpg = (bf16*)(F.ws + WS_WPG); bf16* const Wpu = (bf16*)(F.ws + WS_WPU);
    bf16* const XB = (bf16*)(F.ws + WS_XB); bf16* const BIG = (bf16*)(F.ws + WS_BIG); bf16* const MIX = (bf16*)(F.ws + WS_MIX); bf16* const EB = (bf16*)(F.ws + WS_SCAN); bf16* const PB = (bf16*)(F.ws + WS_PB);

    float* const stats1 = (float*)(F.ws + WS_STATS); float* const stats2 = stats1 + 2 * M; float* const stats3 = stats2 + 2 * M;
    float* const gb1 = (float*)(F.ws + WS_GB); float* const gb2 = gb1 + 2 * DM;
    float* const c1_in = (float*)(F.ws + WS_CVEC); float* const c2_in = c1_in + INP; float* const c1_gu = c2_in + INP; float* const c2_gu = c1_gu + NGU; float* const c1_pg = c2_gu + NGU; float* const c2_pg = c1_pg + DM;
    if (IN(0)) {
        int base = 0;
        ffn_weights<false>(F, 2, 3, 4, base);
        transpose_job<true>(F, F.in[7], DM, DM, INC, Win, DM, 0, base, F.in[5], F.in[6], c1_in, c2_in);
        transpose_job<false>(F, F.in[20], DM, DM, DM, Wout, DM, 0, base);
        transpose_job<true>(F, F.in[29], DM, DM, DM, Wpg, DM, 0, base, F.in[26], F.in[27], c1_pg, c2_pg);
        transpose_job<false>(F, F.in[28], PLE, PLE, DM, Wpu, PLE, 0, base);
        transpose_job<false>(F, F.in[11], 64, 64, RW, (bf16*)(F.ws + WS_SMALL + SM_W2T), 64, 0, base);
        transpose_job<false>(F, F.in[13], 64, 64, RW, (bf16*)(F.ws + WS_SMALL + SM_A2T), 64, 0, base);
        transpose_job<false>(F, F.in[14], 160, 192, RW, (bf16*)(F.ws + WS_SMALL + SM_G2T), 192, 0, base);
        convert_bf16(F, F.in[0], XB, (size_t)M * DM);
        convert_bf16(F, F.in[1], PB, (size_t)M * PLE);
        if (F.bid == 0) for (int i = F.tid; i < DM; i += NT) { gb1[i] = F.in[5][i]; gb1[DM + i] = F.in[6][i]; gb2[i] = F.in[21][i]; gb2[DM + i] = F.in[22][i]; }
    }
    SEAM(0);
    if (IN(1)) { pg8::Gemm g{XB, Wgu, M, NGU, DM}; pg8::StaticOrder S; S.init(M, NGU, F.G, F.bid); pg8::EpiSwiGLU E{BIG, DFF};
        pg8::gemm_phase<pg8::EpiSwiGLU, pg8::StaticOrder, true, true>(F.lds, g, S, E); }
    SEAM(1);
    if (IN(2)) { pg8::Gemm g{BIG, Wd, M, DM, DFF}; pg8::StaticOrder S; S.init(M, DM, F.G, F.bid);
        pg8::EpiResidLN<false> E{F.in[0], F.hz, XB, DM, ALPHA, 0.5f, pg8::RowStats{nullptr, 0.f, 0.f}, nullptr, nullptr, stats1};
        pg8::gemm_phase<pg8::EpiResidLN<false>, pg8::StaticOrder, true, true>(F.lds, g, S, E); }
    SEAM(2);
    if (IN(3)) { pg8::Gemm g{XB, Win, M, INP, DM}; pg8::StaticOrder S; S.init(M, INP, F.G, F.bid); pg8::EpiBf16LN E{BIG, INP, pg8::RowStats{stats1, 1.f / DM, LN_EPS}, c1_in, c2_in};
        pg8::gemm_phase<pg8::EpiBf16LN, pg8::StaticOrder, true, true>(F.lds, g, S, E); }
    SEAM(3);
#ifndef DUP4
#define DUP4 1
#endif
    if (IN(4)) { kmean_tasks(F); __syncthreads();
#pragma unroll 1
        for (int rep_ = 0; rep_ < DUP4; ++rep_) for (int u = F.bid; u < BATCH * NH * 64; u += F.G) chunk_prepass(F, u); }
    SEAM(4);
    if (IN(5)) {
        for (int t = F.bid; t < BATCH * NH; t += F.G) chunk_scan(F, t);
        attn_queue(F, (unsigned*)(ctl + CW_QUEUE));
    }
    SEAM(5);
    if (IN(6)) { rw_finalize(F); int base = 0; ffn_weights<true>(F, 23, 24, 25, base, F.in[21], F.in[22], c1_gu, c2_gu); }
    SEAM(6);
    if (IN(7)) { { pg8::Gemm g{MIX, Wout, M, DM, DM}; pg8::StaticOrder S; S.init(M, DM, F.G, F.bid);
          pg8::EpiResidLNip E{F.hz, XB, stats1, gb1, DM, M, ALPHA, 1.0f, 1.f / DM, LN_EPS};
          pg8::gemm_phase<pg8::EpiResidLNip, pg8::StaticOrder, true, true>(F.lds, g, S, E); }
        { pg8::Gemm g{PB, Wpu, M, DM, PLE}; pg8::StaticOrder S; S.init(M, DM, F.G, F.bid); pg8::EpiBf16<0> E{EB, DM, nullptr, 0, 0, 1.f};
          pg8::gemm_phase<pg8::EpiBf16<0>, pg8::StaticOrder, true, true>(F.lds, g, S, E); } }
    SEAM(7);
    if (IN(8)) { pg8::Gemm g{XB, Wgu, M, NGU, DM}; pg8::StaticOrder S; S.init(M, NGU, F.G, F.bid); pg8::EpiSwiGLULN E{BIG, DFF, pg8::RowStats{stats2, 1.f / DM, LN_EPS}, c1_gu, c2_gu};
        pg8::gemm_phase<pg8::EpiSwiGLULN, pg8::StaticOrder, true, true>(F.lds, g, S, E); }
    SEAM(8);
    if (IN(9)) { pg8::Gemm g{BIG, Wd, M, DM, DFF}; pg8::StaticOrder S; S.init(M, DM, F.G, F.bid);
        pg8::EpiResidLNip E{F.hz, XB, stats2, gb2, DM, M, ALPHA, 0.5f, 1.f / DM, LN_EPS};
        pg8::gemm_phase<pg8::EpiResidLNip, pg8::StaticOrder, true, true>(F.lds, g, S, E); }
    SEAM(9);
    if (IN(10)) { pg8::Gemm g{XB, Wpg, M, DM, DM}; pg8::StaticOrder S; S.init(M, DM, F.G, F.bid);
        pg8::EpiPleLN E{F.hz, F.hz, EB, F.in[30], DM, ALPHA, pg8::RowStats{stats3, 1.f / DM, LN_EPS}, F.in[26], F.in[27], c1_pg, c2_pg};
        pg8::gemm_phase<pg8::EpiPleLN, pg8::StaticOrder, true, true>(F.lds, g, S, E); }
    SEAM(10);
    if (IN(11)) {
        if (!MK_PER_PHASE && xb_ld((unsigned*)(ctl + CW_BAR) + XB_TMO) != 0u) {
            const float q = __builtin_nanf(""); for (size_t i = (size_t)F.bid * NT + F.tid; i < (size_t)M * DM; i += (size_t)F.G * NT) F.hz[i] = q;
        } else ln_phase<false>(F, F.hz, F.in[31], F.in[32], nullptr);
    }
#undef IN
#undef SEAM
}

extern "C" void kernel_launch(void* const* d_in, const int* in_sizes, int n_in, void* d_out, int out_size, void* d_ws, size_t ws_size, hipStream_t stream) {
    static int grid = 0;
    if (grid == 0) {
        if (n_in != 33 || out_size != M * DM || ws_size < WS_END) { fprintf(stderr, "kernel_launch: unexpected problem (n_in %d out %d ws %zu, need %zu); nothing launched\n", n_in, out_size, ws_size, (size_t)WS_END); grid = -1; return; }
        int dev = 0, cus = 0;
        if (hipGetDevice(&dev) != hipSuccess || hipDeviceGetAttribute(&cus, hipDeviceAttributeMultiprocessorCount, dev) != hipSuccess) { grid = -1; return; }
        if (hipFuncSetAttribute((const void*)hymba_fwd, hipFuncAttributeMaxDynamicSharedMemorySize, LDS_BYTES) != hipSuccess) { fprintf(stderr, "kernel_launch: hipFuncSetAttribute failed\n"); grid = -1; return; }
        grid = cus > 0 ? cus : 256;
        fprintf(stderr, "kernel_launch: grid %d, ws %zu\n", grid, ws_size);
    }
    if (grid < 0) return;
    (void)hipMemsetAsync((char*)d_ws + WS_CTL, 0, CTL_ZERO_BYTES, stream);
    Args a{};
    for (int i = 0; i < 33; ++i) a.in[i] = (const float*)d_in[i];
    a.out = (float*)d_out; a.ws = (unsigned char*)d_ws;
#if MK_PER_PHASE
    for (int p = 0; p < NPHASE; ++p) { a.ph_lo = p; a.ph_hi = p + 1; const int reps = (p == REP_PHASE) ? 1 + REP_EXTRA : 1;
        for (int r = 0; r < reps; ++r) hipLaunchKernelGGL(hymba_fwd, dim3(grid), dim3(NT), LDS_BYTES, stream, a);
        if (p == 5 && REP_PHASE >= 20) { a.ph_lo = REP_PHASE; a.ph_hi = REP_PHASE + 1; hipLaunchKernelGGL(hymba_fwd, dim3(grid), dim3(NT), LDS_BYTES, stream, a); } }
#else
    a.ph_lo = 0; a.ph_hi = NPHASE;
    hipLaunchKernelGGL(hymba_fwd, dim3(grid), dim3(NT), LDS_BYTES, stream, a);
#endif
}
```

```cpp
#include <hip/hip_runtime.h>
#include <cstdio>
#include <cstdint>
namespace pg8 {
#define PG8_LAS __attribute__((address_space(3)))
typedef unsigned short bf16_t;
typedef short bf16x8 __attribute__((ext_vector_type(8)));
typedef float f32x4 __attribute__((ext_vector_type(4)));
typedef unsigned u32x4 __attribute__((ext_vector_type(4)));
constexpr int BM = 256, BK = 64, HALF = 128, HTB = HALF * BK * 2  , STAGE_BYTES = 8 * HTB, NXCD = 8, WGM = 8;

__host__ __device__ __forceinline__ int lds_byte(int r, int c) { const int st = (r >> 4) * 2 + (c >> 5), rr = r & 15, cc = c & 31, ob = rr * 64 + cc * 2; return st * 1024 + (ob ^ (((ob >> 9) & 1) << 5)); }
__host__ __device__ __forceinline__ void stage_rc(int b, int& R, int& C) { const int st = b / 1024, sb = b % 1024, swz = sb ^ (((sb >> 9) & 1) << 5); R = (st >> 1) * 16 + swz / 64; C = (st & 1) * 32 + (swz % 64) / 2; }
__host__ __device__ __forceinline__ int perm32(int rho) { const int n = rho >> 4, i = rho & 15; return 8 * (i >> 2) + 4 * n + (i & 3); }

struct Unit { int pm, pn; };
struct Gemm { const bf16_t* A; const bf16_t* Bt; int M, N, K; };

struct StaticOrder {
    int nM, nN, nwg, G, c;
    __host__ __device__ void init(int M, int N, int G_, int c_) { nM = M / BM; nN = N / BM; nwg = nM * nN; G = G_; c = c_; }
    __host__ __device__ bool next(int i, Unit& u) const {
        const long L = (long)i * G + c; if (L >= nwg) return false;
        int wgid = (int)L; { const int q = nwg / NXCD, r = nwg % NXCD, xcd = wgid % NXCD, off = wgid / NXCD; wgid = (xcd < r ? xcd * (q + 1) : r * (q + 1) + (xcd - r) * q) + off; }
        const int nig = WGM * nN, gid = wgid / nig, fm = gid * WGM, gsz = (nM - fm) < WGM ? (nM - fm) : WGM;
        u.pm = fm + ((wgid % nig) % gsz); u.pn = (wgid % nig) / gsz; return true;
    }
    __device__ __forceinline__ void a_ready(const Unit&) const {}
    __device__ __forceinline__ void done(const Unit&) const {}
};

__device__ __forceinline__ unsigned cvt_pk_bf16(float lo, float hi) { unsigned r; asm volatile("v_cvt_pk_bf16_f32 %0, %1, %2" : "=v"(r) : "v"(lo), "v"(hi)); return r; }
typedef float f32x2 __attribute__((ext_vector_type(2)));
__device__ __forceinline__ f32x2 gelu_pk(f32x2 v) {
    const f32x2 av = __builtin_elementwise_abs(v), d = av * 0.2316418882f + 1.0f;
    f32x2 t; t.x = __builtin_amdgcn_rcpf(d.x); t.y = __builtin_amdgcn_rcpf(d.y);
    f32x2 q = t * 0.5307027145f + (-0.7265760135f); q = q * t + 0.7107068705f; q = q * t + (-0.142248368f); q = q * t + 0.127414796f; q = q * t;
    const f32x2 s = (v * v) * (-0.72134752044f);
    f32x2 e; e.x = __builtin_amdgcn_exp2f(s.x); e.y = __builtin_amdgcn_exp2f(s.y);
    const f32x2 m = v * (q * e), r = v - m;
    f32x2 o; o.x = v.x < 0.f ? m.x : r.x; o.y = v.y < 0.f ? m.y : r.y; return o;
}

template <int ACT  > struct EpiBf16 {
    static constexpr bool PERM = true, AFTER_DRAIN = false; static_assert(ACT == 0 || ACT == 1, "EpiBf16: ACT is 0 (none) or 1 (gelu_pk)");
    bf16_t* O; int ldc; const float* bias; int split_cols; size_t split_stride; float scale0;
    __device__ __forceinline__ void operator()(const f32x4 (&acc)[2][2][4][2], const Unit& u, int wr, int wc, int fr, int fq) const {
        const int row0 = u.pm * BM + wr * 64 + fr; int colt = u.pn * BM; bf16_t* base = O;
        float sc = 1.f; if (split_cols) { const int t = colt / split_cols; base += (size_t)t * split_stride; colt -= t * split_cols; if (t == 0) sc = scale0; }
        const int col0 = colt + wc * 32 + 8 * fq, bcol0 = u.pn * BM + wc * 32 + 8 * fq;
        f32x4 bv[2][2];
#pragma unroll
        for (int bj = 0; bj < 2; ++bj)
#pragma unroll
            for (int n = 0; n < 2; ++n) bv[bj][n] = bias ? *(const f32x4*)(bias + bcol0 + bj * HALF + 4 * n) : (f32x4){0.f, 0.f, 0.f, 0.f};
#pragma unroll
        for (int ai = 0; ai < 2; ++ai)
#pragma unroll
            for (int m = 0; m < 4; ++m) { bf16_t* rowp = base + (size_t)(row0 + ai * HALF + m * 16) * ldc + col0;
#pragma unroll
                for (int bj = 0; bj < 2; ++bj) { f32x4 v0 = acc[ai][bj][m][0] + bv[bj][0], v1 = acc[ai][bj][m][1] + bv[bj][1];
                    if (ACT == 1) { f32x2 a = gelu_pk((f32x2){v0[0], v0[1]}), b = gelu_pk((f32x2){v0[2], v0[3]}), c = gelu_pk((f32x2){v1[0], v1[1]}), d = gelu_pk((f32x2){v1[2], v1[3]});
                        v0 = (f32x4){a.x, a.y, b.x, b.y}; v1 = (f32x4){c.x, c.y, d.x, d.y}; }
                    v0 = v0 * sc; v1 = v1 * sc; u32x4 w; w.x = cvt_pk_bf16(v0[0], v0[1]); w.y = cvt_pk_bf16(v0[2], v0[3]); w.z = cvt_pk_bf16(v1[0], v1[1]); w.w = cvt_pk_bf16(v1[2], v1[3]);
                    *(u32x4*)(rowp + bj * HALF) = w; } }
    }
};
__device__ __forceinline__ float sigmoid_f(float x) { return __builtin_amdgcn_rcpf(1.0f + __builtin_amdgcn_exp2f(-1.4426950408889634f * x)); }
struct EpiSwiGLU {
    static constexpr bool PERM = true, AFTER_DRAIN = false;
    bf16_t* O; int ldc;
    __device__ __forceinline__ void operator()(const f32x4 (&acc)[2][2][4][2], const Unit& u, int wr, int wc, int fr, int fq) const {
        const int row0 = u.pm * BM + wr * 64 + fr; const int col0 = u.pn * HALF + wc * 32 + 8 * fq;
#pragma unroll
        for (int ai = 0; ai < 2; ++ai)
#pragma unroll
            for (int m = 0; m < 4; ++m) { bf16_t* rowp = O + (size_t)(row0 + ai * HALF + m * 16) * ldc + col0;
                const f32x4 g0 = acc[ai][0][m][0], g1 = acc[ai][0][m][1], u0 = acc[ai][1][m][0], u1 = acc[ai][1][m][1];
                f32x4 h0, h1;
#pragma unroll
                for (int i = 0; i < 4; ++i) { h0[i] = g0[i] * sigmoid_f(g0[i]) * u0[i]; h1[i] = g1[i] * sigmoid_f(g1[i]) * u1[i]; }
                u32x4 w; w.x = cvt_pk_bf16(h0[0], h0[1]); w.y = cvt_pk_bf16(h0[2], h0[3]); w.z = cvt_pk_bf16(h1[0], h1[1]); w.w = cvt_pk_bf16(h1[2], h1[3]);
                *(u32x4*)rowp = w; }
    }
};
struct EpiResid {
    static constexpr bool PERM = false, AFTER_DRAIN = false;
    const float* base; float* out; int ldc; float alpha, s;
    __device__ __forceinline__ void operator()(const f32x4 (&acc)[2][2][4][2], const Unit& u, int wr, int wc, int fr, int fq) const {
        const int col0 = u.pn * BM + wc * 32 + 4 * fq;
#pragma unroll
        for (int ai = 0; ai < 2; ++ai)
#pragma unroll
            for (int m = 0; m < 4; ++m) { const size_t off = (size_t)(u.pm * BM + ai * HALF + wr * 64 + m * 16 + fr) * ldc + col0;
#pragma unroll
                for (int bj = 0; bj < 2; ++bj)
#pragma unroll
                    for (int n = 0; n < 2; ++n) { const f32x4 bs = *(const f32x4*)(base + off + bj * HALF + n * 16);
                        *(f32x4*)(out + off + bj * HALF + n * 16) = bs * alpha + acc[ai][bj][m][n] * s; }
                if (m & 1) asm volatile("" ::: "memory"); }
    }
};
struct EpiPle {
    static constexpr bool PERM = false, AFTER_DRAIN = false;
    const float* base; float* out; const bf16_t* e; const float* bias; int ldc; float alpha;
    __device__ __forceinline__ void operator()(const f32x4 (&acc)[2][2][4][2], const Unit& u, int wr, int wc, int fr, int fq) const {
        typedef unsigned u32x2v __attribute__((ext_vector_type(2)));
        const int col0 = u.pn * BM + wc * 32 + 4 * fq;
        f32x4 bv[2][2];
#pragma unroll
        for (int bj = 0; bj < 2; ++bj)
#pragma unroll
            for (int n = 0; n < 2; ++n) bv[bj][n] = *(const f32x4*)(bias + col0 + bj * HALF + n * 16);
#pragma unroll
        for (int ai = 0; ai < 2; ++ai)
#pragma unroll
            for (int m = 0; m < 4; ++m) { const size_t off = (size_t)(u.pm * BM + ai * HALF + wr * 64 + m * 16 + fr) * ldc + col0;
#pragma unroll
                for (int bj = 0; bj < 2; ++bj)
#pragma unroll
                    for (int n = 0; n < 2; ++n) { const f32x4 bs = *(const f32x4*)(base + off + bj * HALF + n * 16);
                        const u32x2v ew = *(const u32x2v*)(e + off + bj * HALF + n * 16);
                        f32x4 ev; ev[0] = __uint_as_float(ew.x << 16); ev[1] = __uint_as_float(ew.x & 0xffff0000u); ev[2] = __uint_as_float(ew.y << 16); ev[3] = __uint_as_float(ew.y & 0xffff0000u);
                        const f32x4 a = acc[ai][bj][m][n] + bv[bj][n]; f32x4 o;
#pragma unroll
                        for (int i = 0; i < 4; ++i) o[i] = bs[i] * alpha + sigmoid_f(a[i]) * ev[i];
                        *(f32x4*)(out + off + bj * HALF + n * 16) = o; }
                if (m & 1) asm volatile("" ::: "memory"); }
    }
};

struct RowStats { const float* st; float inv_n, eps;
    __device__ __forceinline__ void get(int row, float& mu, float& rstd) const { const float s = st[2 * row], q = st[2 * row + 1]; mu = s * inv_n; const float var = q * inv_n - mu * mu; rstd = __builtin_amdgcn_rsqf(fmaxf(var, 0.f) + eps); } };
template <bool LNB>
struct EpiResidLN {
    static constexpr bool PERM = false, AFTER_DRAIN = false;
    const float* base; float* out; bf16_t* zb; int ldc; float alpha, s; RowStats bst; const float* bg; const float* bb; float* stats_out;
    __device__ __forceinline__ void operator()(const f32x4 (&acc)[2][2][4][2], const Unit& u, int wr, int wc, int fr, int fq) const {
        typedef unsigned u32x2v __attribute__((ext_vector_type(2)));
        const int col0 = u.pn * BM + wc * 32 + 4 * fq;
#pragma unroll
        for (int ai = 0; ai < 2; ++ai)
#pragma unroll
            for (int m = 0; m < 4; ++m) { const int row = u.pm * BM + ai * HALF + wr * 64 + m * 16 + fr; const size_t off = (size_t)row * ldc + col0;
                float mu = 0.f, rstd = 1.f; if (LNB) bst.get(row, mu, rstd);
                float rs = 0.f, rq = 0.f;
#pragma unroll
                for (int bj = 0; bj < 2; ++bj)
#pragma unroll
                    for (int n = 0; n < 2; ++n) { f32x4 bs = *(const f32x4*)(base + off + bj * HALF + n * 16);
                        if (LNB) bs = (bs - mu) * rstd * *(const f32x4*)(bg + col0 + bj * HALF + n * 16) + *(const f32x4*)(bb + col0 + bj * HALF + n * 16);
                        const f32x4 o = bs * alpha + acc[ai][bj][m][n] * s;
                        *(f32x4*)(out + off + bj * HALF + n * 16) = o;
                        u32x2v w; w.x = cvt_pk_bf16(o[0], o[1]); w.y = cvt_pk_bf16(o[2], o[3]); *(u32x2v*)(zb + off + bj * HALF + n * 16) = w;
                        rs += (o[0] + o[1]) + (o[2] + o[3]); rq += (o[0] * o[0] + o[1] * o[1]) + (o[2] * o[2] + o[3] * o[3]); }
                rs += __shfl_xor(rs, 16); rq += __shfl_xor(rq, 16); rs += __shfl_xor(rs, 32); rq += __shfl_xor(rq, 32);
                if (fq == 0) { atomicAdd(stats_out + 2 * row, rs); atomicAdd(stats_out + 2 * row + 1, rq); }
                asm volatile("" ::: "memory"); }
    }
};
struct EpiBf16LN {
    static constexpr bool PERM = true, AFTER_DRAIN = false;
    bf16_t* O; int ldc; RowStats st; const float* c1; const float* c2;
    __device__ __forceinline__ void operator()(const f32x4 (&acc)[2][2][4][2], const Unit& u, int wr, int wc, int fr, int fq) const {
        const int row0 = u.pm * BM + wr * 64 + fr; const int col0 = u.pn * BM + wc * 32 + 8 * fq;
#pragma unroll
        for (int ai = 0; ai < 2; ++ai)
#pragma unroll
            for (int m = 0; m < 4; ++m) { const int row = row0 + ai * HALF + m * 16; bf16_t* rowp = O + (size_t)row * ldc + col0;
                float mu, rstd; st.get(row, mu, rstd); const float rm = rstd * mu;
#pragma unroll
                for (int bj = 0; bj < 2; ++bj) { const float* c1p = c1 + col0 + bj * HALF; const float* c2p = c2 + col0 + bj * HALF;
                    const f32x4 v0 = acc[ai][bj][m][0] * rstd - *(const f32x4*)(c1p) * rm + *(const f32x4*)(c2p), v1 = acc[ai][bj][m][1] * rstd - *(const f32x4*)(c1p + 4) * rm + *(const f32x4*)(c2p + 4);
                    u32x4 w; w.x = cvt_pk_bf16(v0[0], v0[1]); w.y = cvt_pk_bf16(v0[2], v0[3]); w.z = cvt_pk_bf16(v1[0], v1[1]); w.w = cvt_pk_bf16(v1[2], v1[3]);
                    *(u32x4*)(rowp + bj * HALF) = w; }
                asm volatile("" ::: "memory"); }
    }
};
struct EpiSwiGLULN {
    static constexpr bool PERM = true, AFTER_DRAIN = false;
    bf16_t* O; int ldc; RowStats st; const float* c1; const float* c2;
    __device__ __forceinline__ void operator()(const f32x4 (&acc)[2][2][4][2], const Unit& u, int wr, int wc, int fr, int fq) const {
        const int row0 = u.pm * BM + wr * 64 + fr; const int col0 = u.pn * HALF + wc * 32 + 8 * fq; const int ci = u.pn * BM + wc * 32 + 8 * fq;
#pragma unroll
        for (int ai = 0; ai < 2; ++ai)
#pragma unroll
            for (int m = 0; m < 4; ++m) { const int row = row0 + ai * HALF + m * 16; bf16_t* rowp = O + (size_t)row * ldc + col0;
                float mu, rstd; st.get(row, mu, rstd); const float rm = rstd * mu;
                const f32x4 g0 = acc[ai][0][m][0] * rstd - *(const f32x4*)(c1 + ci) * rm + *(const f32x4*)(c2 + ci), g1 = acc[ai][0][m][1] * rstd - *(const f32x4*)(c1 + ci + 4) * rm + *(const f32x4*)(c2 + ci + 4);
                const f32x4 u0 = acc[ai][1][m][0] * rstd - *(const f32x4*)(c1 + ci + HALF) * rm + *(const f32x4*)(c2 + ci + HALF), u1 = acc[ai][1][m][1] * rstd - *(const f32x4*)(c1 + ci + HALF + 4) * rm + *(const f32x4*)(c2 + ci + HALF + 4);
                f32x4 h0, h1;
#pragma unroll
                for (int i = 0; i < 4; ++i) { h0[i] = g0[i] * sigmoid_f(g0[i]) * u0[i]; h1[i] = g1[i] * sigmoid_f(g1[i]) * u1[i]; }
                u32x4 w; w.x = cvt_pk_bf16(h0[0], h0[1]); w.y = cvt_pk_bf16(h0[2], h0[3]); w.z = cvt_pk_bf16(h1[0], h1[1]); w.w = cvt_pk_bf16(h1[2], h1[3]);
                *(u32x4*)rowp = w; asm volatile("" ::: "memory"); }
    }
};
struct EpiPleLN {
    static constexpr bool PERM = false, AFTER_DRAIN = false;
    const float* base; float* out; const bf16_t* e; const float* bias; int ldc; float alpha; RowStats st; const float* bg; const float* bb; const float* c1; const float* c2;
    __device__ __forceinline__ void operator()(const f32x4 (&acc)[2][2][4][2], const Unit& u, int wr, int wc, int fr, int fq) const {
        typedef unsigned u32x2v __attribute__((ext_vector_type(2)));
        const int col0 = u.pn * BM + wc * 32 + 4 * fq;
#pragma unroll
        for (int bj = 0; bj < 2; ++bj)
#pragma unroll
            for (int n = 0; n < 2; ++n) { const int cc = col0 + bj * HALF + n * 16;
                const f32x4 bv = *(const f32x4*)(bias + cc), gv = *(const f32x4*)(bg + cc), bbv = *(const f32x4*)(bb + cc), c1v = *(const f32x4*)(c1 + cc), c2v = *(const f32x4*)(c2 + cc);
#pragma unroll
                for (int ai = 0; ai < 2; ++ai)
#pragma unroll
                    for (int m = 0; m < 4; ++m) { const int row = u.pm * BM + ai * HALF + wr * 64 + m * 16 + fr; const size_t off = (size_t)row * ldc + cc;
                        float mu, rstd; st.get(row, mu, rstd); const float rm = rstd * mu;
                        const f32x4 bs = (*(const f32x4*)(base + off) - mu) * rstd * gv + bbv;
                        const u32x2v ew = *(const u32x2v*)(e + off);
                        f32x4 ev; ev[0] = __uint_as_float(ew.x << 16); ev[1] = __uint_as_float(ew.x & 0xffff0000u); ev[2] = __uint_as_float(ew.y << 16); ev[3] = __uint_as_float(ew.y & 0xffff0000u);
                        const f32x4 a = acc[ai][bj][m][n] * rstd - c1v * rm + c2v + bv; f32x4 o;
#pragma unroll
                        for (int i = 0; i < 4; ++i) o[i] = bs[i] * alpha + sigmoid_f(a[i]) * ev[i];
                        *(f32x4*)(out + off) = o; }
                asm volatile("" ::: "memory"); }
    }
};

struct EpiResidLNip {
    static constexpr bool PERM = false, AFTER_DRAIN = false;
    float* io; bf16_t* zb; float* st; const float* gb; int ldc, nrows; float alpha, s, inv_n, eps;
    __device__ __forceinline__ void operator()(const f32x4 (&acc)[2][2][4][2], const Unit& u, int wr, int wc, int fr, int fq) const {
        typedef unsigned u32x2v __attribute__((ext_vector_type(2)));
        const int col0 = u.pn * BM + wc * 32 + 4 * fq;
#pragma unroll
        for (int ai = 0; ai < 2; ++ai)
#pragma unroll
            for (int m = 0; m < 4; ++m) { const int row = u.pm * BM + ai * HALF + wr * 64 + m * 16 + fr; const size_t off = (size_t)row * ldc + col0;
                const float sm = st[2 * row], sq = st[2 * row + 1]; const float mu = sm * inv_n; const float rstd = __builtin_amdgcn_rsqf(fmaxf(sq * inv_n - mu * mu, 0.f) + eps);
                float rs = 0.f, rq = 0.f;
#pragma unroll
                for (int bj = 0; bj < 2; ++bj)
#pragma unroll
                    for (int n = 0; n < 2; ++n) { const int cc = col0 + bj * HALF + n * 16; f32x4 bs = *(const f32x4*)(io + off + bj * HALF + n * 16);
                        bs = (bs - mu) * rstd * *(const f32x4*)(gb + cc) + *(const f32x4*)(gb + ldc + cc);
                        const f32x4 o = bs * alpha + acc[ai][bj][m][n] * s;
                        *(f32x4*)(io + off + bj * HALF + n * 16) = o;
                        u32x2v w; w.x = cvt_pk_bf16(o[0], o[1]); w.y = cvt_pk_bf16(o[2], o[3]); *(u32x2v*)(zb + off + bj * HALF + n * 16) = w;
                        rs += (o[0] + o[1]) + (o[2] + o[3]); rq += (o[0] * o[0] + o[1] * o[1]) + (o[2] * o[2] + o[3] * o[3]); }
                rs += __shfl_xor(rs, 16); rq += __shfl_xor(rq, 16); rs += __shfl_xor(rs, 32); rq += __shfl_xor(rq, 32);
                if (fq == 0) { atomicAdd(st + 2 * nrows + 2 * row, rs); atomicAdd(st + 2 * nrows + 2 * row + 1, rq); }
                asm volatile("" ::: "memory"); }
    }
};
template <class Epi, class Sched, bool ALIGN_EPI = false, bool SP2 = false>
__device__ __forceinline__ void gemm_phase(PG8_LAS unsigned char* lds, const Gemm g, const Sched& S, const Epi& E) {
    const int tid = threadIdx.x, wid = __builtin_amdgcn_readfirstlane(tid >> 6), lane = tid & 63, wr = wid >> 2, wc = wid & 3, fr = lane & 15, fq = lane >> 4;
    const int K = g.K, nt = K / BK;
    unsigned voffA[2], voffB[2];
#pragma unroll
    for (int i = 0; i < 2; ++i) { int R, C; stage_rc(tid * 16 + i * 8192, R, C); const int Rb = Epi::PERM ? ((R & ~31) + perm32(R & 31)) : R;
        voffA[i] = (unsigned)(R * K + C) * 2u; voffB[i] = (unsigned)(Rb * K + C) * 2u; }
    const size_t kstep = (size_t)(BK * 2);
    const size_t hstep = (size_t)HALF * K * 2;
    const size_t tstep = 2 * hstep;
    const unsigned ldsw = (unsigned)wid * 1024u;
    const int aoff = lds_byte(wr * 64 + fr, fq * 8), boff = lds_byte(wc * 32 + fr, fq * 8);
#define PG8_SA(b, h) (((b) * 2 + (h)) * HTB)
#define PG8_SB(b, h) ((4 + (b) * 2 + (h)) * HTB)
#define PG8_STAGE(bufoff, gbase, voff) do { _Pragma("unroll") for (int _i = 0; _i < 2; ++_i) \
        __builtin_amdgcn_global_load_lds((const unsigned*)((const char*)(gbase) + (voff)[_i]), (PG8_LAS unsigned*)(lds + (bufoff) + ldsw + _i * 8192), 16, 0, 0); } while (0)
#define PG8_LDA(dst, b, h) do { _Pragma("unroll") for (int m = 0; m < 4; ++m) _Pragma("unroll") for (int k = 0; k < 2; ++k) dst[m][k] = *(const PG8_LAS bf16x8*)(lds + PG8_SA(b, h) + aoff + m * 2048 + k * 1024); } while (0)
#define PG8_LDB(dst, b, h) do { _Pragma("unroll") for (int n = 0; n < 2; ++n) _Pragma("unroll") for (int k = 0; k < 2; ++k) dst[n][k] = *(const PG8_LAS bf16x8*)(lds + PG8_SB(b, h) + boff + n * 2048 + k * 1024); } while (0)
#define PG8_MMA(ai, bj, At, Bt) do { __builtin_amdgcn_s_setprio(1); _Pragma("unroll") for (int m = 0; m < 4; ++m) _Pragma("unroll") for (int n = 0; n < 2; ++n) _Pragma("unroll") for (int k = 0; k < 2; ++k) \
        acc[ai][bj][m][n] = __builtin_amdgcn_mfma_f32_16x16x32_bf16(Bt[n][k], At[m][k], acc[ai][bj][m][n], 0, 0, 0); __builtin_amdgcn_s_setprio(0); } while (0)
#define PG8_WAIT_V(n) asm volatile("s_waitcnt vmcnt(" #n ")" ::: "memory")
#define PG8_WAIT_L(n) asm volatile("s_waitcnt lgkmcnt(" #n ")" ::: "memory")
#define PG8_BAR __builtin_amdgcn_s_barrier()
#define PG8_SCHED __builtin_amdgcn_sched_barrier(0)
    Unit cur, nxt; int ui = 0;
    if (!S.next(0, cur)) return;
    f32x4 acc[2][2][4][2];
#pragma unroll
    for (int a = 0; a < 2; ++a)
#pragma unroll
        for (int b = 0; b < 2; ++b)
#pragma unroll
            for (int m = 0; m < 4; ++m)
#pragma unroll
                for (int n = 0; n < 2; ++n) acc[a][b][m][n] = (f32x4){0.f, 0.f, 0.f, 0.f};
    bf16x8 At[4][2], B0[2][2], B1[2][2];
    const char* cA = (const char*)g.A + (size_t)cur.pm * tstep; const char* cB = (const char*)g.Bt + (size_t)cur.pn * tstep;
    S.a_ready(cur);
    if constexpr (SP2) {
        PG8_STAGE(PG8_SB(0, 0), cB, voffB); PG8_STAGE(PG8_SB(0, 1), cB + hstep, voffB); PG8_STAGE(PG8_SA(0, 0), cA, voffA); PG8_STAGE(PG8_SA(0, 1), cA + hstep, voffA);
        if (wr == 1) PG8_BAR;
        PG8_WAIT_V(2); PG8_BAR;
        PG8_STAGE(PG8_SB(1, 0), cB + kstep, voffB); PG8_STAGE(PG8_SA(1, 0), cA + kstep, voffA); PG8_STAGE(PG8_SB(1, 1), cB + hstep + kstep, voffB);
        PG8_WAIT_V(6); PG8_BAR;
    } else {
        PG8_STAGE(PG8_SB(0, 0), cB, voffB); PG8_STAGE(PG8_SA(0, 0), cA, voffA); PG8_STAGE(PG8_SB(0, 1), cB + hstep, voffB); PG8_STAGE(PG8_SA(0, 1), cA + hstep, voffA);
        if (wr == 1) PG8_BAR;
        PG8_WAIT_V(4); PG8_BAR;
        PG8_STAGE(PG8_SB(1, 0), cB + kstep, voffB); PG8_STAGE(PG8_SA(1, 0), cA + kstep, voffA); PG8_STAGE(PG8_SB(1, 1), cB + hstep + kstep, voffB);
        PG8_WAIT_V(6); PG8_BAR;
    }
    for (;;) {
        const bool has_next = S.next(ui + 1, nxt);
        const char* nA = has_next ? (const char*)g.A + (size_t)nxt.pm * tstep : cA; const char* nB = has_next ? (const char*)g.Bt + (size_t)nxt.pn * tstep : cB;
        for (int t = 0; t < nt; t += 2) {
            const bool last = (t == nt - 2);
            const char* a1 = cA + (size_t)(t + 1) * kstep;
            const char* a2 = last ? nA : cA + (size_t)(t + 2) * kstep; const char* b2 = last ? nB : cB + (size_t)(t + 2) * kstep;
            const char* a3 = a2 + kstep; const char* b3 = b2 + kstep;
            if (last && has_next) S.a_ready(nxt);
            if constexpr (SP2) {
            PG8_LDB(B0, 0, 0); PG8_LDB(B1, 0, 1); PG8_SCHED; PG8_LDA(At, 0, 0); PG8_STAGE(PG8_SA(1, 1), a1 + hstep, voffA);
            PG8_WAIT_V(8); PG8_WAIT_L(0); PG8_BAR; PG8_MMA(0, 0, At, B0); PG8_MMA(0, 1, At, B1); PG8_BAR; PG8_SCHED;
            PG8_LDA(At, 0, 1); PG8_STAGE(PG8_SB(0, 0), b2, voffB); PG8_STAGE(PG8_SB(0, 1), b2 + hstep, voffB); PG8_STAGE(PG8_SA(0, 0), a2, voffA);
            PG8_WAIT_V(8); PG8_WAIT_L(0); PG8_BAR; PG8_MMA(1, 0, At, B0); PG8_MMA(1, 1, At, B1); PG8_BAR; PG8_SCHED;
            PG8_LDB(B0, 1, 0); PG8_LDB(B1, 1, 1); PG8_SCHED; PG8_LDA(At, 1, 0); PG8_STAGE(PG8_SA(0, 1), a2 + hstep, voffA);
            PG8_WAIT_V(8); PG8_WAIT_L(0); PG8_BAR; PG8_MMA(0, 0, At, B0); PG8_MMA(0, 1, At, B1); PG8_BAR; PG8_SCHED;
            PG8_LDA(At, 1, 1); PG8_STAGE(PG8_SB(1, 0), b3, voffB); PG8_STAGE(PG8_SB(1, 1), b3 + hstep, voffB); PG8_STAGE(PG8_SA(1, 0), a3, voffA);
            PG8_WAIT_V(8); PG8_WAIT_L(0); PG8_BAR; PG8_MMA(1, 0, At, B0); PG8_MMA(1, 1, At, B1); PG8_BAR; PG8_SCHED;
            } else {
            PG8_LDB(B0, 0, 0); PG8_SCHED; PG8_LDA(At, 0, 0); PG8_STAGE(PG8_SA(1, 1), a1 + hstep, voffA);
            PG8_WAIT_L(8); PG8_BAR; PG8_WAIT_L(0); PG8_MMA(0, 0, At, B0); PG8_BAR; PG8_SCHED;
            PG8_LDB(B1, 0, 1); PG8_STAGE(PG8_SB(0, 0), b2, voffB);
            PG8_BAR; PG8_WAIT_L(0); PG8_MMA(0, 1, At, B1); PG8_BAR;
            PG8_LDA(At, 0, 1); PG8_STAGE(PG8_SA(0, 0), a2, voffA);
            PG8_BAR; PG8_WAIT_L(0); PG8_MMA(1, 0, At, B0); PG8_BAR; PG8_SCHED;
            PG8_STAGE(PG8_SB(0, 1), b2 + hstep, voffB);
            PG8_WAIT_V(6); PG8_BAR; PG8_MMA(1, 1, At, B1); PG8_BAR;
            PG8_LDB(B0, 1, 0); PG8_SCHED; PG8_LDA(At, 1, 0); PG8_STAGE(PG8_SA(0, 1), a2 + hstep, voffA);
            PG8_WAIT_L(8); PG8_BAR; PG8_WAIT_L(0); PG8_MMA(0, 0, At, B0); PG8_BAR; PG8_SCHED;
            PG8_LDB(B1, 1, 1); PG8_STAGE(PG8_SB(1, 0), b3, voffB);
            PG8_BAR; PG8_WAIT_L(0); PG8_MMA(0, 1, At, B1); PG8_BAR;
            PG8_LDA(At, 1, 1); PG8_STAGE(PG8_SA(1, 0), a3, voffA);
            PG8_BAR; PG8_WAIT_L(0); PG8_MMA(1, 0, At, B0); PG8_BAR; PG8_SCHED;
            PG8_STAGE(PG8_SB(1, 1), b3 + hstep, voffB);
            PG8_WAIT_V(6); PG8_BAR; PG8_MMA(1, 1, At, B1); PG8_BAR;
            }
        }
        if constexpr (ALIGN_EPI) { if (wr == 0) PG8_BAR; }
        if constexpr (!Epi::AFTER_DRAIN) { E(acc, cur, wr, wc, fr, fq); S.done(cur); }
        if (!has_next) break;
#pragma unroll
        for (int a = 0; a < 2; ++a)
#pragma unroll
            for (int b = 0; b < 2; ++b)
#pragma unroll
                for (int m = 0; m < 4; ++m)
#pragma unroll
                    for (int n = 0; n < 2; ++n) acc[a][b][m][n] = (f32x4){0.f, 0.f, 0.f, 0.f};
        cur = nxt; cA = nA; cB = nB; ++ui;
        if constexpr (ALIGN_EPI) { if (wr == 1) PG8_BAR; }
    }
    PG8_WAIT_V(0);
    if constexpr (!ALIGN_EPI) { if (wr == 0) PG8_BAR; }
    PG8_BAR;
    if constexpr (Epi::AFTER_DRAIN) { E.fused(acc, cur, wr, wc, fr, fq, lds, wid, lane); S.done(cur); }
#undef PG8_SA
#undef PG8_SB
#undef PG8_STAGE
#undef PG8_LDA
#undef PG8_LDB
#undef PG8_MMA
#undef PG8_WAIT_V
#undef PG8_WAIT_L
#undef PG8_BAR
#undef PG8_SCHED
}
}

constexpr int NWAVES = 8, NT = NWAVES * 64;
constexpr int BATCH = 2, SEQ = 4096, DM = 2048, M = BATCH * SEQ;
constexpr int DFF = 5632, NGU = 2 * DFF;
constexpr int INC = 6432, INP = 6656;
constexpr int AW = 1024, RW = 1024, NH = 16, HD = 64;
constexpr int PLE = 256;
constexpr int UQ = 0, UK = 1024, UV = 2048, UR = 3072;
constexpr float LN_EPS = 1e-5f, GN_EPS = 64e-5f;
constexpr float ALPHA = 1.189207115002721f;
constexpr float LOG2E = 1.4426950408889634f;

constexpr size_t MiB = 1u << 20;
constexpr size_t WS_CTL = 0, CTL_ZERO_BYTES = 1 * MiB;
constexpr size_t WS_WGU = 2 * MiB;
constexpr size_t WS_WD = 46 * MiB;
constexpr size_t WS_WIN = 68 * MiB;
constexpr size_t WS_WOUT = 94 * MiB;
constexpr size_t WS_WPG = 102 * MiB;
constexpr size_t WS_WPU = 110 * MiB;
constexpr size_t WS_SMALL = 111 * MiB;
constexpr size_t WS_XB = 112 * MiB;
constexpr size_t WS_BIG = 144 * MiB;
constexpr size_t WS_MIX = 248 * MiB;
constexpr size_t WS_SCAN = 280 * MiB;
constexpr size_t WS_F2 = 312 * MiB;
constexpr size_t WS_PB = 392 * MiB;
constexpr size_t WS_END = 396 * MiB;
constexpr size_t SM_W2T = 0, SM_A2T = 131072, SM_G2T = 262144, SM_KMEAN = 655360;
constexpr size_t WS_BONUS = 1 * MiB;
static_assert(SM_G2T + 1024 * 192 * 2 <= SM_KMEAN && SM_KMEAN + 2 * 16 * 16 * 64 * 2 <= MiB, "small map");
constexpr int CW_TMO = 0, CW_BAR = 4096, CW_QUEUE = 8192;
constexpr size_t WS_STATS = 65536, WS_CVEC = 262144, WS_GB = 425984;
static_assert(WS_STATS + 3 * 2 * (size_t)M * 4 <= WS_CVEC && WS_CVEC + 2 * (size_t)(INP + NGU + DM) * 4 <= CTL_ZERO_BYTES, "control region map");

constexpr int RING_BYTES = 131072;
constexpr int LDSCTL_OFF = RING_BYTES, MISC_OFF = LDSCTL_OFF + 320;
constexpr int LDS_BYTES = 147456;

#define GAS __attribute__((address_space(1)))
#define LAS __attribute__((address_space(3)))
typedef unsigned short bf16;
typedef unsigned v4u __attribute__((ext_vector_type(4)));
typedef unsigned v2u __attribute__((ext_vector_type(2)));
typedef float f32x4 __attribute__((ext_vector_type(4)));
typedef float f32x16 __attribute__((ext_vector_type(16)));
typedef short bf16x8 __attribute__((ext_vector_type(8)));
typedef short s16x4 __attribute__((ext_vector_type(4)));
typedef GAS unsigned gu32;
#define RLX_AGENT __ATOMIC_RELAXED, __HIP_MEMORY_SCOPE_AGENT
#define LDS_WAIT() asm volatile("s_waitcnt lgkmcnt(0)" ::: "memory")
#define VM_WAIT() asm volatile("s_waitcnt vmcnt(0)" ::: "memory")
__device__ __forceinline__ unsigned f2bf(float f) { unsigned u = __builtin_bit_cast(unsigned, f); return (u + 0x7fffu + ((u >> 16) & 1u)) >> 16; }
__device__ __forceinline__ unsigned pk2(float lo, float hi) { return f2bf(lo) | (f2bf(hi) << 16); }
__device__ __forceinline__ float bf2f(unsigned short b) { return __uint_as_float((unsigned)b << 16); }
__device__ __forceinline__ float bflo(unsigned w) { return __uint_as_float(w << 16); }
__device__ __forceinline__ float bfhi(unsigned w) { return __uint_as_float(w & 0xffff0000u); }

#define XB_TMO      128
#define XB_XCNT(j)  (256  + 64 * (j))
#define XB_XSUB(j)  (1280 + 64 * (j))
#define XB_XGEN(j)  (2304 + 64 * (j))
#define XB_TOP      3328
#define XB_TOPGEN   3392
#define XCD_BAR_WORDS 3456
#define XB_SPIN_CAP (1u << 18)
__device__ __forceinline__ unsigned xb_ld(unsigned* p)              { return __hip_atomic_load(p, __ATOMIC_RELAXED, __HIP_MEMORY_SCOPE_AGENT); }
__device__ __forceinline__ unsigned xb_add(unsigned* p, unsigned v) { return __hip_atomic_fetch_add(p, v, __ATOMIC_RELAXED, __HIP_MEMORY_SCOPE_AGENT); }
__device__ __forceinline__ unsigned xb_xcc_id() { return (unsigned)__builtin_amdgcn_s_getreg((3 << 11) | 20) & 0xFu; }
#define XB_SPIN(cond, bar) do { unsigned _sp = 0; while (cond) { __builtin_amdgcn_s_sleep(1); \
    if ((++_sp & 255u) == 0u) { if (xb_ld(&(bar)[XB_TMO])) break; if (_sp > XB_SPIN_CAP) { atomicAdd(&(bar)[XB_TMO], 1u); break; } } } } while (0)
struct XcdBarrier { unsigned* bar; unsigned x; volatile LAS unsigned* st; };
__device__ __forceinline__ XcdBarrier xcd_barrier_post(unsigned* bar, volatile LAS unsigned* st) {
    XcdBarrier b; b.bar = bar; b.x = xb_xcc_id(); b.st = st;
    if (threadIdx.x == 0) (void)xb_add(&bar[XB_XCNT(b.x)], 1u);
    return b;
}
__device__ __forceinline__ void xcd_barrier_complete(unsigned* bar, unsigned x, unsigned& nloc, unsigned& nx) {
    const unsigned G = gridDim.x * gridDim.y * gridDim.z;
    unsigned sum, cnt, mine, sp = 0u;
    for (;;) {
        sum = 0u; cnt = 0u; mine = 0u;
#pragma unroll
        for (unsigned j = 0; j < 16; ++j) { const unsigned c = xb_ld(&bar[XB_XCNT(j)]); sum += c; cnt += (c > 0u) ? 1u : 0u; mine = (j == x) ? c : mine; }
        if (sum == G) break;
        __builtin_amdgcn_s_sleep(1);
        if ((++sp & 255u) == 0u) { if (xb_ld(&bar[XB_TMO])) break; if (sp > XB_SPIN_CAP) { atomicAdd(&bar[XB_TMO], 1u); break; } }
    }
    nloc = mine > 0u ? mine : 1u; nx = cnt > 0u ? cnt : 1u;
}
__device__ __forceinline__ void xcd_barrier(const XcdBarrier& b) {
    asm volatile("s_waitcnt vmcnt(0)" ::: "memory");
    __syncthreads();
    if (threadIdx.x == 0) {
        unsigned* bar = b.bar;
        __builtin_amdgcn_s_waitcnt(0);
        unsigned nloc = b.st[0], nx = b.st[1];
        if (nloc == 0u) { xcd_barrier_complete(bar, b.x, nloc, nx); b.st[0] = nloc; b.st[1] = nx; }
        const unsigned old = xb_add(&bar[XB_XSUB(b.x)], 1u);
        const unsigned gen = old / nloc;
        if (old + 1u == (gen + 1u) * nloc) {
            __builtin_amdgcn_fence(__ATOMIC_RELEASE, "agent");
            asm volatile("s_waitcnt vmcnt(0)" ::: "memory");
            const unsigned og = xb_add(&bar[XB_TOP], 1u);
            const unsigned tg = og / nx;
            if (og + 1u == (tg + 1u) * nx) xb_add(&bar[XB_TOPGEN], 1u);
            else XB_SPIN(xb_ld(&bar[XB_TOPGEN]) == tg, bar);
            __builtin_amdgcn_fence(__ATOMIC_ACQUIRE, "agent");
            xb_add(&bar[XB_XGEN(b.x)], 1u);
            asm volatile("s_waitcnt vmcnt(0)" ::: "memory");
        } else {
            XB_SPIN(xb_ld(&bar[XB_XGEN(b.x)]) == gen, bar);
            __builtin_amdgcn_fence(__ATOMIC_ACQUIRE, "agent");
            asm volatile("s_waitcnt vmcnt(0)" ::: "memory");
        }
    }
    __syncthreads();
}

struct Args { const float* in[33]; float* out; unsigned char* ws; int ph_lo, ph_hi; };
struct Frame {
    LAS unsigned char* lds;
    int tid, lane, wave, G, bid;
    const float* const* in;
    float* hz;
    unsigned char* ws;
};
__device__ __forceinline__ float wave_sum(float v) {
#pragma unroll
    for (int o = 1; o < 64; o <<= 1) v += __shfl_xor(v, o);
    return v;
}
__device__ __forceinline__ unsigned cvtpk(float lo, float hi) { typedef float f2 __attribute__((ext_vector_type(2))); typedef __bf16 b2 __attribute__((ext_vector_type(2))); f2 v = {lo, hi}; b2 b = __builtin_convertvector(v, b2); return __builtin_bit_cast(unsigned, b); }
__device__ __forceinline__ float swapmax(float m) { auto rr = __builtin_amdgcn_permlane32_swap(__float_as_uint(m), __float_as_uint(m), false, false); return fmaxf(__uint_as_float(rr[0]), __uint_as_float(rr[1])); }
__device__ __forceinline__ float swapsum(float m) { auto rr = __builtin_amdgcn_permlane32_swap(__float_as_uint(m), __float_as_uint(m), false, false); return __uint_as_float(rr[0]) + __uint_as_float(rr[1]); }

struct TrItem { f32x4 v[8]; };
__device__ __forceinline__ void tr_load(TrItem& T, const float* W, int Kvalid, int N, int k0, int n0, int lane) {
#pragma unroll
    for (int i = 0; i < 8; ++i) { const int kk = (lane >> 3) + 8 * i; T.v[i] = (f32x4){0.f, 0.f, 0.f, 0.f}; if (k0 + kk < Kvalid) T.v[i] = *(const GAS f32x4*)(W + (size_t)(k0 + kk) * N + n0 + 4 * (lane & 7)); }
}
template <bool LNF>
__device__ __forceinline__ void tr_store(const TrItem& T, bf16* WT, int ldo, int orow0, LAS float* scr, int k0, int lane, const float* gk, const float* bk, float* c1, float* c2) {
#pragma unroll
    for (int i = 0; i < 8; ++i) { const int kk = (lane >> 3) + 8 * i; LAS float* d = scr + kk * 33 + 4 * (lane & 7); d[0] = T.v[i][0]; d[1] = T.v[i][1]; d[2] = T.v[i][2]; d[3] = T.v[i][3]; }
    LDS_WAIT(); asm volatile("" ::: "memory");
    const int c = lane & 7;
    float gg[8], bb[8];
    if (LNF) { const f32x4 g0 = *(const GAS f32x4*)(gk + k0 + 8 * c), g1 = *(const GAS f32x4*)(gk + k0 + 8 * c + 4), b0 = *(const GAS f32x4*)(bk + k0 + 8 * c), b1 = *(const GAS f32x4*)(bk + k0 + 8 * c + 4);
#pragma unroll
        for (int i = 0; i < 4; ++i) { gg[i] = g0[i]; gg[4 + i] = g1[i]; bb[i] = b0[i]; bb[4 + i] = b1[i]; } }
#pragma unroll
    for (int j = 0; j < 4; ++j) { const int n = (lane >> 3) + 8 * j; const LAS float* s = scr + (8 * c) * 33 + n;
        float w[8];
#pragma unroll
        for (int i = 0; i < 8; ++i) w[i] = s[i * 33];
        float s1 = 0.f, s2 = 0.f;
        if (LNF) {
#pragma unroll
            for (int i = 0; i < 8; ++i) { s2 += bb[i] * w[i]; w[i] *= gg[i]; } }
        v4u o; o.x = pk2(w[0], w[1]); o.y = pk2(w[2], w[3]); o.z = pk2(w[4], w[5]); o.w = pk2(w[6], w[7]);
        *(GAS v4u*)(WT + (size_t)(orow0 + n) * ldo + k0 + 8 * c) = o;
        if (LNF) { s1 = (bflo(o.x) + bfhi(o.x)) + (bflo(o.y) + bfhi(o.y)) + (bflo(o.z) + bfhi(o.z)) + (bflo(o.w) + bfhi(o.w));
            s1 += __shfl_xor(s1, 1); s2 += __shfl_xor(s2, 1); s1 += __shfl_xor(s1, 2); s2 += __shfl_xor(s2, 2); s1 += __shfl_xor(s1, 4); s2 += __shfl_xor(s2, 4);
            if (c == 0) { atomicAdd(c1 + orow0 + n, s1); atomicAdd(c2 + orow0 + n, s2); } } }
    LDS_WAIT(); asm volatile("" ::: "memory");
}
template <bool LNF = false>
__device__ __forceinline__ void transpose_job(Frame& F, const float* W, int Kvalid, int Kpad, int N, bf16* WT, int ldo, int mode, int& base, const float* gk = nullptr, const float* bk = nullptr, float* c1 = nullptr, float* c2 = nullptr, int wrank = -1, int wcount = 0) {
    LAS float* scr = (LAS float*)(F.lds + F.wave * 16384);
    const int gw = (wrank >= 0) ? wrank : F.bid * NWAVES + F.wave, NGW = (wrank >= 0) ? wcount : F.G * NWAVES;
    const int nblk = N / 32, items = (Kpad / 64) * nblk;
    const int first = (gw - base % NGW + NGW) % NGW;
#define TR_DECODE(it, k0_, n0_, orow_) const int k0_ = 64 * ((it) / nblk), n0_ = 32 * ((it) % nblk), orow_ = (mode == 0) ? n0_ : ((n0_ >> 7) * 256 + (mode == 2 ? 128 : 0) + (n0_ & 127))
    TrItem A, B;
    int it = first;
    if (it < items) { TR_DECODE(it, k0, n0, orow); (void)orow; tr_load(A, W, Kvalid, N, k0, n0, F.lane); }
    while (it < items) {
        { const int nx = it + NGW; if (nx < items) { TR_DECODE(nx, k1, n1, orow1); (void)orow1; tr_load(B, W, Kvalid, N, k1, n1, F.lane); }
          TR_DECODE(it, k0, n0, orow); (void)n0; tr_store<LNF>(A, WT, ldo, orow, scr, k0, F.lane, gk, bk, c1, c2); it = nx; }
        if (it >= items) break;
        { const int nx = it + NGW; if (nx < items) { TR_DECODE(nx, k1, n1, orow1); (void)orow1; tr_load(A, W, Kvalid, N, k1, n1, F.lane); }
          TR_DECODE(it, k0, n0, orow); (void)n0; tr_store<LNF>(B, WT, ldo, orow, scr, k0, F.lane, gk, bk, c1, c2); it = nx; }
    }
#undef TR_DECODE
    base += items;
}
__device__ __forceinline__ void convert_bf16(Frame& F, const float* src, bf16* dst, size_t n) {
    const size_t gt = (size_t)F.bid * NT + F.tid, NGT = (size_t)F.G * NT, n8 = n / 8;
    for (size_t i = gt; i < n8; i += 4 * NGT) { f32x4 a[4], b[4];
#pragma unroll
        for (int u = 0; u < 4; ++u) if (i + u * NGT < n8) { a[u] = *(const GAS f32x4*)(src + (i + u * NGT) * 8); b[u] = *(const GAS f32x4*)(src + (i + u * NGT) * 8 + 4); }
#pragma unroll
        for (int u = 0; u < 4; ++u) if (i + u * NGT < n8) { v4u o; o.x = pk2(a[u][0], a[u][1]); o.y = pk2(a[u][2], a[u][3]); o.z = pk2(b[u][0], b[u][1]); o.w = pk2(b[u][2], b[u][3]); *(GAS v4u*)(dst + (i + u * NGT) * 8) = o; } }
}
template <bool LNF>
__device__ __forceinline__ void ffn_weights(Frame& F, int gi, int ui, int di, bf16* Wgu_dst, bf16* Wd_dst, int& base, const float* gk = nullptr, const float* bk = nullptr, float* c1 = nullptr, float* c2 = nullptr, int wrank = -1, int wcount = 0) {
    transpose_job<LNF>(F, F.in[gi], DM, DM, DFF, Wgu_dst, DM, 1, base, gk, bk, c1, c2, wrank, wcount);
    transpose_job<LNF>(F, F.in[ui], DM, DM, DFF, Wgu_dst, DM, 2, base, gk, bk, c1, c2, wrank, wcount);
    transpose_job<false>(F, F.in[di], DFF, DFF, DM, Wd_dst, DFF, 0, base, nullptr, nullptr, nullptr, nullptr, wrank, wcount);
}

template <bool WRITE_BF16>
__device__ __forceinline__ void ln_phase(Frame& F, float* hz, const float* g, const float* b, bf16* hb) {
    const int gw = F.bid * NWAVES + F.wave, NGW = F.G * NWAVES;
    f32x4 gv[8], bv[8];
#pragma unroll
    for (int j = 0; j < 8; ++j) { gv[j] = *(const GAS f32x4*)(g + F.lane * 4 + 256 * j); bv[j] = *(const GAS f32x4*)(b + F.lane * 4 + 256 * j); }
    for (int m = gw; m < M; m += NGW) {
        GAS f32x4* xr = (GAS f32x4*)(hz + (size_t)m * DM) + F.lane;
        f32x4 v[8]; float s = 0.f;
#pragma unroll
        for (int j = 0; j < 8; ++j) { v[j] = xr[64 * j]; s += (v[j][0] + v[j][1]) + (v[j][2] + v[j][3]); }
        const float mean = wave_sum(s) * (1.f / DM); float s2 = 0.f;
#pragma unroll
        for (int j = 0; j < 8; ++j) { v[j] = v[j] - mean; s2 += (v[j][0] * v[j][0] + v[j][1] * v[j][1]) + (v[j][2] * v[j][2] + v[j][3] * v[j][3]); }
        const float rstd = 1.f / sqrtf(wave_sum(s2) * (1.f / DM) + LN_EPS);
#pragma unroll
        for (int j = 0; j < 8; ++j) { v[j] = v[j] * rstd * gv[j] + bv[j]; xr[64 * j] = v[j]; }
        if (WRITE_BF16) { GAS v2u* o8 = (GAS v2u*)(hb + (size_t)m * DM) + F.lane;
#pragma unroll
            for (int j = 0; j < 8; ++j) { v2u w; w.x = pk2(v[j][0], v[j][1]); w.y = pk2(v[j][2], v[j][3]); o8[64 * j] = w; } }
    }
}

__device__ __forceinline__ int crow(int r, int hi) { return (r & 3) + 8 * (r >> 2) + 4 * hi; }
__device__ __forceinline__ float red32(float v) {
#pragma unroll
    for (int o = 1; o < 32; o <<= 1) v += __shfl_xor(v, o);
    return v;
}
__device__ __forceinline__ void kmean_tasks(Frame& F) {
    const bf16* ub = (const bf16*)(F.ws + WS_BIG); bf16* km = (bf16*)(F.ws + WS_SMALL + SM_KMEAN);
    if (F.wave >= 2) return;
    for (int task = F.bid * 2 + F.wave; task < BATCH * 16 * NH; task += F.G * 2) {
        const int b = task >> 8, blk = (task >> 4) & 15, h = task & 15;
        const int par = F.lane >> 5, dp = F.lane & 31;
        const GAS unsigned* p = (const GAS unsigned*)(ub + (size_t)(b * SEQ + blk * 256 + par) * INP + UK + h * HD) + dp;
        float lo[16], hi_[16];
#pragma unroll
        for (int u = 0; u < 16; ++u) { lo[u] = 0.f; hi_[u] = 0.f; }
#pragma unroll 1
        for (int i = 0; i < 128; i += 16) {
            unsigned wv[16];
#pragma unroll
            for (int u = 0; u < 16; ++u) wv[u] = p[(size_t)(2 * (i + u)) * (INP / 2)];
#pragma unroll
            for (int u = 0; u < 16; ++u) { lo[u] += bflo(wv[u]); hi_[u] += bfhi(wv[u]); }
        }
        float sl = 0.f, sh = 0.f;
#pragma unroll
        for (int u = 0; u < 16; ++u) { sl += lo[u]; sh += hi_[u]; }
        sl += __shfl_xor(sl, 32); sh += __shfl_xor(sh, 32);
        if (par == 0) *(GAS unsigned*)(km + ((b * NH + h) * 16 + blk) * HD + 2 * dp) = pk2(sl * (1.f / 256.f), sh * (1.f / 256.f));
    }
}
__device__ __forceinline__ void shifted4(const bf16* ucol  , bool first_is_seq_start, float mix, float (&o)[4]) {
    float pv = first_is_seq_start ? 0.f : bf2f(*(ucol - INP));
#pragma unroll
    for (int i = 0; i < 4; ++i) { const float c = bf2f(ucol[(size_t)i * INP]); o[i] = c + (pv - c) * mix; pv = c; }
}
constexpr int PA_W = 0, PA_A = 4608, PA_G = 9216, PA_PITCH = 144, PG_PITCH = 400;
__device__ __forceinline__ void prep_tile(Frame& F, int tile) {
    const bf16* ub = (const bf16*)(F.ws + WS_BIG);
    const int m0 = tile * 32;
    const float* shift_mix = F.in[9];
    LAS unsigned char* L = F.lds;
    for (int idx = F.tid; idx < 32 * 288; idx += NT) {
        const int t = idx / 288, k = idx - t * 288, m = m0 + t;
        const bf16* up = ub + (size_t)m * INP + UR + 3072 + k;
        const float cur = bf2f(*up), prev = ((m & (SEQ - 1)) == 0) ? 0.f : bf2f(*(up - INP));
        const float us = cur + (prev - cur) * shift_mix[3072 + k];
        if (k < 64) { const float e2 = __expf(2.f * us); *(LAS bf16*)(L + PA_W + t * PA_PITCH + k * 2) = (bf16)f2bf(1.f - 2.f / (e2 + 1.f)); }
        else if (k < 128) *(LAS bf16*)(L + PA_A + t * PA_PITCH + (k - 64) * 2) = (bf16)f2bf(us);
        else *(LAS bf16*)(L + PA_G + t * PG_PITCH + (k - 128) * 2) = (bf16)f2bf(1.f / (1.f + __expf(-us)));
    }
    for (int idx = F.tid; idx < 32 * 32; idx += NT) *(LAS bf16*)(L + PA_G + (idx >> 5) * PG_PITCH + (160 + (idx & 31)) * 2) = 0;
    __syncthreads();
    const bf16* w2t = (const bf16*)(F.ws + WS_SMALL + SM_W2T); const bf16* a2t = (const bf16*)(F.ws + WS_SMALL + SM_A2T); const bf16* g2t = (const bf16*)(F.ws + WS_SMALL + SM_G2T);
    const float *w0 = F.in[10], *a0 = F.in[12], *k_k = F.in[15], *k_a = F.in[16], *r_k = F.in[17];
    bf16* SR = (bf16*)(F.ws + WS_SCAN); bf16* SE = SR + (size_t)M * RW; bf16* SKP = SE + (size_t)M * RW; bf16* SV = SKP + (size_t)M * RW;
    bf16* SKK = SV + (size_t)M * RW; bf16* SBB = SKK + (size_t)M * RW; bf16* SGG = SBB + (size_t)M * RW;
    float* bonus = (float*)(F.ws + WS_BONUS);
    const int r32 = F.lane & 31, hi = F.lane >> 5;
    const bool seq0 = (m0 & (SEQ - 1)) == 0;
    for (int hp = 0; hp < 2; ++hp) {
        const int head = 2 * F.wave + hp;
        float n2[16], bon[16];
#pragma unroll
        for (int r = 0; r < 16; ++r) { n2[r] = 0.f; bon[r] = 0.f; }
        for (int nt = 0; nt < 2; ++nt) {
            const int c = head * 64 + 32 * nt + r32;
            f32x16 accA = {};
#pragma unroll
            for (int ks = 0; ks < 4; ++ks) { const bf16x8 af = *(const LAS bf16x8*)(L + PA_A + r32 * PA_PITCH + (16 * ks + 8 * hi) * 2); const bf16x8 bfr = *(const GAS bf16x8*)(a2t + c * 64 + 16 * ks + 8 * hi);
                accA = __builtin_amdgcn_mfma_f32_32x32x16_bf16(af, bfr, accA, 0, 0, 0); }
            const float a0c = a0[c], kkc = k_k[c], kac = k_a[c], rkc = r_k[c], mixr = shift_mix[c], mixk = shift_mix[1024 + c];
#pragma unroll
            for (int g = 0; g < 4; ++g) { const int tb = 8 * g + 4 * hi; float rr[4], kr[4];
                shifted4(ub + (size_t)(m0 + tb) * INP + UR + c, seq0 && tb == 0, mixr, rr);
                shifted4(ub + (size_t)(m0 + tb) * INP + UR + 1024 + c, seq0 && tb == 0, mixk, kr);
#pragma unroll
                for (int i = 0; i < 4; ++i) { const int r = 4 * g + i; const float a = 1.f / (1.f + __expf(-(a0c + accA[r])));
                    const float kq = kr[i] * kkc; n2[r] += kq * kq; bon[r] += rr[i] * kr[i] * (1.f + (a - 1.f) * kac) * rkc; } }
        }
        float inv[16];
#pragma unroll
        for (int r = 0; r < 16; ++r) { const float s = red32(n2[r]); inv[r] = 1.f / fmaxf(sqrtf(s), 1e-12f); bon[r] = red32(bon[r]); }
        if (r32 == 0) {
#pragma unroll
            for (int r = 0; r < 16; ++r) bonus[(size_t)(m0 + crow(r, hi)) * NH + head] = bon[r]; }
        for (int nt = 0; nt < 2; ++nt) {
            const int c = head * 64 + 32 * nt + r32;
            f32x16 accA = {}, accW = {}, accG = {};
#pragma unroll
            for (int ks = 0; ks < 4; ++ks) { const bf16x8 af = *(const LAS bf16x8*)(L + PA_A + r32 * PA_PITCH + (16 * ks + 8 * hi) * 2); const bf16x8 bfr = *(const GAS bf16x8*)(a2t + c * 64 + 16 * ks + 8 * hi);
                accA = __builtin_amdgcn_mfma_f32_32x32x16_bf16(af, bfr, accA, 0, 0, 0);
                const bf16x8 wf = *(const LAS bf16x8*)(L + PA_W + r32 * PA_PITCH + (16 * ks + 8 * hi) * 2); const bf16x8 bw = *(const GAS bf16x8*)(w2t + c * 64 + 16 * ks + 8 * hi);
                accW = __builtin_amdgcn_mfma_f32_32x32x16_bf16(wf, bw, accW, 0, 0, 0); }
#pragma unroll
            for (int ks = 0; ks < 12; ++ks) { const bf16x8 gf = *(const LAS bf16x8*)(L + PA_G + r32 * PG_PITCH + (16 * ks + 8 * hi) * 2); const bf16x8 bg = *(const GAS bf16x8*)(g2t + c * 192 + 16 * ks + 8 * hi);
                accG = __builtin_amdgcn_mfma_f32_32x32x16_bf16(gf, bg, accG, 0, 0, 0); }
            const float a0c = a0[c], w0c = w0[c], kkc = k_k[c], kac = k_a[c], mixr = shift_mix[c], mixk = shift_mix[1024 + c], mixv = shift_mix[2048 + c];
#pragma unroll
            for (int g = 0; g < 4; ++g) { const int tb = 8 * g + 4 * hi; float rr[4], kr[4], vr[4];
                shifted4(ub + (size_t)(m0 + tb) * INP + UR + c, seq0 && tb == 0, mixr, rr);
                shifted4(ub + (size_t)(m0 + tb) * INP + UR + 1024 + c, seq0 && tb == 0, mixk, kr);
                shifted4(ub + (size_t)(m0 + tb) * INP + UR + 2048 + c, seq0 && tb == 0, mixv, vr);
#pragma unroll
                for (int i = 0; i < 4; ++i) { const int r = 4 * g + i; const size_t o = (size_t)(m0 + tb + i) * RW + c;
                    const float a = 1.f / (1.f + __expf(-(a0c + accA[r])));
                    const float x = -(w0c + accW[r]);
                    const float sp = fmaxf(x, 0.f) + __logf(1.f + __expf(-fabsf(x)));
                    const float e = __expf(-sp - 0.5f);
                    const float kk = kr[i] * kkc * inv[r], kp = kr[i] * (1.f + (a - 1.f) * kac);
                    SR[o] = (bf16)f2bf(rr[i]); SE[o] = (bf16)f2bf(e); SKP[o] = (bf16)f2bf(kp); SV[o] = (bf16)f2bf(vr[i]);
                    SKK[o] = (bf16)f2bf(kk); SBB[o] = (bf16)f2bf(kk * a); SGG[o] = (bf16)f2bf(accG[r]); } }
        }
    }
    __syncthreads();
}

__device__ __forceinline__ s16x4 vtr(const LAS unsigned char* p) { typedef short v4i16_t __attribute__((ext_vector_type(4))); return __builtin_bit_cast(s16x4, __builtin_amdgcn_ds_read_tr16_b64_v4i16((LAS v4i16_t*)p)); }
constexpr int CP = 144, CMB = 64 * CP;
enum { C_AT = 0, C_BT, C_KT, C_RT, C_BP, C_KP, C_VV, C_Q0, C_Q1, C_X0, C_X1, C_AK, C_BR, C_KR, C_NSLOT };
static_assert(C_NSLOT * CMB <= RING_BYTES, "chunk pre-pass LDS");
constexpr int C_SMALL = 132096;
constexpr size_t CH_UNIT = 32768, CH_TT = 0, CH_PT = 8192, CH_HT = 16384, CH_YV = 24576;
__device__ __forceinline__ bf16x8 trfrag(const LAS unsigned char* Mt, int k0, int c0, int lane) {
    const LAS unsigned char* p = Mt + (k0 + 8 * (lane >> 5) + ((lane & 15) >> 2)) * CP + (c0 + 16 * ((lane >> 4) & 1) + 4 * (lane & 3)) * 2;
    const s16x4 lo = vtr(p), hh = vtr(p + 4 * CP);
    return (bf16x8){lo[0], lo[1], lo[2], lo[3], hh[0], hh[1], hh[2], hh[3]};
}
template <bool A_TR, bool B_TR>
__device__ __forceinline__ f32x16 tile_mm(const LAS unsigned char* A, int r0, const LAS unsigned char* B, int c0, f32x16 acc, int lane) {
    const int r32 = lane & 31, hi = lane >> 5;
#pragma unroll
    for (int ks = 0; ks < 4; ++ks) {
        const bf16x8 af = A_TR ? trfrag(A, 16 * ks, r0, lane) : *(const LAS bf16x8*)(A + (r0 + r32) * CP + (16 * ks + 8 * hi) * 2);
        const bf16x8 bf = B_TR ? trfrag(B, 16 * ks, c0, lane) : *(const LAS bf16x8*)(B + (c0 + r32) * CP + (16 * ks + 8 * hi) * 2);
        acc = __builtin_amdgcn_mfma_f32_32x32x16_bf16(af, bf, acc, 0, 0, 0);
    }
    return acc;
}
__device__ __forceinline__ void tile_store_lds(LAS unsigned char* Z, int r0, int c0, const f32x16& v, int lane) {
    const int r32 = lane & 31, hi = lane >> 5;
#pragma unroll
    for (int r = 0; r < 16; ++r) *(LAS bf16*)(Z + (r0 + crow(r, hi)) * CP + (c0 + r32) * 2) = (bf16)f2bf(v[r]);
}
__device__ __forceinline__ void tile_store_glb_t(bf16* G, int r0, int c0, const f32x16& v, int lane) {
    const int r32 = lane & 31, hi = lane >> 5;
#pragma unroll
    for (int g = 0; g < 4; ++g) { v2u w; w.x = pk2(v[4 * g], v[4 * g + 1]); w.y = pk2(v[4 * g + 2], v[4 * g + 3]);
        *(GAS v2u*)(G + (size_t)(c0 + r32) * 64 + r0 + 8 * g + 4 * hi) = w; }
}
constexpr int RAW_R = C_AT, RAW_K = C_BT, RAW_V = C_KT, RAW_E = C_RT, RAW_KK = C_BP, RAW_BB = C_KP, RAW_KP = C_VV, ACT_W = C_Q0, ACT_A = C_Q1, ACT_G = C_X0;
constexpr int GPITCH = 400, C_PART = C_SMALL + 2048 + 256;
static_assert(64 * GPITCH <= 3 * CMB, "gate activations fit three slots");
constexpr size_t VG_UNIT = 16384, VG_VS = 0, VG_GG = 8192;
#define LBAR() do { asm volatile("s_waitcnt lgkmcnt(0)" ::: "memory"); __builtin_amdgcn_s_barrier(); asm volatile("" ::: "memory"); } while (0)
#ifndef DUP_U1
#define DUP_U1 1
#endif
#ifndef DUP_U2
#define DUP_U2 1
#endif
#ifndef DUP_S1
#define DUP_S1 1
#endif
#ifndef DUP_S3
#define DUP_S3 1
#endif
#ifndef DUP_S4
#define DUP_S4 1
#endif
#ifndef DUP_S5
#define DUP_S5 1
#endif
__device__ __forceinline__ void chunk_prepass(Frame& F, int unit) {
    const int bh = unit >> 6, c = unit & 63, b = bh >> 4, h = bh & 15;
    const size_t m0 = (size_t)b * SEQ + (size_t)c * 64;
    const bf16* ub = (const bf16*)(F.ws + WS_BIG);
    LAS unsigned char* L = F.lds;
    LAS float* totals = (LAS float*)(L + C_SMALL); LAS float* gend = totals + 512; LAS float* part = (LAS float*)(L + C_PART);
    bf16* CH = (bf16*)(F.ws + WS_WGU + (size_t)unit * CH_UNIT);
    bf16* VG = (bf16*)(F.ws + WS_SCAN + (size_t)unit * VG_UNIT);
    const int lane = F.lane, w = F.wave, r32 = lane & 31, hi = lane >> 5;
    const float* shift_mix = F.in[9];
_Pragma("unroll 1") for (int rep_ = 0; rep_ < DUP_U1; ++rep_)
    {
        const int p = F.tid & 31, t16 = F.tid >> 5;
        const GAS unsigned* ubase = (const GAS unsigned*)(ub + m0 * INP + UR);
        const int prev0 = (c == 0) ? 0 : -(INP / 2);
        unsigned cu[4][3], pv[4][3];
#pragma unroll
        for (int pass = 0; pass < 4; ++pass) { const int t = t16 + 16 * pass; const int ro = t * (INP / 2), rp = (t == 0) ? prev0 : ro - (INP / 2);
#pragma unroll
            for (int a = 0; a < 3; ++a) { const int co = (a * 1024 + h * HD) / 2 + p; cu[pass][a] = ubase[ro + co]; pv[pass][a] = ubase[rp + co]; } }
        float mx[3][2];
#pragma unroll
        for (int a = 0; a < 3; ++a) { mx[a][0] = shift_mix[a * 1024 + h * HD + 2 * p]; mx[a][1] = shift_mix[a * 1024 + h * HD + 2 * p + 1]; }
#pragma unroll 1
        for (int half = 0; half < 2; ++half) {
            unsigned cl[9], pl[9];
#pragma unroll
            for (int n = 0; n < 9; ++n) { const int idx = F.tid + NT * (9 * half + n), t = idx / 144, pp = idx - 144 * t; const int ro = t * (INP / 2), rp = (t == 0) ? prev0 : ro - (INP / 2);
                cl[n] = ubase[ro + 1536 + pp]; pl[n] = ubase[rp + 1536 + pp]; }
            if (half == 0) {
#pragma unroll
                for (int pass = 0; pass < 4; ++pass) { const int t = t16 + 16 * pass; const bool first = (c == 0 && t == 0);
#pragma unroll
                    for (int a = 0; a < 3; ++a) { const unsigned cu_ = cu[pass][a], pv_ = first ? 0u : pv[pass][a];
                        const float lo = bflo(cu_) + (bflo(pv_) - bflo(cu_)) * mx[a][0], hi_ = bfhi(cu_) + (bfhi(pv_) - bfhi(cu_)) * mx[a][1];
                        *(LAS unsigned*)(L + (a == 0 ? RAW_R : a == 1 ? RAW_K : RAW_V) * CMB + t * CP + p * 4) = cvtpk(lo, hi_); } } }
#pragma unroll
            for (int n = 0; n < 9; ++n) { const int idx = F.tid + NT * (9 * half + n), t = idx / 144, pp = idx - 144 * t; const bool first = (c == 0 && t == 0);
                const unsigned cu_ = cl[n], pv_ = first ? 0u : pl[n];
                const float m0_ = shift_mix[3072 + 2 * pp], m1_ = shift_mix[3072 + 2 * pp + 1];
                float lo = bflo(cu_) + (bflo(pv_) - bflo(cu_)) * m0_, hi_ = bfhi(cu_) + (bfhi(pv_) - bfhi(cu_)) * m1_;
                if (pp < 32) { lo = 1.f - 2.f / (__expf(2.f * lo) + 1.f); hi_ = 1.f - 2.f / (__expf(2.f * hi_) + 1.f); *(LAS unsigned*)(L + ACT_W * CMB + t * CP + pp * 4) = cvtpk(lo, hi_); }
                else if (pp < 64) *(LAS unsigned*)(L + ACT_A * CMB + t * CP + (pp - 32) * 4) = cvtpk(lo, hi_);
                else { lo = 1.f / (1.f + __expf(-lo)); hi_ = 1.f / (1.f + __expf(-hi_)); *(LAS unsigned*)(L + ACT_G * CMB + t * GPITCH + (pp - 64) * 4) = cvtpk(lo, hi_); } }
        }
        for (int idx = F.tid; idx < 64 * 16; idx += NT) *(LAS unsigned*)(L + ACT_G * CMB + (idx >> 4) * GPITCH + (80 + (idx & 15)) * 4) = 0u;
        LBAR();
    }
_Pragma("unroll 1") for (int rep_ = 0; rep_ < DUP_U2; ++rep_)
    {
        const int tr = (w >> 1) & 1, tc = w & 1, t = 32 * tc + r32;
        const bf16* w2t = (const bf16*)(F.ws + WS_SMALL + SM_W2T); const bf16* a2t = (const bf16*)(F.ws + WS_SMALL + SM_A2T); const bf16* g2t = (const bf16*)(F.ws + WS_SMALL + SM_G2T);
        float a_[16], kq_[16];
        if (w < 4) {
            f32x16 accW = {}, accA = {};
#pragma unroll
            for (int ks = 0; ks < 4; ++ks) { const bf16x8 bw = *(const LAS bf16x8*)(L + ACT_W * CMB + t * CP + (16 * ks + 8 * hi) * 2), ba = *(const LAS bf16x8*)(L + ACT_A * CMB + t * CP + (16 * ks + 8 * hi) * 2);
                const bf16x8 aw = *(const GAS bf16x8*)(w2t + (h * HD + 32 * tr + r32) * 64 + 16 * ks + 8 * hi), aa = *(const GAS bf16x8*)(a2t + (h * HD + 32 * tr + r32) * 64 + 16 * ks + 8 * hi);
                accW = __builtin_amdgcn_mfma_f32_32x32x16_bf16(aw, bw, accW, 0, 0, 0); accA = __builtin_amdgcn_mfma_f32_32x32x16_bf16(aa, ba, accA, 0, 0, 0); }
            const float *w0 = F.in[10], *a0 = F.in[12], *k_k = F.in[15], *k_a = F.in[16], *r_k = F.in[17];
            float n2 = 0.f, bon = 0.f;
#pragma unroll
            for (int g = 0; g < 4; ++g) { const int jb = 32 * tr + 8 * g + 4 * hi;
                const v2u rw_ = *(const LAS v2u*)(L + RAW_R * CMB + t * CP + jb * 2), kw_ = *(const LAS v2u*)(L + RAW_K * CMB + t * CP + jb * 2);
                const float rr[4] = {bflo(rw_.x), bfhi(rw_.x), bflo(rw_.y), bfhi(rw_.y)}, kr[4] = {bflo(kw_.x), bfhi(kw_.x), bflo(kw_.y), bfhi(kw_.y)};
                const f32x4 w0v = *(const GAS f32x4*)(w0 + h * HD + jb), a0v = *(const GAS f32x4*)(a0 + h * HD + jb), kkv = *(const GAS f32x4*)(k_k + h * HD + jb), kav = *(const GAS f32x4*)(k_a + h * HD + jb), rkv = *(const GAS f32x4*)(r_k + h * HD + jb);
                float e4[4], kp4[4];
#pragma unroll
                for (int i = 0; i < 4; ++i) { const int r = 4 * g + i;
                    const float a = 1.f / (1.f + __expf(-(a0v[i] + accA[r])));
                    const float x = -(w0v[i] + accW[r]); const float sp = fmaxf(x, 0.f) + __logf(1.f + __expf(-fabsf(x)));
                    e4[i] = __expf(-sp - 0.5f);
                    const float kq = kr[i] * kkv[i]; kp4[i] = kr[i] * (1.f + (a - 1.f) * kav[i]);
                    n2 += kq * kq; bon += rr[i] * kp4[i] * rkv[i]; a_[r] = a; kq_[r] = kq; }
                v2u ew, kw2; ew.x = cvtpk(e4[0], e4[1]); ew.y = cvtpk(e4[2], e4[3]); kw2.x = cvtpk(kp4[0], kp4[1]); kw2.y = cvtpk(kp4[2], kp4[3]);
                *(LAS v2u*)(L + RAW_E * CMB + t * CP + jb * 2) = ew; *(LAS v2u*)(L + RAW_KP * CMB + t * CP + jb * 2) = kw2; }
            n2 = swapsum(n2); bon = swapsum(bon);
            if (hi == 0) { part[tr * 64 + t] = n2; part[128 + tr * 64 + t] = bon; }
        } else {
            f32x16 accG = {};
#pragma unroll
            for (int ks = 0; ks < 12; ++ks) { const bf16x8 bg = *(const LAS bf16x8*)(L + ACT_G * CMB + t * GPITCH + (16 * ks + 8 * hi) * 2);
                const bf16x8 ag = *(const GAS bf16x8*)(g2t + (h * HD + 32 * tr + r32) * 192 + 16 * ks + 8 * hi);
                accG = __builtin_amdgcn_mfma_f32_32x32x16_bf16(ag, bg, accG, 0, 0, 0); }
            tile_store_glb_t(VG + VG_GG / 2, 32 * tr, 32 * tc, accG, lane);
        }
        LBAR();
        if (w < 4) {
            const float n2t = part[t] + part[64 + t], bont = part[128 + t] + part[192 + t];
            const float inv = 1.f / fmaxf(sqrtf(n2t), 1e-12f);
            if (tr == 0 && hi == 0) ((float*)(F.ws + WS_BONUS))[(m0 + t) * NH + h] = bont;
#pragma unroll
            for (int g = 0; g < 4; ++g) { const int jb = 32 * tr + 8 * g + 4 * hi; float kk4[4], bb4[4];
#pragma unroll
                for (int i = 0; i < 4; ++i) { kk4[i] = kq_[4 * g + i] * inv; bb4[i] = kk4[i] * a_[4 * g + i]; }
                v2u kw_, bw_; kw_.x = cvtpk(kk4[0], kk4[1]); kw_.y = cvtpk(kk4[2], kk4[3]); bw_.x = cvtpk(bb4[0], bb4[1]); bw_.y = cvtpk(bb4[2], bb4[3]);
                *(LAS v2u*)(L + RAW_KK * CMB + t * CP + jb * 2) = kw_; *(LAS v2u*)(L + RAW_BB * CMB + t * CP + jb * 2) = bw_; }
        }
        LBAR();
    }
    {
        const int j = F.tid & 63, tg = F.tid >> 6;
        float r_[8], e_[8], kp_[8], v_[8], kk_[8], bb_[8];
#pragma unroll
        for (int i = 0; i < 8; ++i) { const int o = (8 * tg + i) * CP + j * 2;
            r_[i] = bf2f(*(const LAS bf16*)(L + RAW_R * CMB + o)); e_[i] = bf2f(*(const LAS bf16*)(L + RAW_E * CMB + o)); kp_[i] = bf2f(*(const LAS bf16*)(L + RAW_KP * CMB + o));
            v_[i] = bf2f(*(const LAS bf16*)(L + RAW_V * CMB + o)); kk_[i] = bf2f(*(const LAS bf16*)(L + RAW_KK * CMB + o)); bb_[i] = bf2f(*(const LAS bf16*)(L + RAW_BB * CMB + o)); }
        float cs[8]; cs[0] = e_[0];
#pragma unroll
        for (int i = 1; i < 8; ++i) cs[i] = cs[i - 1] + e_[i];
        totals[tg * 64 + j] = cs[7];
        LBAR();
        float pre = 0.f, tot = 0.f;
#pragma unroll
        for (int g = 0; g < 8; ++g) { const float t_ = totals[g * 64 + j]; tot += t_; if (g < tg) pre += t_; }
        if (tg == 0) gend[j] = __expf(-tot);
#pragma unroll
        for (int i = 0; i < 8; ++i) { const int t = 8 * tg + i; const float ct = pre + cs[i];
            const float Gt = __expf(-ct), Gp = __expf(-(ct - e_[i])), iG = __expf(ct), gE = __expf(ct - tot);
            const int o = t * CP + j * 2;
            *(LAS bf16*)(L + C_AT * CMB + o) = (bf16)f2bf(-kk_[i] * Gp);
            *(LAS bf16*)(L + C_BT * CMB + o) = (bf16)f2bf(bb_[i] * iG);
            *(LAS bf16*)(L + C_KT * CMB + o) = (bf16)f2bf(kp_[i] * iG);
            *(LAS bf16*)(L + C_RT * CMB + o) = (bf16)f2bf(r_[i] * Gt);
            *(LAS bf16*)(L + C_BP * CMB + o) = (bf16)f2bf(bb_[i] * gE);
            *(LAS bf16*)(L + C_KP * CMB + o) = (bf16)f2bf(kp_[i] * gE);
            *(LAS bf16*)(L + C_VV * CMB + o) = (bf16)f2bf(v_[i]);
            *(LAS bf16*)(L + C_X0 * CMB + o) = (t == j) ? (bf16)0x3f80 : (bf16)0;
            VG[VG_VS / 2 + t * 64 + j] = (bf16)f2bf(v_[i]); }
        LBAR();
    }
_Pragma("unroll 1") for (int rep_ = 0; rep_ < DUP_S1; ++rep_)
    {
        const int p = w >> 1, tr = w & 1;
        const LAS unsigned char* A = L + ((p & 1) ? C_KT : C_BT) * CMB; const LAS unsigned char* B = L + ((p >> 1) ? C_RT : C_AT) * CMB;
        LAS unsigned char* Z = L + (p == 0 ? C_Q0 : p == 1 ? C_AK : p == 2 ? C_BR : C_KR) * CMB;
#pragma unroll
        for (int tc = 0; tc < 2; ++tc) { f32x16 acc = {};
            if (tr <= tc) { acc = tile_mm<false, false>(A, 32 * tr, B, 32 * tc, acc, lane);
#pragma unroll
                for (int r = 0; r < 16; ++r) { const int s_ = 32 * tr + crow(r, hi), t_ = 32 * tc + r32; const bool keep = (p < 2) ? (s_ < t_) : (s_ <= t_); acc[r] = keep ? acc[r] : 0.f; } }
            tile_store_lds(Z, 32 * tr, 32 * tc, acc, lane); }
        LBAR();
    }
    {
        const int tr = (w >> 1) & 1, tc = w & 1; f32x16 xacc = {};
        if (w < 4 && tr == tc) {
#pragma unroll
            for (int r = 0; r < 16; ++r) xacc[r] = (crow(r, hi) == r32) ? 1.f : 0.f; }
#pragma unroll 1
        for (int k = 0; k < 6; ++k) {
            const LAS unsigned char* Xc = L + ((k & 1) ? C_X1 : C_X0) * CMB; const LAS unsigned char* Qc = L + ((k & 1) ? C_Q1 : C_Q0) * CMB;
            LAS unsigned char* Xn = L + ((k & 1) ? C_X0 : C_X1) * CMB; LAS unsigned char* Qn = L + ((k & 1) ? C_Q0 : C_Q1) * CMB;
            if (w < 4) { if (tr <= tc) xacc = tile_mm<false, true>(Xc, 32 * tr, Qc, 32 * tc, xacc, lane);
                tile_store_lds(Xn, 32 * tr, 32 * tc, xacc, lane); }
            else if (k < 5) { f32x16 q = {}; if (tr <= tc) q = tile_mm<false, true>(Qc, 32 * tr, Qc, 32 * tc, q, lane);
                tile_store_lds(Qn, 32 * tr, 32 * tc, q, lane); }
            LBAR();
        }
    }
_Pragma("unroll 1") for (int rep_ = 0; rep_ < DUP_S3; ++rep_)
    {
        const int tr = (w >> 1) & 1, tc = w & 1; f32x16 acc = {};
        if (w < 4) { acc = tile_mm<true, true>(L + C_AT * CMB, 32 * tr, L + C_X0 * CMB, 32 * tc, acc, lane); tile_store_lds(L + C_BT * CMB, 32 * tr, 32 * tc, acc, lane); }
        else { if (tr <= tc) acc = tile_mm<false, true>(L + C_AK * CMB, 32 * tr, L + C_X0 * CMB, 32 * tc, acc, lane); tile_store_lds(L + C_KT * CMB, 32 * tr, 32 * tc, acc, lane); }
        LBAR();
    }
_Pragma("unroll 1") for (int rep_ = 0; rep_ < DUP_S4; ++rep_)
    {
        const int p = w >> 1, tr = w & 1;
        const LAS unsigned char* A = L + ((p & 1) ? C_KT : C_BT) * CMB; const LAS unsigned char* B = L + ((p >> 1) ? C_BR : C_BP) * CMB;
#pragma unroll
        for (int tc = 0; tc < 2; ++tc) { f32x16 acc = {};
            acc = tile_mm<false, true>(A, 32 * tr, B, 32 * tc, acc, lane);
            if (p == 0) {
#pragma unroll
                for (int r = 0; r < 16; ++r) if (32 * tr + crow(r, hi) == 32 * tc + r32) acc[r] += gend[32 * tc + r32];
                tile_store_glb_t(CH + CH_TT / 2, 32 * tr, 32 * tc, acc, lane);
            } else if (p == 1) {
#pragma unroll
                for (int r = 0; r < 16; ++r) acc[r] += bf2f(*(const LAS bf16*)(L + C_KP * CMB + (32 * tr + crow(r, hi)) * CP + (32 * tc + r32) * 2));
                tile_store_lds(L + C_Q0 * CMB, 32 * tr, 32 * tc, acc, lane);
            } else if (p == 2) {
#pragma unroll
                for (int g = 0; g < 4; ++g) { const v2u rw_ = *(const LAS v2u*)(L + C_RT * CMB + (32 * tc + r32) * CP + (32 * tr + 8 * g + 4 * hi) * 2);
                    acc[4 * g] += bflo(rw_.x); acc[4 * g + 1] += bfhi(rw_.x); acc[4 * g + 2] += bflo(rw_.y); acc[4 * g + 3] += bfhi(rw_.y); }
                tile_store_glb_t(CH + CH_PT / 2, 32 * tr, 32 * tc, acc, lane);
            } else {
#pragma unroll
                for (int r = 0; r < 16; ++r) acc[r] += bf2f(*(const LAS bf16*)(L + C_KR * CMB + (32 * tr + crow(r, hi)) * CP + (32 * tc + r32) * 2));
                tile_store_lds(L + C_Q1 * CMB, 32 * tr, 32 * tc, acc, lane);
            } }
        LBAR();
    }
_Pragma("unroll 1") for (int rep_ = 0; rep_ < DUP_S5; ++rep_)
    {
        const int tr = (w >> 1) & 1, tc = w & 1; f32x16 acc = {};
        acc = tile_mm<true, true>(L + C_VV * CMB, 32 * tr, L + ((w < 4) ? C_Q0 : C_Q1) * CMB, 32 * tc, acc, lane);
        tile_store_glb_t(CH + ((w < 4) ? CH_HT : CH_YV) / 2, 32 * tr, 32 * tc, acc, lane);
        LBAR();
    }
}
constexpr int CS_DATA = 2 * CMB, CS_DSZ = 6 * CMB, CS_GPART = CS_DATA + 2 * CS_DSZ;
static_assert(CS_GPART + 2048 <= RING_BYTES, "chunk scan LDS");
__device__ __forceinline__ void chunk_scan(Frame& F, int bh) {
    const int b = bh >> 4, h = bh & 15;
    LAS unsigned char* L = F.lds;
    bf16* mix = (bf16*)(F.ws + WS_MIX);
    const int lane = F.lane, w = F.wave, r32 = lane & 31, hi = lane >> 5;
    const int tr = (w >> 1) & 1, tc = w & 1; const bool isS = w < 4;
    for (int i = F.tid; i < 2 * CMB / 4; i += NT) ((LAS unsigned*)L)[i] = 0u;
    LAS float* gpart = (LAS float*)(L + CS_GPART);
    const unsigned char* CHb = F.ws + WS_WGU + (size_t)(bh * 64) * CH_UNIT + (size_t)(F.tid >> 3) * 128 + (F.tid & 7) * 16;
    const unsigned char* VGb = F.ws + WS_SCAN + (size_t)(bh * 64) * VG_UNIT + (size_t)(F.tid >> 3) * 128 + (F.tid & 7) * 16;
    const int ldst = (F.tid >> 3) * CP + (F.tid & 7) * 16;
    const float* bonus = (const float*)(F.ws + WS_BONUS) + ((size_t)b * SEQ + 32 * tc + r32) * NH + h;
    f32x4 gng[4], gnb[4];
#pragma unroll
    for (int g = 0; g < 4; ++g) { gng[g] = *(const GAS f32x4*)(F.in[18] + h * HD + 32 * tr + 8 * g + 4 * hi); gnb[g] = *(const GAS f32x4*)(F.in[19] + h * HD + 32 * tr + 8 * g + 4 * hi); }
    v4u pre[6];
#define CS_LOAD(cc) do { _Pragma("unroll") for (int k = 0; k < 4; ++k) pre[k] = *(const GAS v4u*)(CHb + (size_t)(cc) * CH_UNIT + k * 8192); \
        pre[4] = *(const GAS v4u*)(VGb + (size_t)(cc) * VG_UNIT); pre[5] = *(const GAS v4u*)(VGb + (size_t)(cc) * VG_UNIT + 8192); } while (0)
#define CS_WRITE(buf) do { _Pragma("unroll") for (int k = 0; k < 6; ++k) *(LAS v4u*)(L + CS_DATA + (buf) * CS_DSZ + k * CMB + ldst) = pre[k]; } while (0)
    CS_LOAD(0); CS_WRITE(0); CS_LOAD(1);
    __syncthreads();
#pragma unroll 1
    for (int c = 0; c < 64; ++c) {
        const LAS unsigned char* Sc = L + (c & 1) * CMB; LAS unsigned char* Sn = L + ((c & 1) ^ 1) * CMB;
        const LAS unsigned char* D = L + CS_DATA + (c & 1) * CS_DSZ;
        if (c + 1 < 64) CS_WRITE((c + 1) & 1);
        if (c + 2 < 64) CS_LOAD(c + 2);
        const float bon = isS ? 0.f : bonus[(size_t)c * 64 * NH];
        const LAS unsigned char* Bm = D + (isS ? 0 : 1) * CMB + (32 * tc + r32) * CP + 8 * hi * 2;
        const LAS unsigned char* Cm = D + (isS ? 2 : 3) * CMB + (32 * tc + r32) * CP + (32 * tr + 4 * hi) * 2;
        f32x16 acc;
#pragma unroll
        for (int g = 0; g < 4; ++g) { const v2u ci = *(const LAS v2u*)(Cm + 16 * g); acc[4 * g] = bflo(ci.x); acc[4 * g + 1] = bfhi(ci.x); acc[4 * g + 2] = bflo(ci.y); acc[4 * g + 3] = bfhi(ci.y); }
#pragma unroll
        for (int ks = 0; ks < 4; ++ks) acc = __builtin_amdgcn_mfma_f32_32x32x16_bf16(trfrag(Sc, 16 * ks, 32 * tr, lane), *(const LAS bf16x8*)(Bm + 32 * ks), acc, 0, 0, 0);
        LAS float* gp = gpart + (c & 1) * 256;
        v2u vv[4], gg[4];
        if (isS) {
#pragma unroll
            for (int g = 0; g < 4; ++g) { v2u o; o.x = pk2(acc[4 * g], acc[4 * g + 1]); o.y = pk2(acc[4 * g + 2], acc[4 * g + 3]);
                *(LAS v2u*)(Sn + (32 * tc + r32) * CP + (32 * tr + 8 * g + 4 * hi) * 2) = o; }
        } else {
            float s1 = 0.f, s2 = 0.f;
#pragma unroll
            for (int r = 0; r < 16; ++r) { s1 += acc[r]; s2 += acc[r] * acc[r]; }
            s1 = swapsum(s1); s2 = swapsum(s2);
            if (hi == 0) { gp[(tr * 2 + tc) * 32 + r32] = s1; gp[128 + (tr * 2 + tc) * 32 + r32] = s2; }
#pragma unroll
            for (int g = 0; g < 4; ++g) { vv[g] = *(const LAS v2u*)(D + 4 * CMB + (32 * tc + r32) * CP + (32 * tr + 8 * g + 4 * hi) * 2); gg[g] = *(const LAS v2u*)(D + 5 * CMB + (32 * tc + r32) * CP + (32 * tr + 8 * g + 4 * hi) * 2); }
        }
        asm volatile("s_waitcnt lgkmcnt(0)" ::: "memory"); __builtin_amdgcn_s_barrier(); asm volatile("" ::: "memory");
        if (!isS) {
            const float t1 = gp[tc * 32 + r32] + gp[(2 + tc) * 32 + r32], t2 = gp[128 + tc * 32 + r32] + gp[128 + (2 + tc) * 32 + r32];
            const float mu = t1 * (1.f / HD); const float rstd = __builtin_amdgcn_rsqf(fmaxf(t2 * (1.f / HD) - mu * mu, 0.f) + GN_EPS);
            bf16* mp = mix + ((size_t)b * SEQ + (size_t)c * 64 + 32 * tc + r32) * DM + AW + h * HD + 32 * tr + 4 * hi;
#pragma unroll
            for (int g = 0; g < 4; ++g) {
                const float v0 = bflo(vv[g].x), v1 = bfhi(vv[g].x), v2 = bflo(vv[g].y), v3 = bfhi(vv[g].y), g0 = bflo(gg[g].x), g1 = bfhi(gg[g].x), g2 = bflo(gg[g].y), g3 = bfhi(gg[g].y);
                const float o0 = ((acc[4 * g] - mu) * rstd * gng[g][0] + gnb[g][0] + bon * v0) * g0, o1 = ((acc[4 * g + 1] - mu) * rstd * gng[g][1] + gnb[g][1] + bon * v1) * g1;
                const float o2 = ((acc[4 * g + 2] - mu) * rstd * gng[g][2] + gnb[g][2] + bon * v2) * g2, o3 = ((acc[4 * g + 3] - mu) * rstd * gng[g][3] + gnb[g][3] + bon * v3) * g3;
                v2u o; o.x = cvtpk(o0, o1); o.y = cvtpk(o2, o3); *(GAS v2u*)(mp + 8 * g) = o; }
        }
    }
    __syncthreads();
#undef CS_LOAD
#undef CS_WRITE
}
__device__ __forceinline__ void rw_finalize(Frame& F) {
    const int gw = F.bid * NWAVES + F.wave, NGW = F.G * NWAVES;
    const float* Y = (const float*)(F.ws + WS_XB); const bf16* VGb = (const bf16*)(F.ws + WS_SCAN);
    const float* bonus = (const float*)(F.ws + WS_BONUS); bf16* mix = (bf16*)(F.ws + WS_MIX);
    const float *gn_g = F.in[18], *gn_b = F.in[19];
    for (int m = gw; m < M; m += NGW) { const int b = m / SEQ, ts = m % SEQ;
        for (int h = 0; h < NH; ++h) { const int c = h * HD + F.lane; const size_t o = (size_t)m * RW + c;
            const bf16* vg = VGb + ((size_t)((b * NH + h) * 64 + (ts >> 6)) * VG_UNIT) / 2 + (ts & 63) * 64 + F.lane;
            const float y = Y[o]; const float mu = wave_sum(y) * (1.f / HD); const float d = y - mu; const float var = wave_sum(d * d) * (1.f / HD);
            const float yn = d * (1.f / sqrtf(var + GN_EPS)) * gn_g[c] + gn_b[c];
            const float val = (yn + bonus[(size_t)m * NH + h] * bf2f(vg[VG_VS / 2])) * bf2f(vg[VG_GG / 2]);
            mix[(size_t)m * DM + AW + c] = (bf16)f2bf(val); }
    }
}

constexpr int AT_K = 0, AT_V = 16384, AT_WS = 32768, AT_GATE = 34816, AT_TAB = 51200, AT_OST = 52224, AT_BYTES = AT_OST + 8 * 4096;
__device__ __forceinline__ int rel_bucket_i(int d) {
    if (d < 16) return d;
    return 16 + (d >= 19) + (d >= 21) + (d >= 24) + (d >= 27) + (d >= 31) + (d >= 35) + (d >= 40) + (d >= 46) + (d >= 52) + (d >= 59) + (d >= 67) + (d >= 77) + (d >= 87) + (d >= 99) + (d >= 113);
}

__device__ __forceinline__ void attn_unit(Frame& F, int b, int h, int qb) {
    const bf16* ub = (const bf16*)(F.ws + WS_BIG); const bf16* km = (const bf16*)(F.ws + WS_SMALL + SM_KMEAN); bf16* mix = (bf16*)(F.ws + WS_MIX);
    const float* rel_bias = F.in[8];
    LAS unsigned char* L = F.lds;
    const int lane = F.lane, wid = F.wave, r32 = lane & 31, hi = lane >> 5;
    const size_t mb = (size_t)b * SEQ;
    const int q0 = qb * 256;
    LAS float* tab = (LAS float*)(L + AT_TAB);
    LAS float* wsf = (LAS float*)(L + AT_WS) + wid * 64;
    constexpr float C2 = 0.125f * LOG2E;
    if (F.tid < 129) tab[F.tid] = rel_bias[rel_bucket_i(F.tid) * NH + h] * LOG2E;
    bf16x8 qr[4];
    { const bf16* Qw = ub + (mb + q0 + wid * 32 + r32) * INP + UQ + h * HD;
#pragma unroll
      for (int d0 = 0; d0 < 4; ++d0) qr[d0] = *(const GAS bf16x8*)(Qw + d0 * 16 + hi * 8); }
    unsigned sel = 0u;
    if (qb > 0) {
        f32x16 g = {};
        const bf16* kmp = km + ((size_t)(b * NH + h) * 16 + (r32 & 15)) * HD;
#pragma unroll
        for (int d0 = 0; d0 < 4; ++d0) { const bf16x8 kf = *(const GAS bf16x8*)(kmp + d0 * 16 + hi * 8); g = __builtin_amdgcn_mfma_f32_32x32x16_bf16(kf, qr[d0], g, 0, 0, 0); }
        LAS float* gs = (LAS float*)(L + AT_GATE) + wid * 512;
#pragma unroll
        for (int r = 0; r < 8; ++r) gs[r32 * 16 + crow(r, hi)] = g[r];
        LDS_WAIT(); asm volatile("" ::: "memory");
        float gv[16];
#pragma unroll
        for (int i = 0; i < 4; ++i) { const f32x4 t = *(const LAS f32x4*)(gs + r32 * 16 + 4 * i); gv[4 * i] = t[0]; gv[4 * i + 1] = t[1]; gv[4 * i + 2] = t[2]; gv[4 * i + 3] = t[3]; }
#pragma unroll
        for (int pass = 0; pass < 3; ++pass) { float best = -INFINITY; int bi = -1;
#pragma unroll
            for (int n = 0; n < 16; ++n) { const bool ok = (n < qb) && !((sel >> n) & 1u) && (gv[n] > best); if (ok) { best = gv[n]; bi = n; } }
            if (bi >= 0) sel |= 1u << bi; }
    }
    const bf16* ksrc = ub + (mb + lane) * INP + UK + h * HD + wid * 8;
    const bf16* vsrc = ub + (mb + 16 * (wid & 3) + (lane >> 2)) * INP + UV + h * HD + (wid >> 2) * 32 + (lane & 3) * 8;
    const int stoff = wid * 1024 + lane * 16;
    const int NTILE = 4 * (qb + 1);
    v4u kreg, vreg;
    kreg = *(const GAS v4u*)(ksrc); vreg = *(const GAS v4u*)(vsrc);
    __syncthreads();
    *(LAS v4u*)(L + AT_K + stoff) = kreg; *(LAS v4u*)(L + AT_V + stoff) = vreg;
    __syncthreads();
    float mrun = -INFINITY, lrun = 0.f; f32x16 o[2]; o[0] = f32x16{}; o[1] = f32x16{};
    const float c31 = tab[128];
    for (int jt = 0; jt < NTILE; ++jt) {
        const int cur = jt & 1;
        if (jt + 1 < NTILE) { kreg = *(const GAS v4u*)(ksrc + (size_t)(jt + 1) * 64 * INP); vreg = *(const GAS v4u*)(vsrc + (size_t)(jt + 1) * 64 * INP); }
        const int n = jt >> 2;
        const int dbase = 256 * (qb - n) + 32 * wid - 64 * (jt & 3);
        const bool lane_ok = (n == qb) || ((sel >> n) & 1u);
        const bool wave_live = (dbase + 31 >= 0) && __any(lane_ok);
        if (wave_live) {
            f32x16 p0 = {}, p1 = {};
            const LAS unsigned char* kb = L + AT_K + cur * 8192 + hi * 1024 + r32 * 16;
#pragma unroll
            for (int d0 = 0; d0 < 4; ++d0) { const bf16x8 b0 = *(const LAS bf16x8*)(kb + d0 * 2048); const bf16x8 b1 = *(const LAS bf16x8*)(kb + d0 * 2048 + 512);
                p0 = __builtin_amdgcn_mfma_f32_32x32x16_bf16(b0, qr[d0], p0, 0, 0, 0); p1 = __builtin_amdgcn_mfma_f32_32x32x16_bf16(b1, qr[d0], p1, 0, 0, 0); }
            const bool far = (dbase - 63 >= 128);
            const int dl = dbase + r32;
            if (far) {
#pragma unroll
                for (int r = 0; r < 16; ++r) { p0[r] = lane_ok ? p0[r] * C2 + c31 : -INFINITY; p1[r] = lane_ok ? p1[r] * C2 + c31 : -INFINITY; }
            } else {
#pragma unroll
                for (int r = 0; r < 16; ++r) { const int d0_ = dl - crow(r, hi), d1_ = d0_ - 32;
                    const float b0 = tab[min(max(d0_, 0), 128)], b1 = tab[min(max(d1_, 0), 128)];
                    p0[r] = (lane_ok && d0_ >= 0) ? p0[r] * C2 + b0 : -INFINITY; p1[r] = (lane_ok && d1_ >= 0) ? p1[r] * C2 + b1 : -INFINITY; }
            }
            float rm = fmaxf(p0[0], p1[0]);
#pragma unroll
            for (int r = 1; r < 16; ++r) rm = fmaxf(rm, fmaxf(p0[r], p1[r]));
            rm = swapmax(rm);
            const float mnew = fmaxf(mrun, rm);
            const float msafe = (mnew == -INFINITY) ? 0.f : mnew;
            const float alpha = __builtin_amdgcn_exp2f(mrun - msafe);
            mrun = mnew;
            float ps = 0.f;
#pragma unroll
            for (int r = 0; r < 16; ++r) { p0[r] = __builtin_amdgcn_exp2f(p0[r] - msafe); p1[r] = __builtin_amdgcn_exp2f(p1[r] - msafe); ps += p0[r] + p1[r]; }
            lrun = lrun * alpha + ps;
            if (__any(alpha != 1.f)) {
                if (hi == 0) wsf[r32] = alpha;
                LDS_WAIT(); asm volatile("" ::: "memory");
#pragma unroll
                for (int r = 0; r < 16; ++r) { const float f = wsf[crow(r, hi)]; o[0][r] *= f; o[1][r] *= f; }
                asm volatile("" ::: "memory");
            }
            v4u pw[4];
            pw[0] = (v4u){cvtpk(p0[0], p0[1]), cvtpk(p0[2], p0[3]), cvtpk(p0[4], p0[5]), cvtpk(p0[6], p0[7])};
            pw[1] = (v4u){cvtpk(p0[8], p0[9]), cvtpk(p0[10], p0[11]), cvtpk(p0[12], p0[13]), cvtpk(p0[14], p0[15])};
            pw[2] = (v4u){cvtpk(p1[0], p1[1]), cvtpk(p1[2], p1[3]), cvtpk(p1[4], p1[5]), cvtpk(p1[6], p1[7])};
            pw[3] = (v4u){cvtpk(p1[8], p1[9]), cvtpk(p1[10], p1[11]), cvtpk(p1[12], p1[13]), cvtpk(p1[14], p1[15])};
            const LAS unsigned char* vb = L + AT_V + cur * 8192 + ((lane >> 4) & 1) * 32 + (lane & 3) * 8 + (4 * hi + ((lane & 15) >> 2)) * 64;
#pragma unroll
            for (int d0 = 0; d0 < 2; ++d0)
#pragma unroll
                for (int ks = 0; ks < 4; ++ks) { const s16x4 lo = vtr(vb + d0 * 4096 + ks * 1024), hh = vtr(vb + d0 * 4096 + ks * 1024 + 512);
                    const bf16x8 vf = (bf16x8){lo[0], lo[1], lo[2], lo[3], hh[0], hh[1], hh[2], hh[3]};
                    o[d0] = __builtin_amdgcn_mfma_f32_32x32x16_bf16(__builtin_bit_cast(bf16x8, pw[ks]), vf, o[d0], 0, 0, 0); }
        }
        if (jt + 1 < NTILE) { *(LAS v4u*)(L + AT_K + (cur ^ 1) * 8192 + stoff) = kreg; *(LAS v4u*)(L + AT_V + (cur ^ 1) * 8192 + stoff) = vreg; }
        __syncthreads();
    }
    lrun = swapsum(lrun);
    if (hi == 0) wsf[32 + r32] = lrun;
    LDS_WAIT(); asm volatile("" ::: "memory");
    LAS bf16* stg = (LAS bf16*)(L + AT_OST) + wid * 2048;
#pragma unroll
    for (int r = 0; r < 16; ++r) { const int orow = crow(r, hi); const float rl = 1.f / wsf[32 + orow];
        stg[orow * 64 + r32] = (bf16)f2bf(o[0][r] * rl); stg[orow * 64 + 32 + r32] = (bf16)f2bf(o[1][r] * rl); }
    LDS_WAIT(); asm volatile("" ::: "memory");
    bf16* Ow = mix + (mb + q0 + wid * 32) * DM + h * HD;
#pragma unroll
    for (int i = 0; i < 4; ++i) { const int row = i * 8 + (lane >> 3), ch = lane & 7; const v4u v = *(const LAS v4u*)(stg + row * 64 + ch * 8); *(GAS v4u*)(Ow + (size_t)row * DM + ch * 8) = v; }
}

__device__ __forceinline__ void attn_queue(Frame& F, unsigned* head) {
    volatile LAS unsigned* slot = (volatile LAS unsigned*)(F.lds + MISC_OFF + 64);
    for (;;) {
        __syncthreads();
        if (F.tid == 0) *slot = __hip_atomic_fetch_add(head, 1u, __ATOMIC_RELAXED, __HIP_MEMORY_SCOPE_AGENT);
        __syncthreads();
        const unsigned u = *slot;
        if (u >= 512u) break;
        const int bh = (int)(u & 31u), qb = 15 - (int)(u >> 5);
        attn_unit(F, bh >> 4, bh & 15, qb);
    }
}

#ifndef REP_PHASE
#define REP_PHASE -1
#endif
#ifndef REP_EXTRA
#define REP_EXTRA 1
#endif
#ifndef MK_PER_PHASE
#define MK_PER_PHASE 0
#endif
constexpr int NPHASE = 11;
__global__ void __launch_bounds__(NT, 2) hymba_fwd(Args args) {
    extern __shared__ __attribute__((aligned(16))) unsigned char lds[];
    Frame F;
    F.lds = (LAS unsigned char*)lds;
    F.tid = threadIdx.x; F.lane = F.tid & 63; F.wave = __builtin_amdgcn_readfirstlane(F.tid >> 6);
    F.G = gridDim.x; F.bid = blockIdx.x; F.in = args.in; F.hz = args.out; F.ws = args.ws;
    volatile LAS unsigned* MISC = (volatile LAS unsigned*)(F.lds + MISC_OFF);
    for (int u = F.tid; u < (LDS_BYTES - LDSCTL_OFF) / 4; u += NT) ((LAS unsigned*)(F.lds + LDSCTL_OFF))[u] = 0u;
    __syncthreads();
    gu32* ctl = (gu32*)(F.ws + WS_CTL);
    XcdBarrier bar; bar.bar = (unsigned*)(ctl + CW_BAR); bar.x = 0; bar.st = nullptr;
    if (!MK_PER_PHASE) bar = xcd_barrier_post((unsigned*)(ctl + CW_BAR), MISC + 8);
    const int lo = args.ph_lo, hi = args.ph_hi;
#define IN(k) (lo <= (k) && (k) < hi)
#define SEAM(k) do { if (IN(k) && IN((k) + 1)) xcd_barrier(bar); } while (0)
    bf16* const Wgu = (bf16*)(F.ws + WS_WGU); bf16* const Wd = (bf16*)(F.ws + WS_WD); bf16* const Win = (bf16*)(F.ws + WS_WIN); bf16* const Wout = (bf16*)(F.ws + WS_WOUT);
    bf16* const Wgu2 = (bf16*)(F.ws + WS_F2); bf16* const Wd2 = (bf16*)(F.ws + WS_F2 + 44 * MiB);
    bf16* const Wpg = (bf16*)(F.ws + WS_WPG); bf16* const Wpu = (bf16*)(F.ws + WS_WPU);
    bf16* const XB = (bf16*)(F.ws + WS_XB); bf16* const BIG = (bf16*)(F.ws + WS_BIG); bf16* const MIX = (bf16*)(F.ws + WS_MIX); bf16* const EB = (bf16*)(F.ws + WS_SCAN); bf16* const PB = (bf16*)(F.ws + WS_PB);

    float* const stats1 = (float*)(F.ws + WS_STATS); float* const stats2 = stats1 + 2 * M; float* const stats3 = stats2 + 2 * M;
    float* const gb1 = (float*)(F.ws + WS_GB); float* const gb2 = gb1 + 2 * DM;
    float* const c1_in = (float*)(F.ws + WS_CVEC); float* const c2_in = c1_in + INP; float* const c1_gu = c2_in + INP; float* const c2_gu = c1_gu + NGU; float* const c1_pg = c2_gu + NGU; float* const c2_pg = c1_pg + DM;
    if (IN(0)) {
        int base = 0;
        ffn_weights<false>(F, 2, 3, 4, Wgu, Wd, base);
        transpose_job<true>(F, F.in[7], DM, DM, INC, Win, DM, 0, base, F.in[5], F.in[6], c1_in, c2_in);
        transpose_job<false>(F, F.in[20], DM, DM, DM, Wout, DM, 0, base);
        transpose_job<true>(F, F.in[29], DM, DM, DM, Wpg, DM, 0, base, F.in[26], F.in[27], c1_pg, c2_pg);
        transpose_job<false>(F, F.in[28], PLE, PLE, DM, Wpu, PLE, 0, base);
        transpose_job<false>(F, F.in[11], 64, 64, RW, (bf16*)(F.ws + WS_SMALL + SM_W2T), 64, 0, base);
        transpose_job<false>(F, F.in[13], 64, 64, RW, (bf16*)(F.ws + WS_SMALL + SM_A2T), 64, 0, base);
        transpose_job<false>(F, F.in[14], 160, 192, RW, (bf16*)(F.ws + WS_SMALL + SM_G2T), 192, 0, base);
        convert_bf16(F, F.in[0], XB, (size_t)M * DM);
        convert_bf16(F, F.in[1], PB, (size_t)M * PLE);
        if (F.bid == 0) for (int i = F.tid; i < DM; i += NT) { gb1[i] = F.in[5][i]; gb1[DM + i] = F.in[6][i]; gb2[i] = F.in[21][i]; gb2[DM + i] = F.in[22][i]; }
    }
    SEAM(0);
    if (IN(1)) { pg8::Gemm g{XB, Wgu, M, NGU, DM}; pg8::StaticOrder S; S.init(M, NGU, F.G, F.bid); pg8::EpiSwiGLU E{BIG, DFF};
        pg8::gemm_phase<pg8::EpiSwiGLU, pg8::StaticOrder, true, true>(F.lds, g, S, E);
        { const int nwg = (M / 256) * (NGU / 256), rem = nwg % F.G; int base = 0;
          if (rem == 0) ffn_weights<true>(F, 23, 24, 25, Wgu2, Wd2, base, F.in[21], F.in[22], c1_gu, c2_gu);
          else if (F.bid >= rem) ffn_weights<true>(F, 23, 24, 25, Wgu2, Wd2, base, F.in[21], F.in[22], c1_gu, c2_gu, (F.bid - rem) * NWAVES + F.wave, (F.G - rem) * NWAVES); } }
    SEAM(1);
    if (IN(2)) { pg8::Gemm g{BIG, Wd, M, DM, DFF}; pg8::StaticOrder S; S.init(M, DM, F.G, F.bid);
        pg8::EpiResidLN<false> E{F.in[0], F.hz, XB, DM, ALPHA, 0.5f, pg8::RowStats{nullptr, 0.f, 0.f}, nullptr, nullptr, stats1};
        pg8::gemm_phase<pg8::EpiResidLN<false>, pg8::StaticOrder, true, true>(F.lds, g, S, E); }
    SEAM(2);
    if (IN(3)) { pg8::Gemm g{XB, Win, M, INP, DM}; pg8::StaticOrder S; S.init(M, INP, F.G, F.bid); pg8::EpiBf16LN E{BIG, INP, pg8::RowStats{stats1, 1.f / DM, LN_EPS}, c1_in, c2_in};
        pg8::gemm_phase<pg8::EpiBf16LN, pg8::StaticOrder, true, true>(F.lds, g, S, E); }
    SEAM(3);
#ifndef DUP4
#define DUP4 1
#endif
    if (IN(4)) { kmean_tasks(F); __syncthreads();
#pragma unroll 1
        for (int rep_ = 0; rep_ < DUP4; ++rep_) for (int u = F.bid; u < BATCH * NH * 64; u += F.G) chunk_prepass(F, u); }
    SEAM(4);
    if (IN(5)) {
        for (int t = F.bid; t < BATCH * NH; t += F.G) chunk_scan(F, t);
        attn_queue(F, (unsigned*)(ctl + CW_QUEUE));
    }
    SEAM(5);
    if (IN(6)) { { pg8::Gemm g{MIX, Wout, M, DM, DM}; pg8::StaticOrder S; S.init(M, DM, F.G, F.bid);
          pg8::EpiResidLNip E{F.hz, XB, stats1, gb1, DM, M, ALPHA, 1.0f, 1.f / DM, LN_EPS};
          pg8::gemm_phase<pg8::EpiResidLNip, pg8::StaticOrder, true, true>(F.lds, g, S, E); }
        { pg8::Gemm g{PB, Wpu, M, DM, PLE}; pg8::StaticOrder S; S.init(M, DM, F.G, F.bid); pg8::EpiBf16<0> E{EB, DM, nullptr, 0, 0, 1.f};
          pg8::gemm_phase<pg8::EpiBf16<0>, pg8::StaticOrder, true, true>(F.lds, g, S, E); } }
    SEAM(6);
    if (IN(7)) { pg8::Gemm g{XB, Wgu2, M, NGU, DM}; pg8::StaticOrder S; S.init(M, NGU, F.G, F.bid); pg8::EpiSwiGLULN E{BIG, DFF, pg8::RowStats{stats2, 1.f / DM, LN_EPS}, c1_gu, c2_gu};
        pg8::gemm_phase<pg8::EpiSwiGLULN, pg8::StaticOrder, true, true>(F.lds, g, S, E); }
    SEAM(7);
    if (IN(8)) { pg8::Gemm g{BIG, Wd2, M, DM, DFF}; pg8::StaticOrder S; S.init(M, DM, F.G, F.bid);
        pg8::EpiResidLNip E{F.hz, XB, stats2, gb2, DM, M, ALPHA, 0.5f, 1.f / DM, LN_EPS};
        pg8::gemm_phase<pg8::EpiResidLNip, pg8::StaticOrder, true, true>(F.lds, g, S, E); }
    SEAM(8);
    if (IN(9)) { pg8::Gemm g{XB, Wpg, M, DM, DM}; pg8::StaticOrder S; S.init(M, DM, F.G, F.bid);
        pg8::EpiPleLN E{F.hz, F.hz, EB, F.in[30], DM, ALPHA, pg8::RowStats{stats3, 1.f / DM, LN_EPS}, F.in[26], F.in[27], c1_pg, c2_pg};
        pg8::gemm_phase<pg8::EpiPleLN, pg8::StaticOrder, true, true>(F.lds, g, S, E); }
    SEAM(9);
    if (IN(10)) {
        if (!MK_PER_PHASE && xb_ld((unsigned*)(ctl + CW_BAR) + XB_TMO) != 0u) {
            const float q = __builtin_nanf(""); for (size_t i = (size_t)F.bid * NT + F.tid; i < (size_t)M * DM; i += (size_t)F.G * NT) F.hz[i] = q;
        } else ln_phase<false>(F, F.hz, F.in[31], F.in[32], nullptr);
    }
#undef IN
#undef SEAM
}

extern "C" void kernel_launch(void* const* d_in, const int* in_sizes, int n_in, void* d_out, int out_size, void* d_ws, size_t ws_size, hipStream_t stream) {
    static int grid = 0;
    if (grid == 0) {
        if (n_in != 33 || out_size != M * DM || ws_size < WS_END) { fprintf(stderr, "kernel_launch: unexpected problem (n_in %d out %d ws %zu, need %zu); nothing launched\n", n_in, out_size, ws_size, (size_t)WS_END); grid = -1; return; }
        int dev = 0, cus = 0;
        if (hipGetDevice(&dev) != hipSuccess || hipDeviceGetAttribute(&cus, hipDeviceAttributeMultiprocessorCount, dev) != hipSuccess) { grid = -1; return; }
        if (hipFuncSetAttribute((const void*)hymba_fwd, hipFuncAttributeMaxDynamicSharedMemorySize, LDS_BYTES) != hipSuccess) { fprintf(stderr, "kernel_launch: hipFuncSetAttribute failed\n"); grid = -1; return; }
        grid = cus > 0 ? cus : 256;
        fprintf(stderr, "kernel_launch: grid %d, ws %zu\n", grid, ws_size);
    }
    if (grid < 0) return;
    (void)hipMemsetAsync((char*)d_ws + WS_CTL, 0, CTL_ZERO_BYTES, stream);
    Args a{};
    for (int i = 0; i < 33; ++i) a.in[i] = (const float*)d_in[i];
    a.out = (float*)d_out; a.ws = (unsigned char*)d_ws;
#if MK_PER_PHASE
    for (int p = 0; p < NPHASE; ++p) { a.ph_lo = p; a.ph_hi = p + 1; const int reps = (p == REP_PHASE) ? 1 + REP_EXTRA : 1;
        for (int r = 0; r < reps; ++r) hipLaunchKernelGGL(hymba_fwd, dim3(grid), dim3(NT), LDS_BYTES, stream, a);
        if (p == 5 && REP_PHASE >= 20) { a.ph_lo = REP_PHASE; a.ph_hi = REP_PHASE + 1; hipLaunchKernelGGL(hymba_fwd, dim3(grid), dim3(NT), LDS_BYTES, stream, a); } }
#else
    a.ph_lo = 0; a.ph_hi = NPHASE;
    hipLaunchKernelGGL(hymba_fwd, dim3(grid), dim3(NT), LDS_BYTES, stream, a);
#endif
}
```

```cpp
#include <hip/hip_runtime.h>
#include <cstdio>
#include <cstdint>
namespace pg8 {
#define PG8_LAS __attribute__((address_space(3)))
typedef unsigned short bf16_t;
typedef short bf16x8 __attribute__((ext_vector_type(8)));
typedef float f32x4 __attribute__((ext_vector_type(4)));
typedef unsigned u32x4 __attribute__((ext_vector_type(4)));
constexpr int BM = 256, BK = 64, HALF = 128, HTB = HALF * BK * 2  , STAGE_BYTES = 8 * HTB, NXCD = 8, WGM = 8;

__host__ __device__ __forceinline__ int lds_byte(int r, int c) { const int st = (r >> 4) * 2 + (c >> 5), rr = r & 15, cc = c & 31, ob = rr * 64 + cc * 2; return st * 1024 + (ob ^ (((ob >> 9) & 1) << 5)); }
__host__ __device__ __forceinline__ void stage_rc(int b, int& R, int& C) { const int st = b / 1024, sb = b % 1024, swz = sb ^ (((sb >> 9) & 1) << 5); R = (st >> 1) * 16 + swz / 64; C = (st & 1) * 32 + (swz % 64) / 2; }
__host__ __device__ __forceinline__ int perm32(int rho) { const int n = rho >> 4, i = rho & 15; return 8 * (i >> 2) + 4 * n + (i & 3); }

struct Unit { int pm, pn; };
struct Gemm { const bf16_t* A; const bf16_t* Bt; int M, N, K; };

struct StaticOrder {
    int nM, nN, nwg, G, c;
    __host__ __device__ void init(int M, int N, int G_, int c_) { nM = M / BM; nN = N / BM; nwg = nM * nN; G = G_; c = c_; }
    __host__ __device__ bool next(int i, Unit& u) const {
        const long L = (long)i * G + c; if (L >= nwg) return false;
        int wgid = (int)L; { const int q = nwg / NXCD, r = nwg % NXCD, xcd = wgid % NXCD, off = wgid / NXCD; wgid = (xcd < r ? xcd * (q + 1) : r * (q + 1) + (xcd - r) * q) + off; }
        const int nig = WGM * nN, gid = wgid / nig, fm = gid * WGM, gsz = (nM - fm) < WGM ? (nM - fm) : WGM;
        u.pm = fm + ((wgid % nig) % gsz); u.pn = (wgid % nig) / gsz; return true;
    }
    __device__ __forceinline__ void a_ready(const Unit&) const {}
    __device__ __forceinline__ void done(const Unit&) const {}
};

__device__ __forceinline__ unsigned cvt_pk_bf16(float lo, float hi) { unsigned r; asm volatile("v_cvt_pk_bf16_f32 %0, %1, %2" : "=v"(r) : "v"(lo), "v"(hi)); return r; }
typedef float f32x2 __attribute__((ext_vector_type(2)));
__device__ __forceinline__ f32x2 gelu_pk(f32x2 v) {
    const f32x2 av = __builtin_elementwise_abs(v), d = av * 0.2316418882f + 1.0f;
    f32x2 t; t.x = __builtin_amdgcn_rcpf(d.x); t.y = __builtin_amdgcn_rcpf(d.y);
    f32x2 q = t * 0.5307027145f + (-0.7265760135f); q = q * t + 0.7107068705f; q = q * t + (-0.142248368f); q = q * t + 0.127414796f; q = q * t;
    const f32x2 s = (v * v) * (-0.72134752044f);
    f32x2 e; e.x = __builtin_amdgcn_exp2f(s.x); e.y = __builtin_amdgcn_exp2f(s.y);
    const f32x2 m = v * (q * e), r = v - m;
    f32x2 o; o.x = v.x < 0.f ? m.x : r.x; o.y = v.y < 0.f ? m.y : r.y; return o;
}

template <int ACT  > struct EpiBf16 {
    static constexpr bool PERM = true, AFTER_DRAIN = false; static_assert(ACT == 0 || ACT == 1, "EpiBf16: ACT is 0 (none) or 1 (gelu_pk)");
    bf16_t* O; int ldc; const float* bias; int split_cols; size_t split_stride; float scale0;
    __device__ __forceinline__ void operator()(const f32x4 (&acc)[2][2][4][2], const Unit& u, int wr, int wc, int fr, int fq) const {
        const int row0 = u.pm * BM + wr * 64 + fr; int colt = u.pn * BM; bf16_t* base = O;
        float sc = 1.f; if (split_cols) { const int t = colt / split_cols; base += (size_t)t * split_stride; colt -= t * split_cols; if (t == 0) sc = scale0; }
        const int col0 = colt + wc * 32 + 8 * fq, bcol0 = u.pn * BM + wc * 32 + 8 * fq;
        f32x4 bv[2][2];
#pragma unroll
        for (int bj = 0; bj < 2; ++bj)
#pragma unroll
            for (int n = 0; n < 2; ++n) bv[bj][n] = bias ? *(const f32x4*)(bias + bcol0 + bj * HALF + 4 * n) : (f32x4){0.f, 0.f, 0.f, 0.f};
#pragma unroll
        for (int ai = 0; ai < 2; ++ai)
#pragma unroll
            for (int m = 0; m < 4; ++m) { bf16_t* rowp = base + (size_t)(row0 + ai * HALF + m * 16) * ldc + col0;
#pragma unroll
                for (int bj = 0; bj < 2; ++bj) { f32x4 v0 = acc[ai][bj][m][0] + bv[bj][0], v1 = acc[ai][bj][m][1] + bv[bj][1];
                    if (ACT == 1) { f32x2 a = gelu_pk((f32x2){v0[0], v0[1]}), b = gelu_pk((f32x2){v0[2], v0[3]}), c = gelu_pk((f32x2){v1[0], v1[1]}), d = gelu_pk((f32x2){v1[2], v1[3]});
                        v0 = (f32x4){a.x, a.y, b.x, b.y}; v1 = (f32x4){c.x, c.y, d.x, d.y}; }
                    v0 = v0 * sc; v1 = v1 * sc; u32x4 w; w.x = cvt_pk_bf16(v0[0], v0[1]); w.y = cvt_pk_bf16(v0[2], v0[3]); w.z = cvt_pk_bf16(v1[0], v1[1]); w.w = cvt_pk_bf16(v1[2], v1[3]);
                    *(u32x4*)(rowp + bj * HALF) = w; } }
    }
};
__device__ __forceinline__ float sigmoid_f(float x) { return __builtin_amdgcn_rcpf(1.0f + __builtin_amdgcn_exp2f(-1.4426950408889634f * x)); }
struct EpiSwiGLU {
    static constexpr bool PERM = true, AFTER_DRAIN = false;
    bf16_t* O; int ldc;
    __device__ __forceinline__ void operator()(const f32x4 (&acc)[2][2][4][2], const Unit& u, int wr, int wc, int fr, int fq) const {
        const int row0 = u.pm * BM + wr * 64 + fr; const int col0 = u.pn * HALF + wc * 32 + 8 * fq;
#pragma unroll
        for (int ai = 0; ai < 2; ++ai)
#pragma unroll
            for (int m = 0; m < 4; ++m) { bf16_t* rowp = O + (size_t)(row0 + ai * HALF + m * 16) * ldc + col0;
                const f32x4 g0 = acc[ai][0][m][0], g1 = acc[ai][0][m][1], u0 = acc[ai][1][m][0], u1 = acc[ai][1][m][1];
                f32x4 h0, h1;
#pragma unroll
                for (int i = 0; i < 4; ++i) { h0[i] = g0[i] * sigmoid_f(g0[i]) * u0[i]; h1[i] = g1[i] * sigmoid_f(g1[i]) * u1[i]; }
                u32x4 w; w.x = cvt_pk_bf16(h0[0], h0[1]); w.y = cvt_pk_bf16(h0[2], h0[3]); w.z = cvt_pk_bf16(h1[0], h1[1]); w.w = cvt_pk_bf16(h1[2], h1[3]);
                *(u32x4*)rowp = w; }
    }
};
struct EpiResid {
    static constexpr bool PERM = false, AFTER_DRAIN = false;
    const float* base; float* out; int ldc; float alpha, s;
    __device__ __forceinline__ void operator()(const f32x4 (&acc)[2][2][4][2], const Unit& u, int wr, int wc, int fr, int fq) const {
        const int col0 = u.pn * BM + wc * 32 + 4 * fq;
#pragma unroll
        for (int ai = 0; ai < 2; ++ai)
#pragma unroll
            for (int m = 0; m < 4; ++m) { const size_t off = (size_t)(u.pm * BM + ai * HALF + wr * 64 + m * 16 + fr) * ldc + col0;
#pragma unroll
                for (int bj = 0; bj < 2; ++bj)
#pragma unroll
                    for (int n = 0; n < 2; ++n) { const f32x4 bs = *(const f32x4*)(base + off + bj * HALF + n * 16);
                        *(f32x4*)(out + off + bj * HALF + n * 16) = bs * alpha + acc[ai][bj][m][n] * s; }
                if (m & 1) asm volatile("" ::: "memory"); }
    }
};
struct EpiPle {
    static constexpr bool PERM = false, AFTER_DRAIN = false;
    const float* base; float* out; const bf16_t* e; const float* bias; int ldc; float alpha;
    __device__ __forceinline__ void operator()(const f32x4 (&acc)[2][2][4][2], const Unit& u, int wr, int wc, int fr, int fq) const {
        typedef unsigned u32x2v __attribute__((ext_vector_type(2)));
        const int col0 = u.pn * BM + wc * 32 + 4 * fq;
        f32x4 bv[2][2];
#pragma unroll
        for (int bj = 0; bj < 2; ++bj)
#pragma unroll
            for (int n = 0; n < 2; ++n) bv[bj][n] = *(const f32x4*)(bias + col0 + bj * HALF + n * 16);
#pragma unroll
        for (int ai = 0; ai < 2; ++ai)
#pragma unroll
            for (int m = 0; m < 4; ++m) { const size_t off = (size_t)(u.pm * BM + ai * HALF + wr * 64 + m * 16 + fr) * ldc + col0;
#pragma unroll
                for (int bj = 0; bj < 2; ++bj)
#pragma unroll
                    for (int n = 0; n < 2; ++n) { const f32x4 bs = *(const f32x4*)(base + off + bj * HALF + n * 16);
                        const u32x2v ew = *(const u32x2v*)(e + off + bj * HALF + n * 16);
                        f32x4 ev; ev[0] = __uint_as_float(ew.x << 16); ev[1] = __uint_as_float(ew.x & 0xffff0000u); ev[2] = __uint_as_float(ew.y << 16); ev[3] = __uint_as_float(ew.y & 0xffff0000u);
                        const f32x4 a = acc[ai][bj][m][n] + bv[bj][n]; f32x4 o;
#pragma unroll
                        for (int i = 0; i < 4; ++i) o[i] = bs[i] * alpha + sigmoid_f(a[i]) * ev[i];
                        *(f32x4*)(out + off + bj * HALF + n * 16) = o; }
                if (m & 1) asm volatile("" ::: "memory"); }
    }
};

struct RowStats { const float* st; float inv_n, eps;
    __device__ __forceinline__ void get(int row, float& mu, float& rstd) const { const float s = st[2 * row], q = st[2 * row + 1]; mu = s * inv_n; const float var = q * inv_n - mu * mu; rstd = __builtin_amdgcn_rsqf(fmaxf(var, 0.f) + eps); } };
template <bool LNB>
struct EpiResidLN {
    static constexpr bool PERM = false, AFTER_DRAIN = false;
    const float* base; float* out; bf16_t* zb; int ldc; float alpha, s; RowStats bst; const float* bg; const float* bb; float* stats_out;
    __device__ __forceinline__ void operator()(const f32x4 (&acc)[2][2][4][2], const Unit& u, int wr, int wc, int fr, int fq) const {
        typedef unsigned u32x2v __attribute__((ext_vector_type(2)));
        const int col0 = u.pn * BM + wc * 32 + 4 * fq;
#pragma unroll
        for (int ai = 0; ai < 2; ++ai)
#pragma unroll
        for (int mp = 0; mp < 2; ++mp) {
            f32x4 bs[4][2][2];
#pragma unroll
            for (int m = 2 * mp; m < 2 * mp + 2; ++m) { const size_t off = (size_t)(u.pm * BM + ai * HALF + wr * 64 + m * 16 + fr) * ldc + col0;
#pragma unroll
                for (int bj = 0; bj < 2; ++bj)
#pragma unroll
                    for (int n = 0; n < 2; ++n) bs[m][bj][n] = *(const f32x4*)(base + off + bj * HALF + n * 16); }
#pragma unroll
            for (int m = 2 * mp; m < 2 * mp + 2; ++m) { const int row = u.pm * BM + ai * HALF + wr * 64 + m * 16 + fr; const size_t off = (size_t)row * ldc + col0;
                float mu = 0.f, rstd = 1.f; if (LNB) bst.get(row, mu, rstd);
                float rs = 0.f, rq = 0.f;
#pragma unroll
                for (int bj = 0; bj < 2; ++bj)
#pragma unroll
                    for (int n = 0; n < 2; ++n) { f32x4 b_ = bs[m][bj][n];
                        if (LNB) b_ = (b_ - mu) * rstd * *(const f32x4*)(bg + col0 + bj * HALF + n * 16) + *(const f32x4*)(bb + col0 + bj * HALF + n * 16);
                        const f32x4 o = b_ * alpha + acc[ai][bj][m][n] * s;
                        *(f32x4*)(out + off + bj * HALF + n * 16) = o;
                        u32x2v w; w.x = cvt_pk_bf16(o[0], o[1]); w.y = cvt_pk_bf16(o[2], o[3]); *(u32x2v*)(zb + off + bj * HALF + n * 16) = w;
                        rs += (o[0] + o[1]) + (o[2] + o[3]); rq += (o[0] * o[0] + o[1] * o[1]) + (o[2] * o[2] + o[3] * o[3]); }
                rs += __shfl_xor(rs, 16); rq += __shfl_xor(rq, 16); rs += __shfl_xor(rs, 32); rq += __shfl_xor(rq, 32);
                if (fq == 0) { atomicAdd(stats_out + 2 * row, rs); atomicAdd(stats_out + 2 * row + 1, rq); } }
            asm volatile("" ::: "memory"); }
    }
};
struct EpiBf16LN {
    static constexpr bool PERM = true, AFTER_DRAIN = false;
    bf16_t* O; int ldc; RowStats st; const float* c1; const float* c2;
    __device__ __forceinline__ void operator()(const f32x4 (&acc)[2][2][4][2], const Unit& u, int wr, int wc, int fr, int fq) const {
        const int row0 = u.pm * BM + wr * 64 + fr; const int col0 = u.pn * BM + wc * 32 + 8 * fq;
#pragma unroll
        for (int ai = 0; ai < 2; ++ai)
#pragma unroll
            for (int m = 0; m < 4; ++m) { const int row = row0 + ai * HALF + m * 16; bf16_t* rowp = O + (size_t)row * ldc + col0;
                float mu, rstd; st.get(row, mu, rstd); const float rm = rstd * mu;
#pragma unroll
                for (int bj = 0; bj < 2; ++bj) { const float* c1p = c1 + col0 + bj * HALF; const float* c2p = c2 + col0 + bj * HALF;
                    const f32x4 v0 = acc[ai][bj][m][0] * rstd - *(const f32x4*)(c1p) * rm + *(const f32x4*)(c2p), v1 = acc[ai][bj][m][1] * rstd - *(const f32x4*)(c1p + 4) * rm + *(const f32x4*)(c2p + 4);
                    u32x4 w; w.x = cvt_pk_bf16(v0[0], v0[1]); w.y = cvt_pk_bf16(v0[2], v0[3]); w.z = cvt_pk_bf16(v1[0], v1[1]); w.w = cvt_pk_bf16(v1[2], v1[3]);
                    *(u32x4*)(rowp + bj * HALF) = w; }
                asm volatile("" ::: "memory"); }
    }
};
struct EpiSwiGLULN {
    static constexpr bool PERM = true, AFTER_DRAIN = false;
    bf16_t* O; int ldc; RowStats st; const float* c1; const float* c2;
    __device__ __forceinline__ void operator()(const f32x4 (&acc)[2][2][4][2], const Unit& u, int wr, int wc, int fr, int fq) const {
        const int row0 = u.pm * BM + wr * 64 + fr; const int col0 = u.pn * HALF + wc * 32 + 8 * fq; const int ci = u.pn * BM + wc * 32 + 8 * fq;
#pragma unroll
        for (int ai = 0; ai < 2; ++ai)
#pragma unroll
            for (int m = 0; m < 4; ++m) { const int row = row0 + ai * HALF + m * 16; bf16_t* rowp = O + (size_t)row * ldc + col0;
                float mu, rstd; st.get(row, mu, rstd); const float rm = rstd * mu;
                const f32x4 g0 = acc[ai][0][m][0] * rstd - *(const f32x4*)(c1 + ci) * rm + *(const f32x4*)(c2 + ci), g1 = acc[ai][0][m][1] * rstd - *(const f32x4*)(c1 + ci + 4) * rm + *(const f32x4*)(c2 + ci + 4);
                const f32x4 u0 = acc[ai][1][m][0] * rstd - *(const f32x4*)(c1 + ci + HALF) * rm + *(const f32x4*)(c2 + ci + HALF), u1 = acc[ai][1][m][1] * rstd - *(const f32x4*)(c1 + ci + HALF + 4) * rm + *(const f32x4*)(c2 + ci + HALF + 4);
                f32x4 h0, h1;
#pragma unroll
                for (int i = 0; i < 4; ++i) { h0[i] = g0[i] * sigmoid_f(g0[i]) * u0[i]; h1[i] = g1[i] * sigmoid_f(g1[i]) * u1[i]; }
                u32x4 w; w.x = cvt_pk_bf16(h0[0], h0[1]); w.y = cvt_pk_bf16(h0[2], h0[3]); w.z = cvt_pk_bf16(h1[0], h1[1]); w.w = cvt_pk_bf16(h1[2], h1[3]);
                *(u32x4*)rowp = w; asm volatile("" ::: "memory"); }
    }
};
struct EpiPleLN {
    static constexpr bool PERM = false, AFTER_DRAIN = false;
    const float* base; float* out; const bf16_t* e; const float* bias; int ldc; float alpha; RowStats st; const float* bg; const float* bb; const float* c1; const float* c2;
    __device__ __forceinline__ void operator()(const f32x4 (&acc)[2][2][4][2], const Unit& u, int wr, int wc, int fr, int fq) const {
        typedef unsigned u32x2v __attribute__((ext_vector_type(2)));
        const int col0 = u.pn * BM + wc * 32 + 4 * fq;
#pragma unroll
        for (int bj = 0; bj < 2; ++bj)
#pragma unroll
            for (int n = 0; n < 2; ++n) { const int cc = col0 + bj * HALF + n * 16;
                const f32x4 bv = *(const f32x4*)(bias + cc), gv = *(const f32x4*)(bg + cc), bbv = *(const f32x4*)(bb + cc), c1v = *(const f32x4*)(c1 + cc), c2v = *(const f32x4*)(c2 + cc);
#pragma unroll
                for (int ai = 0; ai < 2; ++ai)
#pragma unroll
                    for (int m = 0; m < 4; ++m) { const int row = u.pm * BM + ai * HALF + wr * 64 + m * 16 + fr; const size_t off = (size_t)row * ldc + cc;
                        float mu, rstd; st.get(row, mu, rstd); const float rm = rstd * mu;
                        const f32x4 bs = (*(const f32x4*)(base + off) - mu) * rstd * gv + bbv;
                        const u32x2v ew = *(const u32x2v*)(e + off);
                        f32x4 ev; ev[0] = __uint_as_float(ew.x << 16); ev[1] = __uint_as_float(ew.x & 0xffff0000u); ev[2] = __uint_as_float(ew.y << 16); ev[3] = __uint_as_float(ew.y & 0xffff0000u);
                        const f32x4 a = acc[ai][bj][m][n] * rstd - c1v * rm + c2v + bv; f32x4 o;
#pragma unroll
                        for (int i = 0; i < 4; ++i) o[i] = bs[i] * alpha + sigmoid_f(a[i]) * ev[i];
                        *(f32x4*)(out + off) = o; }
                asm volatile("" ::: "memory"); }
    }
};

struct EpiResidLNip {
    static constexpr bool PERM = false, AFTER_DRAIN = false;
    float* io; bf16_t* zb; float* st; const float* gb; int ldc, nrows; float alpha, s, inv_n, eps;
    __device__ __forceinline__ void operator()(const f32x4 (&acc)[2][2][4][2], const Unit& u, int wr, int wc, int fr, int fq) const {
        typedef unsigned u32x2v __attribute__((ext_vector_type(2)));
        const int col0 = u.pn * BM + wc * 32 + 4 * fq;
#pragma unroll
        for (int ai = 0; ai < 2; ++ai)
#pragma unroll
        for (int mp = 0; mp < 2; ++mp) {
            f32x4 bs[4][2][2]; float sm[4], sq[4];
#pragma unroll
            for (int m = 2 * mp; m < 2 * mp + 2; ++m) { const int row = u.pm * BM + ai * HALF + wr * 64 + m * 16 + fr; const size_t off = (size_t)row * ldc + col0; sm[m] = st[2 * row]; sq[m] = st[2 * row + 1];
#pragma unroll
                for (int bj = 0; bj < 2; ++bj)
#pragma unroll
                    for (int n = 0; n < 2; ++n) bs[m][bj][n] = *(const f32x4*)(io + off + bj * HALF + n * 16); }
#pragma unroll
            for (int m = 2 * mp; m < 2 * mp + 2; ++m) { const int row = u.pm * BM + ai * HALF + wr * 64 + m * 16 + fr; const size_t off = (size_t)row * ldc + col0;
                const float mu = sm[m] * inv_n; const float rstd = __builtin_amdgcn_rsqf(fmaxf(sq[m] * inv_n - mu * mu, 0.f) + eps);
                float rs = 0.f, rq = 0.f;
#pragma unroll
                for (int bj = 0; bj < 2; ++bj)
#pragma unroll
                    for (int n = 0; n < 2; ++n) { const int cc = col0 + bj * HALF + n * 16;
                        const f32x4 b_ = (bs[m][bj][n] - mu) * rstd * *(const f32x4*)(gb + cc) + *(const f32x4*)(gb + ldc + cc);
                        const f32x4 o = b_ * alpha + acc[ai][bj][m][n] * s;
                        *(f32x4*)(io + off + bj * HALF + n * 16) = o;
                        u32x2v w; w.x = cvt_pk_bf16(o[0], o[1]); w.y = cvt_pk_bf16(o[2], o[3]); *(u32x2v*)(zb + off + bj * HALF + n * 16) = w;
                        rs += (o[0] + o[1]) + (o[2] + o[3]); rq += (o[0] * o[0] + o[1] * o[1]) + (o[2] * o[2] + o[3] * o[3]); }
                rs += __shfl_xor(rs, 16); rq += __shfl_xor(rq, 16); rs += __shfl_xor(rs, 32); rq += __shfl_xor(rq, 32);
                if (fq == 0) { atomicAdd(st + 2 * nrows + 2 * row, rs); atomicAdd(st + 2 * nrows + 2 * row + 1, rq); } }
            asm volatile("" ::: "memory"); }
    }
};
template <class Epi, class Sched, bool ALIGN_EPI = false, bool SP2 = false>
__device__ __forceinline__ void gemm_phase(PG8_LAS unsigned char* lds, const Gemm g, const Sched& S, const Epi& E) {
    const int tid = threadIdx.x, wid = __builtin_amdgcn_readfirstlane(tid >> 6), lane = tid & 63, wr = wid >> 2, wc = wid & 3, fr = lane & 15, fq = lane >> 4;
    const int K = g.K, nt = K / BK;
    unsigned voffA[2], voffB[2];
#pragma unroll
    for (int i = 0; i < 2; ++i) { int R, C; stage_rc(tid * 16 + i * 8192, R, C); const int Rb = Epi::PERM ? ((R & ~31) + perm32(R & 31)) : R;
        voffA[i] = (unsigned)(R * K + C) * 2u; voffB[i] = (unsigned)(Rb * K + C) * 2u; }
    const size_t kstep = (size_t)(BK * 2);
    const size_t hstep = (size_t)HALF * K * 2;
    const size_t tstep = 2 * hstep;
    const unsigned ldsw = (unsigned)wid * 1024u;
    const int aoff = lds_byte(wr * 64 + fr, fq * 8), boff = lds_byte(wc * 32 + fr, fq * 8);
#define PG8_SA(b, h) (((b) * 2 + (h)) * HTB)
#define PG8_SB(b, h) ((4 + (b) * 2 + (h)) * HTB)
#define PG8_STAGE(bufoff, gbase, voff) do { _Pragma("unroll") for (int _i = 0; _i < 2; ++_i) \
        __builtin_amdgcn_global_load_lds((const unsigned*)((const char*)(gbase) + (voff)[_i]), (PG8_LAS unsigned*)(lds + (bufoff) + ldsw + _i * 8192), 16, 0, 0); } while (0)
#define PG8_LDA(dst, b, h) do { _Pragma("unroll") for (int m = 0; m < 4; ++m) _Pragma("unroll") for (int k = 0; k < 2; ++k) dst[m][k] = *(const PG8_LAS bf16x8*)(lds + PG8_SA(b, h) + aoff + m * 2048 + k * 1024); } while (0)
#define PG8_LDB(dst, b, h) do { _Pragma("unroll") for (int n = 0; n < 2; ++n) _Pragma("unroll") for (int k = 0; k < 2; ++k) dst[n][k] = *(const PG8_LAS bf16x8*)(lds + PG8_SB(b, h) + boff + n * 2048 + k * 1024); } while (0)
#define PG8_MMA(ai, bj, At, Bt) do { __builtin_amdgcn_s_setprio(1); _Pragma("unroll") for (int m = 0; m < 4; ++m) _Pragma("unroll") for (int n = 0; n < 2; ++n) _Pragma("unroll") for (int k = 0; k < 2; ++k) \
        acc[ai][bj][m][n] = __builtin_amdgcn_mfma_f32_16x16x32_bf16(Bt[n][k], At[m][k], acc[ai][bj][m][n], 0, 0, 0); __builtin_amdgcn_s_setprio(0); } while (0)
#define PG8_WAIT_V(n) asm volatile("s_waitcnt vmcnt(" #n ")" ::: "memory")
#define PG8_WAIT_L(n) asm volatile("s_waitcnt lgkmcnt(" #n ")" ::: "memory")
#define PG8_BAR __builtin_amdgcn_s_barrier()
#define PG8_SCHED __builtin_amdgcn_sched_barrier(0)
    Unit cur, nxt; int ui = 0;
    if (!S.next(0, cur)) return;
    f32x4 acc[2][2][4][2];
#pragma unroll
    for (int a = 0; a < 2; ++a)
#pragma unroll
        for (int b = 0; b < 2; ++b)
#pragma unroll
            for (int m = 0; m < 4; ++m)
#pragma unroll
                for (int n = 0; n < 2; ++n) acc[a][b][m][n] = (f32x4){0.f, 0.f, 0.f, 0.f};
    bf16x8 At[4][2], B0[2][2], B1[2][2];
    const char* cA = (const char*)g.A + (size_t)cur.pm * tstep; const char* cB = (const char*)g.Bt + (size_t)cur.pn * tstep;
    S.a_ready(cur);
    if constexpr (SP2) {
        PG8_STAGE(PG8_SB(0, 0), cB, voffB); PG8_STAGE(PG8_SB(0, 1), cB + hstep, voffB); PG8_STAGE(PG8_SA(0, 0), cA, voffA); PG8_STAGE(PG8_SA(0, 1), cA + hstep, voffA);
        if (wr == 1) PG8_BAR;
        PG8_WAIT_V(2); PG8_BAR;
        PG8_STAGE(PG8_SB(1, 0), cB + kstep, voffB); PG8_STAGE(PG8_SA(1, 0), cA + kstep, voffA); PG8_STAGE(PG8_SB(1, 1), cB + hstep + kstep, voffB);
        PG8_WAIT_V(6); PG8_BAR;
    } else {
        PG8_STAGE(PG8_SB(0, 0), cB, voffB); PG8_STAGE(PG8_SA(0, 0), cA, voffA); PG8_STAGE(PG8_SB(0, 1), cB + hstep, voffB); PG8_STAGE(PG8_SA(0, 1), cA + hstep, voffA);
        if (wr == 1) PG8_BAR;
        PG8_WAIT_V(4); PG8_BAR;
        PG8_STAGE(PG8_SB(1, 0), cB + kstep, voffB); PG8_STAGE(PG8_SA(1, 0), cA + kstep, voffA); PG8_STAGE(PG8_SB(1, 1), cB + hstep + kstep, voffB);
        PG8_WAIT_V(6); PG8_BAR;
    }
    for (;;) {
        const bool has_next = S.next(ui + 1, nxt);
        const char* nA = has_next ? (const char*)g.A + (size_t)nxt.pm * tstep : cA; const char* nB = has_next ? (const char*)g.Bt + (size_t)nxt.pn * tstep : cB;
        for (int t = 0; t < nt; t += 2) {
            const bool last = (t == nt - 2);
            const char* a1 = cA + (size_t)(t + 1) * kstep;
            const char* a2 = last ? nA : cA + (size_t)(t + 2) * kstep; const char* b2 = last ? nB : cB + (size_t)(t + 2) * kstep;
            const char* a3 = a2 + kstep; const char* b3 = b2 + kstep;
            if (last && has_next) S.a_ready(nxt);
            if constexpr (SP2) {
            PG8_LDB(B0, 0, 0); PG8_LDB(B1, 0, 1); PG8_SCHED; PG8_LDA(At, 0, 0); PG8_STAGE(PG8_SA(1, 1), a1 + hstep, voffA);
            PG8_WAIT_V(8); PG8_WAIT_L(0); PG8_BAR; PG8_MMA(0, 0, At, B0); PG8_MMA(0, 1, At, B1); PG8_BAR; PG8_SCHED;
            PG8_LDA(At, 0, 1); PG8_STAGE(PG8_SB(0, 0), b2, voffB); PG8_STAGE(PG8_SB(0, 1), b2 + hstep, voffB); PG8_STAGE(PG8_SA(0, 0), a2, voffA);
            PG8_WAIT_V(8); PG8_WAIT_L(0); PG8_BAR; PG8_MMA(1, 0, At, B0); PG8_MMA(1, 1, At, B1); PG8_BAR; PG8_SCHED;
            PG8_LDB(B0, 1, 0); PG8_LDB(B1, 1, 1); PG8_SCHED; PG8_LDA(At, 1, 0); PG8_STAGE(PG8_SA(0, 1), a2 + hstep, voffA);
            PG8_WAIT_V(8); PG8_WAIT_L(0); PG8_BAR; PG8_MMA(0, 0, At, B0); PG8_MMA(0, 1, At, B1); PG8_BAR; PG8_SCHED;
            PG8_LDA(At, 1, 1); PG8_STAGE(PG8_SB(1, 0), b3, voffB); PG8_STAGE(PG8_SB(1, 1), b3 + hstep, voffB); PG8_STAGE(PG8_SA(1, 0), a3, voffA);
            PG8_WAIT_V(8); PG8_WAIT_L(0); PG8_BAR; PG8_MMA(1, 0, At, B0); PG8_MMA(1, 1, At, B1); PG8_BAR; PG8_SCHED;
            } else {
            PG8_LDB(B0, 0, 0); PG8_SCHED; PG8_LDA(At, 0, 0); PG8_STAGE(PG8_SA(1, 1), a1 + hstep, voffA);
            PG8_WAIT_L(8); PG8_BAR; PG8_WAIT_L(0); PG8_MMA(0, 0, At, B0); PG8_BAR; PG8_SCHED;
            PG8_LDB(B1, 0, 1); PG8_STAGE(PG8_SB(0, 0), b2, voffB);
            PG8_BAR; PG8_WAIT_L(0); PG8_MMA(0, 1, At, B1); PG8_BAR;
            PG8_LDA(At, 0, 1); PG8_STAGE(PG8_SA(0, 0), a2, voffA);
            PG8_BAR; PG8_WAIT_L(0); PG8_MMA(1, 0, At, B0); PG8_BAR; PG8_SCHED;
            PG8_STAGE(PG8_SB(0, 1), b2 + hstep, voffB);
            PG8_WAIT_V(6); PG8_BAR; PG8_MMA(1, 1, At, B1); PG8_BAR;
            PG8_LDB(B0, 1, 0); PG8_SCHED; PG8_LDA(At, 1, 0); PG8_STAGE(PG8_SA(0, 1), a2 + hstep, voffA);
            PG8_WAIT_L(8); PG8_BAR; PG8_WAIT_L(0); PG8_MMA(0, 0, At, B0); PG8_BAR; PG8_SCHED;
            PG8_LDB(B1, 1, 1); PG8_STAGE(PG8_SB(1, 0), b3, voffB);
            PG8_BAR; PG8_WAIT_L(0); PG8_MMA(0, 1, At, B1); PG8_BAR;
            PG8_LDA(At, 1, 1); PG8_STAGE(PG8_SA(1, 0), a3, voffA);
            PG8_BAR; PG8_WAIT_L(0); PG8_MMA(1, 0, At, B0); PG8_BAR; PG8_SCHED;
            PG8_STAGE(PG8_SB(1, 1), b3 + hstep, voffB);
            PG8_WAIT_V(6); PG8_BAR; PG8_MMA(1, 1, At, B1); PG8_BAR;
            }
        }
        if constexpr (ALIGN_EPI) { if (wr == 0) PG8_BAR; }
        if constexpr (!Epi::AFTER_DRAIN) { E(acc, cur, wr, wc, fr, fq); S.done(cur); }
        if (!has_next) break;
#pragma unroll
        for (int a = 0; a < 2; ++a)
#pragma unroll
            for (int b = 0; b < 2; ++b)
#pragma unroll
                for (int m = 0; m < 4; ++m)
#pragma unroll
                    for (int n = 0; n < 2; ++n) acc[a][b][m][n] = (f32x4){0.f, 0.f, 0.f, 0.f};
        cur = nxt; cA = nA; cB = nB; ++ui;
        if constexpr (ALIGN_EPI) { if (wr == 1) PG8_BAR; }
    }
    PG8_WAIT_V(0);
    if constexpr (!ALIGN_EPI) { if (wr == 0) PG8_BAR; }
    PG8_BAR;
    if constexpr (Epi::AFTER_DRAIN) { E.fused(acc, cur, wr, wc, fr, fq, lds, wid, lane); S.done(cur); }
#undef PG8_SA
#undef PG8_SB
#undef PG8_STAGE
#undef PG8_LDA
#undef PG8_LDB
#undef PG8_MMA
#undef PG8_WAIT_V
#undef PG8_WAIT_L
#undef PG8_BAR
#undef PG8_SCHED
}
}

constexpr int NWAVES = 8, NT = NWAVES * 64;
constexpr int BATCH = 2, SEQ = 4096, DM = 2048, M = BATCH * SEQ;
constexpr int DFF = 5632, NGU = 2 * DFF;
constexpr int INC = 6432, INP = 6656;
constexpr int AW = 1024, RW = 1024, NH = 16, HD = 64;
constexpr int PLE = 256;
constexpr int UQ = 0, UK = 1024, UV = 2048, UR = 3072;
constexpr float LN_EPS = 1e-5f, GN_EPS = 64e-5f;
constexpr float ALPHA = 1.189207115002721f;
constexpr float LOG2E = 1.4426950408889634f;

constexpr size_t MiB = 1u << 20;
constexpr size_t WS_CTL = 0, CTL_ZERO_BYTES = 1 * MiB;
constexpr size_t WS_WGU = 2 * MiB;
constexpr size_t WS_WD = 46 * MiB;
constexpr size_t WS_WIN = 68 * MiB;
constexpr size_t WS_WOUT = 94 * MiB;
constexpr size_t WS_WPG = 102 * MiB;
constexpr size_t WS_WPU = 110 * MiB;
constexpr size_t WS_SMALL = 111 * MiB;
constexpr size_t WS_XB = 112 * MiB;
constexpr size_t WS_BIG = 144 * MiB;
constexpr size_t WS_MIX = 248 * MiB;
constexpr size_t WS_SCAN = 280 * MiB;
constexpr size_t WS_F2 = 312 * MiB;
constexpr size_t WS_PB = 392 * MiB;
constexpr size_t WS_END = 396 * MiB;
constexpr size_t SM_W2T = 0, SM_A2T = 131072, SM_G2T = 262144, SM_KMEAN = 655360;
constexpr size_t WS_BONUS = 1 * MiB;
static_assert(SM_G2T + 1024 * 192 * 2 <= SM_KMEAN && SM_KMEAN + 2 * 16 * 16 * 64 * 2 <= MiB, "small map");
constexpr int CW_TMO = 0, CW_BAR = 4096, CW_QUEUE = 8192;
constexpr size_t WS_STATS = 65536, WS_CVEC = 262144, WS_GB = 425984;
static_assert(WS_STATS + 3 * 2 * (size_t)M * 4 <= WS_CVEC && WS_CVEC + 2 * (size_t)(INP + NGU + DM) * 4 <= CTL_ZERO_BYTES, "control region map");

constexpr int RING_BYTES = 131072;
constexpr int LDSCTL_OFF = 147456, MISC_OFF = LDSCTL_OFF + 320;
constexpr int LDS_BYTES = 155648;

#define GAS __attribute__((address_space(1)))
#define LAS __attribute__((address_space(3)))
typedef unsigned short bf16;
typedef unsigned v4u __attribute__((ext_vector_type(4)));
typedef unsigned v2u __attribute__((ext_vector_type(2)));
typedef float f32x4 __attribute__((ext_vector_type(4)));
typedef float f32x16 __attribute__((ext_vector_type(16)));
typedef short bf16x8 __attribute__((ext_vector_type(8)));
typedef short s16x4 __attribute__((ext_vector_type(4)));
typedef GAS unsigned gu32;
#define RLX_AGENT __ATOMIC_RELAXED, __HIP_MEMORY_SCOPE_AGENT
#define LDS_WAIT() asm volatile("s_waitcnt lgkmcnt(0)" ::: "memory")
#define VM_WAIT() asm volatile("s_waitcnt vmcnt(0)" ::: "memory")
__device__ __forceinline__ unsigned f2bf(float f) { unsigned u = __builtin_bit_cast(unsigned, f); return (u + 0x7fffu + ((u >> 16) & 1u)) >> 16; }
__device__ __forceinline__ unsigned pk2(float lo, float hi) { return f2bf(lo) | (f2bf(hi) << 16); }
__device__ __forceinline__ float bf2f(unsigned short b) { return __uint_as_float((unsigned)b << 16); }
__device__ __forceinline__ float bflo(unsigned w) { return __uint_as_float(w << 16); }
__device__ __forceinline__ float bfhi(unsigned w) { return __uint_as_float(w & 0xffff0000u); }

#define XB_TMO      128
#define XB_XCNT(j)  (256  + 64 * (j))
#define XB_XSUB(j)  (1280 + 64 * (j))
#define XB_XGEN(j)  (2304 + 64 * (j))
#define XB_TOP      3328
#define XB_TOPGEN   3392
#define XCD_BAR_WORDS 3456
#define XB_SPIN_CAP (1u << 18)
__device__ __forceinline__ unsigned xb_ld(unsigned* p)              { return __hip_atomic_load(p, __ATOMIC_RELAXED, __HIP_MEMORY_SCOPE_AGENT); }
__device__ __forceinline__ unsigned xb_add(unsigned* p, unsigned v) { return __hip_atomic_fetch_add(p, v, __ATOMIC_RELAXED, __HIP_MEMORY_SCOPE_AGENT); }
__device__ __forceinline__ unsigned xb_xcc_id() { return (unsigned)__builtin_amdgcn_s_getreg((3 << 11) | 20) & 0xFu; }
#define XB_SPIN(cond, bar) do { unsigned _sp = 0; while (cond) { __builtin_amdgcn_s_sleep(1); \
    if ((++_sp & 255u) == 0u) { if (xb_ld(&(bar)[XB_TMO])) break; if (_sp > XB_SPIN_CAP) { atomicAdd(&(bar)[XB_TMO], 1u); break; } } } } while (0)
struct XcdBarrier { unsigned* bar; unsigned x; volatile LAS unsigned* st; };
__device__ __forceinline__ XcdBarrier xcd_barrier_post(unsigned* bar, volatile LAS unsigned* st) {
    XcdBarrier b; b.bar = bar; b.x = xb_xcc_id(); b.st = st;
    if (threadIdx.x == 0) (void)xb_add(&bar[XB_XCNT(b.x)], 1u);
    return b;
}
__device__ __forceinline__ void xcd_barrier_complete(unsigned* bar, unsigned x, unsigned& nloc, unsigned& nx) {
    const unsigned G = gridDim.x * gridDim.y * gridDim.z;
    unsigned sum, cnt, mine, sp = 0u;
    for (;;) {
        sum = 0u; cnt = 0u; mine = 0u;
#pragma unroll
        for (unsigned j = 0; j < 16; ++j) { const unsigned c = xb_ld(&bar[XB_XCNT(j)]); sum += c; cnt += (c > 0u) ? 1u : 0u; mine = (j == x) ? c : mine; }
        if (sum == G) break;
        __builtin_amdgcn_s_sleep(1);
        if ((++sp & 255u) == 0u) { if (xb_ld(&bar[XB_TMO])) break; if (sp > XB_SPIN_CAP) { atomicAdd(&bar[XB_TMO], 1u); break; } }
    }
    nloc = mine > 0u ? mine : 1u; nx = cnt > 0u ? cnt : 1u;
}
__device__ __forceinline__ void xcd_barrier(const XcdBarrier& b) {
    asm volatile("s_waitcnt vmcnt(0)" ::: "memory");
    __syncthreads();
    if (threadIdx.x == 0) {
        unsigned* bar = b.bar;
        __builtin_amdgcn_s_waitcnt(0);
        unsigned nloc = b.st[0], nx = b.st[1];
        if (nloc == 0u) { xcd_barrier_complete(bar, b.x, nloc, nx); b.st[0] = nloc; b.st[1] = nx; }
        const unsigned old = xb_add(&bar[XB_XSUB(b.x)], 1u);
        const unsigned gen = old / nloc;
        if (old + 1u == (gen + 1u) * nloc) {
            __builtin_amdgcn_fence(__ATOMIC_RELEASE, "agent");
            asm volatile("s_waitcnt vmcnt(0)" ::: "memory");
            const unsigned og = xb_add(&bar[XB_TOP], 1u);
            const unsigned tg = og / nx;
            if (og + 1u == (tg + 1u) * nx) xb_add(&bar[XB_TOPGEN], 1u);
            else XB_SPIN(xb_ld(&bar[XB_TOPGEN]) == tg, bar);
            __builtin_amdgcn_fence(__ATOMIC_ACQUIRE, "agent");
            xb_add(&bar[XB_XGEN(b.x)], 1u);
            asm volatile("s_waitcnt vmcnt(0)" ::: "memory");
        } else {
            XB_SPIN(xb_ld(&bar[XB_XGEN(b.x)]) == gen, bar);
            __builtin_amdgcn_fence(__ATOMIC_ACQUIRE, "agent");
            asm volatile("s_waitcnt vmcnt(0)" ::: "memory");
        }
    }
    __syncthreads();
}

struct Args { const float* in[33]; float* out; unsigned char* ws; int ph_lo, ph_hi; };
struct Frame {
    LAS unsigned char* lds;
    int tid, lane, wave, G, bid;
    const float* const* in;
    float* hz;
    unsigned char* ws;
};
__device__ __forceinline__ float wave_sum(float v) {
#pragma unroll
    for (int o = 1; o < 64; o <<= 1) v += __shfl_xor(v, o);
    return v;
}
__device__ __forceinline__ unsigned cvtpk(float lo, float hi) { typedef float f2 __attribute__((ext_vector_type(2))); typedef __bf16 b2 __attribute__((ext_vector_type(2))); f2 v = {lo, hi}; b2 b = __builtin_convertvector(v, b2); return __builtin_bit_cast(unsigned, b); }
__device__ __forceinline__ float swapmax(float m) { auto rr = __builtin_amdgcn_permlane32_swap(__float_as_uint(m), __float_as_uint(m), false, false); return fmaxf(__uint_as_float(rr[0]), __uint_as_float(rr[1])); }
__device__ __forceinline__ float swapsum(float m) { auto rr = __builtin_amdgcn_permlane32_swap(__float_as_uint(m), __float_as_uint(m), false, false); return __uint_as_float(rr[0]) + __uint_as_float(rr[1]); }

struct TrItem { f32x4 v[8]; };
__device__ __forceinline__ void tr_load(TrItem& T, const float* W, int Kvalid, int N, int k0, int n0, int lane) {
#pragma unroll
    for (int i = 0; i < 8; ++i) { const int kk = (lane >> 3) + 8 * i; T.v[i] = (f32x4){0.f, 0.f, 0.f, 0.f}; if (k0 + kk < Kvalid) T.v[i] = *(const GAS f32x4*)(W + (size_t)(k0 + kk) * N + n0 + 4 * (lane & 7)); }
}
template <bool LNF>
__device__ __forceinline__ void tr_store(const TrItem& T, bf16* WT, int ldo, int orow0, LAS float* scr, int k0, int lane, const float* gk, const float* bk, float* c1, float* c2) {
#pragma unroll
    for (int i = 0; i < 8; ++i) { const int kk = (lane >> 3) + 8 * i; LAS float* d = scr + kk * 33 + 4 * (lane & 7); d[0] = T.v[i][0]; d[1] = T.v[i][1]; d[2] = T.v[i][2]; d[3] = T.v[i][3]; }
    LDS_WAIT(); asm volatile("" ::: "memory");
    const int c = lane & 7;
    float gg[8], bb[8];
    if (LNF) { const f32x4 g0 = *(const GAS f32x4*)(gk + k0 + 8 * c), g1 = *(const GAS f32x4*)(gk + k0 + 8 * c + 4), b0 = *(const GAS f32x4*)(bk + k0 + 8 * c), b1 = *(const GAS f32x4*)(bk + k0 + 8 * c + 4);
#pragma unroll
        for (int i = 0; i < 4; ++i) { gg[i] = g0[i]; gg[4 + i] = g1[i]; bb[i] = b0[i]; bb[4 + i] = b1[i]; } }
#pragma unroll
    for (int j = 0; j < 4; ++j) { const int n = (lane >> 3) + 8 * j; const LAS float* s = scr + (8 * c) * 33 + n;
        float w[8];
#pragma unroll
        for (int i = 0; i < 8; ++i) w[i] = s[i * 33];
        float s1 = 0.f, s2 = 0.f;
        if (LNF) {
#pragma unroll
            for (int i = 0; i < 8; ++i) { s2 += bb[i] * w[i]; w[i] *= gg[i]; } }
        v4u o; o.x = pk2(w[0], w[1]); o.y = pk2(w[2], w[3]); o.z = pk2(w[4], w[5]); o.w = pk2(w[6], w[7]);
        *(GAS v4u*)(WT + (size_t)(orow0 + n) * ldo + k0 + 8 * c) = o;
        if (LNF) { s1 = (bflo(o.x) + bfhi(o.x)) + (bflo(o.y) + bfhi(o.y)) + (bflo(o.z) + bfhi(o.z)) + (bflo(o.w) + bfhi(o.w));
            s1 += __shfl_xor(s1, 1); s2 += __shfl_xor(s2, 1); s1 += __shfl_xor(s1, 2); s2 += __shfl_xor(s2, 2); s1 += __shfl_xor(s1, 4); s2 += __shfl_xor(s2, 4);
            if (c == 0) { atomicAdd(c1 + orow0 + n, s1); atomicAdd(c2 + orow0 + n, s2); } } }
    LDS_WAIT(); asm volatile("" ::: "memory");
}
template <bool LNF = false>
__device__ __forceinline__ void transpose_job(Frame& F, const float* W, int Kvalid, int Kpad, int N, bf16* WT, int ldo, int mode, int& base, const float* gk = nullptr, const float* bk = nullptr, float* c1 = nullptr, float* c2 = nullptr, int wrank = -1, int wcount = 0) {
    LAS float* scr = (LAS float*)(F.lds + F.wave * 16384);
    const int gw = (wrank >= 0) ? wrank : F.bid * NWAVES + F.wave, NGW = (wrank >= 0) ? wcount : F.G * NWAVES;
    const int nblk = N / 32, items = (Kpad / 64) * nblk;
    const int first = (gw - base % NGW + NGW) % NGW;
#define TR_DECODE(it, k0_, n0_, orow_) const int k0_ = 64 * ((it) / nblk), n0_ = 32 * ((it) % nblk), orow_ = (mode == 0) ? n0_ : ((n0_ >> 7) * 256 + (mode == 2 ? 128 : 0) + (n0_ & 127))
    TrItem A, B;
    int it = first;
    if (it < items) { TR_DECODE(it, k0, n0, orow); (void)orow; tr_load(A, W, Kvalid, N, k0, n0, F.lane); }
    while (it < items) {
        { const int nx = it + NGW; if (nx < items) { TR_DECODE(nx, k1, n1, orow1); (void)orow1; tr_load(B, W, Kvalid, N, k1, n1, F.lane); }
          TR_DECODE(it, k0, n0, orow); (void)n0; tr_store<LNF>(A, WT, ldo, orow, scr, k0, F.lane, gk, bk, c1, c2); it = nx; }
        if (it >= items) break;
        { const int nx = it + NGW; if (nx < items) { TR_DECODE(nx, k1, n1, orow1); (void)orow1; tr_load(A, W, Kvalid, N, k1, n1, F.lane); }
          TR_DECODE(it, k0, n0, orow); (void)n0; tr_store<LNF>(B, WT, ldo, orow, scr, k0, F.lane, gk, bk, c1, c2); it = nx; }
    }
#undef TR_DECODE
    base += items;
}
__device__ __forceinline__ void convert_bf16(Frame& F, const float* src, bf16* dst, size_t n) {
    const size_t gt = (size_t)F.bid * NT + F.tid, NGT = (size_t)F.G * NT, n8 = n / 8;
    for (size_t i = gt; i < n8; i += 4 * NGT) { f32x4 a[4], b[4];
#pragma unroll
        for (int u = 0; u < 4; ++u) if (i + u * NGT < n8) { a[u] = *(const GAS f32x4*)(src + (i + u * NGT) * 8); b[u] = *(const GAS f32x4*)(src + (i + u * NGT) * 8 + 4); }
#pragma unroll
        for (int u = 0; u < 4; ++u) if (i + u * NGT < n8) { v4u o; o.x = pk2(a[u][0], a[u][1]); o.y = pk2(a[u][2], a[u][3]); o.z = pk2(b[u][0], b[u][1]); o.w = pk2(b[u][2], b[u][3]); *(GAS v4u*)(dst + (i + u * NGT) * 8) = o; } }
}
template <bool LNF>
__device__ __forceinline__ void ffn_weights(Frame& F, int gi, int ui, int di, bf16* Wgu_dst, bf16* Wd_dst, int& base, const float* gk = nullptr, const float* bk = nullptr, float* c1 = nullptr, float* c2 = nullptr, int wrank = -1, int wcount = 0) {
    transpose_job<LNF>(F, F.in[gi], DM, DM, DFF, Wgu_dst, DM, 1, base, gk, bk, c1, c2, wrank, wcount);
    transpose_job<LNF>(F, F.in[ui], DM, DM, DFF, Wgu_dst, DM, 2, base, gk, bk, c1, c2, wrank, wcount);
    transpose_job<false>(F, F.in[di], DFF, DFF, DM, Wd_dst, DFF, 0, base, nullptr, nullptr, nullptr, nullptr, wrank, wcount);
}

template <bool WRITE_BF16>
__device__ __forceinline__ void ln_phase(Frame& F, float* hz, const float* g, const float* b, bf16* hb) {
    const int gw = F.bid * NWAVES + F.wave, NGW = F.G * NWAVES;
    f32x4 gv[8], bv[8];
#pragma unroll
    for (int j = 0; j < 8; ++j) { gv[j] = *(const GAS f32x4*)(g + F.lane * 4 + 256 * j); bv[j] = *(const GAS f32x4*)(b + F.lane * 4 + 256 * j); }
    for (int m = gw; m < M; m += NGW) {
        GAS f32x4* xr = (GAS f32x4*)(hz + (size_t)m * DM) + F.lane;
        f32x4 v[8]; float s = 0.f;
#pragma unroll
        for (int j = 0; j < 8; ++j) { v[j] = xr[64 * j]; s += (v[j][0] + v[j][1]) + (v[j][2] + v[j][3]); }
        const float mean = wave_sum(s) * (1.f / DM); float s2 = 0.f;
#pragma unroll
        for (int j = 0; j < 8; ++j) { v[j] = v[j] - mean; s2 += (v[j][0] * v[j][0] + v[j][1] * v[j][1]) + (v[j][2] * v[j][2] + v[j][3] * v[j][3]); }
        const float rstd = 1.f / sqrtf(wave_sum(s2) * (1.f / DM) + LN_EPS);
#pragma unroll
        for (int j = 0; j < 8; ++j) { v[j] = v[j] * rstd * gv[j] + bv[j]; xr[64 * j] = v[j]; }
        if (WRITE_BF16) { GAS v2u* o8 = (GAS v2u*)(hb + (size_t)m * DM) + F.lane;
#pragma unroll
            for (int j = 0; j < 8; ++j) { v2u w; w.x = pk2(v[j][0], v[j][1]); w.y = pk2(v[j][2], v[j][3]); o8[64 * j] = w; } }
    }
}

__device__ __forceinline__ int crow(int r, int hi) { return (r & 3) + 8 * (r >> 2) + 4 * hi; }
__device__ __forceinline__ float red32(float v) {
#pragma unroll
    for (int o = 1; o < 32; o <<= 1) v += __shfl_xor(v, o);
    return v;
}
__device__ __forceinline__ void kmean_tasks(Frame& F) {
    const bf16* ub = (const bf16*)(F.ws + WS_BIG); bf16* km = (bf16*)(F.ws + WS_SMALL + SM_KMEAN);
    if (F.wave >= 2) return;
    for (int task = F.bid * 2 + F.wave; task < BATCH * 16 * NH; task += F.G * 2) {
        const int b = task >> 8, blk = (task >> 4) & 15, h = task & 15;
        const int par = F.lane >> 5, dp = F.lane & 31;
        const GAS unsigned* p = (const GAS unsigned*)(ub + (size_t)(b * SEQ + blk * 256 + par) * INP + UK + h * HD) + dp;
        float lo[16], hi_[16];
#pragma unroll
        for (int u = 0; u < 16; ++u) { lo[u] = 0.f; hi_[u] = 0.f; }
#pragma unroll 1
        for (int i = 0; i < 128; i += 16) {
            unsigned wv[16];
#pragma unroll
            for (int u = 0; u < 16; ++u) wv[u] = p[(size_t)(2 * (i + u)) * (INP / 2)];
#pragma unroll
            for (int u = 0; u < 16; ++u) { lo[u] += bflo(wv[u]); hi_[u] += bfhi(wv[u]); }
        }
        float sl = 0.f, sh = 0.f;
#pragma unroll
        for (int u = 0; u < 16; ++u) { sl += lo[u]; sh += hi_[u]; }
        sl += __shfl_xor(sl, 32); sh += __shfl_xor(sh, 32);
        if (par == 0) *(GAS unsigned*)(km + ((b * NH + h) * 16 + blk) * HD + 2 * dp) = pk2(sl * (1.f / 256.f), sh * (1.f / 256.f));
    }
}
__device__ __forceinline__ void shifted4(const bf16* ucol  , bool first_is_seq_start, float mix, float (&o)[4]) {
    float pv = first_is_seq_start ? 0.f : bf2f(*(ucol - INP));
#pragma unroll
    for (int i = 0; i < 4; ++i) { const float c = bf2f(ucol[(size_t)i * INP]); o[i] = c + (pv - c) * mix; pv = c; }
}
constexpr int PA_W = 0, PA_A = 4608, PA_G = 9216, PA_PITCH = 144, PG_PITCH = 400;
__device__ __forceinline__ void prep_tile(Frame& F, int tile) {
    const bf16* ub = (const bf16*)(F.ws + WS_BIG);
    const int m0 = tile * 32;
    const float* shift_mix = F.in[9];
    LAS unsigned char* L = F.lds;
    for (int idx = F.tid; idx < 32 * 288; idx += NT) {
        const int t = idx / 288, k = idx - t * 288, m = m0 + t;
        const bf16* up = ub + (size_t)m * INP + UR + 3072 + k;
        const float cur = bf2f(*up), prev = ((m & (SEQ - 1)) == 0) ? 0.f : bf2f(*(up - INP));
        const float us = cur + (prev - cur) * shift_mix[3072 + k];
        if (k < 64) { const float e2 = __expf(2.f * us); *(LAS bf16*)(L + PA_W + t * PA_PITCH + k * 2) = (bf16)f2bf(1.f - 2.f / (e2 + 1.f)); }
        else if (k < 128) *(LAS bf16*)(L + PA_A + t * PA_PITCH + (k - 64) * 2) = (bf16)f2bf(us);
        else *(LAS bf16*)(L + PA_G + t * PG_PITCH + (k - 128) * 2) = (bf16)f2bf(1.f / (1.f + __expf(-us)));
    }
    for (int idx = F.tid; idx < 32 * 32; idx += NT) *(LAS bf16*)(L + PA_G + (idx >> 5) * PG_PITCH + (160 + (idx & 31)) * 2) = 0;
    __syncthreads();
    const bf16* w2t = (const bf16*)(F.ws + WS_SMALL + SM_W2T); const bf16* a2t = (const bf16*)(F.ws + WS_SMALL + SM_A2T); const bf16* g2t = (const bf16*)(F.ws + WS_SMALL + SM_G2T);
    const float *w0 = F.in[10], *a0 = F.in[12], *k_k = F.in[15], *k_a = F.in[16], *r_k = F.in[17];
    bf16* SR = (bf16*)(F.ws + WS_SCAN); bf16* SE = SR + (size_t)M * RW; bf16* SKP = SE + (size_t)M * RW; bf16* SV = SKP + (size_t)M * RW;
    bf16* SKK = SV + (size_t)M * RW; bf16* SBB = SKK + (size_t)M * RW; bf16* SGG = SBB + (size_t)M * RW;
    float* bonus = (float*)(F.ws + WS_BONUS);
    const int r32 = F.lane & 31, hi = F.lane >> 5;
    const bool seq0 = (m0 & (SEQ - 1)) == 0;
    for (int hp = 0; hp < 2; ++hp) {
        const int head = 2 * F.wave + hp;
        float n2[16], bon[16];
#pragma unroll
        for (int r = 0; r < 16; ++r) { n2[r] = 0.f; bon[r] = 0.f; }
        for (int nt = 0; nt < 2; ++nt) {
            const int c = head * 64 + 32 * nt + r32;
            f32x16 accA = {};
#pragma unroll
            for (int ks = 0; ks < 4; ++ks) { const bf16x8 af = *(const LAS bf16x8*)(L + PA_A + r32 * PA_PITCH + (16 * ks + 8 * hi) * 2); const bf16x8 bfr = *(const GAS bf16x8*)(a2t + c * 64 + 16 * ks + 8 * hi);
                accA = __builtin_amdgcn_mfma_f32_32x32x16_bf16(af, bfr, accA, 0, 0, 0); }
            const float a0c = a0[c], kkc = k_k[c], kac = k_a[c], rkc = r_k[c], mixr = shift_mix[c], mixk = shift_mix[1024 + c];
#pragma unroll
            for (int g = 0; g < 4; ++g) { const int tb = 8 * g + 4 * hi; float rr[4], kr[4];
                shifted4(ub + (size_t)(m0 + tb) * INP + UR + c, seq0 && tb == 0, mixr, rr);
                shifted4(ub + (size_t)(m0 + tb) * INP + UR + 1024 + c, seq0 && tb == 0, mixk, kr);
#pragma unroll
                for (int i = 0; i < 4; ++i) { const int r = 4 * g + i; const float a = 1.f / (1.f + __expf(-(a0c + accA[r])));
                    const float kq = kr[i] * kkc; n2[r] += kq * kq; bon[r] += rr[i] * kr[i] * (1.f + (a - 1.f) * kac) * rkc; } }
        }
        float inv[16];
#pragma unroll
        for (int r = 0; r < 16; ++r) { const float s = red32(n2[r]); inv[r] = 1.f / fmaxf(sqrtf(s), 1e-12f); bon[r] = red32(bon[r]); }
        if (r32 == 0) {
#pragma unroll
            for (int r = 0; r < 16; ++r) bonus[(size_t)(m0 + crow(r, hi)) * NH + head] = bon[r]; }
        for (int nt = 0; nt < 2; ++nt) {
            const int c = head * 64 + 32 * nt + r32;
            f32x16 accA = {}, accW = {}, accG = {};
#pragma unroll
            for (int ks = 0; ks < 4; ++ks) { const bf16x8 af = *(const LAS bf16x8*)(L + PA_A + r32 * PA_PITCH + (16 * ks + 8 * hi) * 2); const bf16x8 bfr = *(const GAS bf16x8*)(a2t + c * 64 + 16 * ks + 8 * hi);
                accA = __builtin_amdgcn_mfma_f32_32x32x16_bf16(af, bfr, accA, 0, 0, 0);
                const bf16x8 wf = *(const LAS bf16x8*)(L + PA_W + r32 * PA_PITCH + (16 * ks + 8 * hi) * 2); const bf16x8 bw = *(const GAS bf16x8*)(w2t + c * 64 + 16 * ks + 8 * hi);
                accW = __builtin_amdgcn_mfma_f32_32x32x16_bf16(wf, bw, accW, 0, 0, 0); }
#pragma unroll
            for (int ks = 0; ks < 12; ++ks) { const bf16x8 gf = *(const LAS bf16x8*)(L + PA_G + r32 * PG_PITCH + (16 * ks + 8 * hi) * 2); const bf16x8 bg = *(const GAS bf16x8*)(g2t + c * 192 + 16 * ks + 8 * hi);
                accG = __builtin_amdgcn_mfma_f32_32x32x16_bf16(gf, bg, accG, 0, 0, 0); }
            const float a0c = a0[c], w0c = w0[c], kkc = k_k[c], kac = k_a[c], mixr = shift_mix[c], mixk = shift_mix[1024 + c], mixv = shift_mix[2048 + c];
#pragma unroll
            for (int g = 0; g < 4; ++g) { const int tb = 8 * g + 4 * hi; float rr[4], kr[4], vr[4];
                shifted4(ub + (size_t)(m0 + tb) * INP + UR + c, seq0 && tb == 0, mixr, rr);
                shifted4(ub + (size_t)(m0 + tb) * INP + UR + 1024 + c, seq0 && tb == 0, mixk, kr);
                shifted4(ub + (size_t)(m0 + tb) * INP + UR + 2048 + c, seq0 && tb == 0, mixv, vr);
#pragma unroll
                for (int i = 0; i < 4; ++i) { const int r = 4 * g + i; const size_t o = (size_t)(m0 + tb + i) * RW + c;
                    const float a = 1.f / (1.f + __expf(-(a0c + accA[r])));
                    const float x = -(w0c + accW[r]);
                    const float sp = fmaxf(x, 0.f) + __logf(1.f + __expf(-fabsf(x)));
                    const float e = __expf(-sp - 0.5f);
                    const float kk = kr[i] * kkc * inv[r], kp = kr[i] * (1.f + (a - 1.f) * kac);
                    SR[o] = (bf16)f2bf(rr[i]); SE[o] = (bf16)f2bf(e); SKP[o] = (bf16)f2bf(kp); SV[o] = (bf16)f2bf(vr[i]);
                    SKK[o] = (bf16)f2bf(kk); SBB[o] = (bf16)f2bf(kk * a); SGG[o] = (bf16)f2bf(accG[r]); } }
        }
    }
    __syncthreads();
}

__device__ __forceinline__ s16x4 vtr(const LAS unsigned char* p) { typedef short v4i16_t __attribute__((ext_vector_type(4))); return __builtin_bit_cast(s16x4, __builtin_amdgcn_ds_read_tr16_b64_v4i16((LAS v4i16_t*)p)); }
constexpr int CP = 144, CMB = 64 * CP;
enum { C_AT = 0, C_BT, C_KT, C_RT, C_BP, C_KP, C_VV, C_Q0, C_Q1, C_X0, C_X1, C_AK, C_BR, C_KR, C_NSLOT };
static_assert(C_NSLOT * CMB <= RING_BYTES, "chunk pre-pass LDS");
constexpr int C_SMALL = 148480;
constexpr size_t CH_UNIT = 32768, CH_TT = 0, CH_PT = 8192, CH_HT = 16384, CH_YV = 24576;
__device__ __forceinline__ bf16x8 trfrag(const LAS unsigned char* Mt, int k0, int c0, int lane) {
    const LAS unsigned char* p = Mt + (k0 + 8 * (lane >> 5) + ((lane & 15) >> 2)) * CP + (c0 + 16 * ((lane >> 4) & 1) + 4 * (lane & 3)) * 2;
    const s16x4 lo = vtr(p), hh = vtr(p + 4 * CP);
    return (bf16x8){lo[0], lo[1], lo[2], lo[3], hh[0], hh[1], hh[2], hh[3]};
}
template <bool A_TR, bool B_TR>
__device__ __forceinline__ f32x16 tile_mm(const LAS unsigned char* A, int r0, const LAS unsigned char* B, int c0, f32x16 acc, int lane) {
    const int r32 = lane & 31, hi = lane >> 5;
#pragma unroll
    for (int ks = 0; ks < 4; ++ks) {
        const bf16x8 af = A_TR ? trfrag(A, 16 * ks, r0, lane) : *(const LAS bf16x8*)(A + (r0 + r32) * CP + (16 * ks + 8 * hi) * 2);
        const bf16x8 bf = B_TR ? trfrag(B, 16 * ks, c0, lane) : *(const LAS bf16x8*)(B + (c0 + r32) * CP + (16 * ks + 8 * hi) * 2);
        acc = __builtin_amdgcn_mfma_f32_32x32x16_bf16(af, bf, acc, 0, 0, 0);
    }
    return acc;
}
__device__ __forceinline__ void tile_store_lds(LAS unsigned char* Z, int r0, int c0, const f32x16& v, int lane) {
    const int r32 = lane & 31, hi = lane >> 5;
#pragma unroll
    for (int r = 0; r < 16; ++r) *(LAS bf16*)(Z + (r0 + crow(r, hi)) * CP + (c0 + r32) * 2) = (bf16)f2bf(v[r]);
}
__device__ __forceinline__ void tile_store_glb_t(bf16* G, int r0, int c0, const f32x16& v, int lane) {
    const int r32 = lane & 31, hi = lane >> 5;
#pragma unroll
    for (int g = 0; g < 4; ++g) { v2u w; w.x = pk2(v[4 * g], v[4 * g + 1]); w.y = pk2(v[4 * g + 2], v[4 * g + 3]);
        *(GAS v2u*)(G + (size_t)(c0 + r32) * 64 + r0 + 8 * g + 4 * hi) = w; }
}
constexpr int RAW_R = C_AT, RAW_K = C_BT, RAW_V = C_KT, RAW_E = C_RT, RAW_KK = C_BP, RAW_BB = C_KP, RAW_KP = C_VV, ACT_G = C_X0;
constexpr int GPITCH = 400;
constexpr int ACT_WP = C_NSLOT * CMB, ACT_AP = ACT_WP + CMB;
constexpr int C_PART = C_SMALL + 2048 + 256;
static_assert(64 * GPITCH <= 3 * CMB && ACT_AP + CMB <= LDSCTL_OFF && C_PART + 2048 <= LDS_BYTES, "RWKV group LDS map");
constexpr size_t VG_UNIT = 16384, VG_VS = 0, VG_GG = 8192;
#define LBAR() do { asm volatile("s_waitcnt lgkmcnt(0)" ::: "memory"); __builtin_amdgcn_s_barrier(); asm volatile("" ::: "memory"); } while (0)
__device__ __forceinline__ void rwkv_group(Frame& F, int grp) {
    const int b = grp >> 7, c = (grp >> 1) & 63, hh = grp & 1;
    const size_t m0 = (size_t)b * SEQ + (size_t)c * 64;
    const bf16* ub = (const bf16*)(F.ws + WS_BIG);
    LAS unsigned char* L = F.lds;
    LAS float* totals = (LAS float*)(L + C_SMALL); LAS float* gend = totals + 512; LAS float* part = (LAS float*)(L + C_PART);
    const int lane = F.lane, w = F.wave, r32 = lane & 31, hi = lane >> 5;
    const float* shift_mix = F.in[9];
    const GAS unsigned* ubase = (const GAS unsigned*)(ub + m0 * INP + UR);
    const int prev0 = (c == 0) ? 0 : -(INP / 2);
    const int p = F.tid & 31, t16 = F.tid >> 5;
    unsigned gcl[10];
    { unsigned gpl[10];
        unsigned cl[8], pl[8];
#pragma unroll
        for (int n = 0; n < 8; ++n) { const int idx = F.tid + NT * n, t = idx >> 6, pp = idx & 63; const int ro = t * (INP / 2), rp = (t == 0) ? prev0 : ro - (INP / 2);
            cl[n] = ubase[ro + 1536 + pp]; pl[n] = ubase[rp + 1536 + pp]; }
        __builtin_amdgcn_sched_barrier(0);
#pragma unroll
        for (int n = 0; n < 8; ++n) { const int idx = F.tid + NT * n, t = idx >> 6, pp = idx & 63; const bool first = (c == 0 && t == 0);
            const unsigned cu_ = cl[n], pv_ = first ? 0u : pl[n];
            const float m0_ = shift_mix[3072 + 2 * pp], m1_ = shift_mix[3072 + 2 * pp + 1];
            float lo = bflo(cu_) + (bflo(pv_) - bflo(cu_)) * m0_, hi_ = bfhi(cu_) + (bfhi(pv_) - bfhi(cu_)) * m1_;
            if (pp < 32) { lo = 1.f - 2.f / (__expf(2.f * lo) + 1.f); hi_ = 1.f - 2.f / (__expf(2.f * hi_) + 1.f); *(LAS unsigned*)(L + ACT_WP + t * CP + pp * 4) = cvtpk(lo, hi_); }
            else *(LAS unsigned*)(L + ACT_AP + t * CP + (pp - 32) * 4) = cvtpk(lo, hi_); }
        __builtin_amdgcn_sched_barrier(0);
#pragma unroll
        for (int n = 0; n < 10; ++n) { const int idx = F.tid + NT * n, t = idx / 80, pp = idx - 80 * t; const int ro = t * (INP / 2), rp = (t == 0) ? prev0 : ro - (INP / 2);
            gcl[n] = ubase[ro + 1600 + pp]; gpl[n] = ubase[rp + 1600 + pp]; }
        __builtin_amdgcn_sched_barrier(0);
#pragma unroll
        for (int n = 0; n < 10; ++n) { const int idx = F.tid + NT * n, t = idx / 80, pp = idx - 80 * t; const bool first = (c == 0 && t == 0);
            const unsigned cu_ = gcl[n], pv_ = first ? 0u : gpl[n];
            const float m0_ = shift_mix[3200 + 2 * pp], m1_ = shift_mix[3200 + 2 * pp + 1];
            const float lo = bflo(cu_) + (bflo(pv_) - bflo(cu_)) * m0_, hi_ = bfhi(cu_) + (bfhi(pv_) - bfhi(cu_)) * m1_;
            gcl[n] = cvtpk(1.f / (1.f + __expf(-lo)), 1.f / (1.f + __expf(-hi_))); }
        __builtin_amdgcn_sched_barrier(0);
    }
    unsigned cu[4][3], pv[4][3];
#define RG_LOAD(hd) do { _Pragma("unroll") for (int pass = 0; pass < 4; ++pass) { const int t = t16 + 16 * pass; const int ro = t * (INP / 2), rp = (t == 0) ? prev0 : ro - (INP / 2); \
        _Pragma("unroll") for (int a = 0; a < 3; ++a) { const int co = (a * 1024 + (hd) * HD) / 2 + p; cu[pass][a] = ubase[ro + co]; pv[pass][a] = ubase[rp + co]; } } } while (0)
    RG_LOAD(8 * hh);
#pragma unroll 1
    for (int h8 = 0; h8 < 8; ++h8) {
    const int h = 8 * hh + h8, unit = (b * NH + h) * 64 + c;
    int tidv = F.tid; asm volatile("" : "+v"(tidv));
    const int lane = tidv & 63, r32 = lane & 31, hi = lane >> 5, p = tidv & 31, t16 = tidv >> 5;
    bf16* CH = (bf16*)(F.ws + WS_WGU + (size_t)unit * CH_UNIT);
    bf16* VG = (bf16*)(F.ws + WS_SCAN + (size_t)unit * VG_UNIT);
    {
        float mx[3][2];
#pragma unroll
        for (int a = 0; a < 3; ++a) { mx[a][0] = shift_mix[a * 1024 + h * HD + 2 * p]; mx[a][1] = shift_mix[a * 1024 + h * HD + 2 * p + 1]; }
#pragma unroll
        for (int pass = 0; pass < 4; ++pass) { const int t = t16 + 16 * pass; const bool first = (c == 0 && t == 0);
#pragma unroll
            for (int a = 0; a < 3; ++a) { const unsigned cu_ = cu[pass][a], pv_ = first ? 0u : pv[pass][a];
                const float lo = bflo(cu_) + (bflo(pv_) - bflo(cu_)) * mx[a][0], hi_ = bfhi(cu_) + (bfhi(pv_) - bfhi(cu_)) * mx[a][1];
                *(LAS unsigned*)(L + (a == 0 ? RAW_R : a == 1 ? RAW_K : RAW_V) * CMB + t * CP + p * 4) = cvtpk(lo, hi_); } }
#pragma unroll
        for (int n = 0; n < 10; ++n) { const int idx = tidv + NT * n, t = idx / 80, pp = idx - 80 * t; *(LAS unsigned*)(L + ACT_G * CMB + t * GPITCH + pp * 4) = gcl[n]; }
        for (int idx = tidv; idx < 64 * 16; idx += NT) *(LAS unsigned*)(L + ACT_G * CMB + (idx >> 4) * GPITCH + (80 + (idx & 15)) * 4) = 0u;
        if (h8 + 1 < 8) RG_LOAD(h + 1);
        LBAR();
    }
    {
        const int tile = w & 3, half = w >> 2, tr = tile >> 1, tc = tile & 1, t = 32 * tc + r32;
        const bf16* w2t = (const bf16*)(F.ws + WS_SMALL + SM_W2T); const bf16* a2t = (const bf16*)(F.ws + WS_SMALL + SM_A2T); const bf16* g2t = (const bf16*)(F.ws + WS_SMALL + SM_G2T);
        float a_[8], kq_[8];
        f32x16 accW = {}, accA = {}, accG = {};
#pragma unroll
        for (int ks = 0; ks < 4; ++ks) { const bf16x8 bw = *(const LAS bf16x8*)(L + ACT_WP + t * CP + (16 * ks + 8 * hi) * 2), ba = *(const LAS bf16x8*)(L + ACT_AP + t * CP + (16 * ks + 8 * hi) * 2);
            const bf16x8 aw = *(const GAS bf16x8*)(w2t + (h * HD + 32 * tr + r32) * 64 + 16 * ks + 8 * hi), aa = *(const GAS bf16x8*)(a2t + (h * HD + 32 * tr + r32) * 64 + 16 * ks + 8 * hi);
            accW = __builtin_amdgcn_mfma_f32_32x32x16_bf16(aw, bw, accW, 0, 0, 0); accA = __builtin_amdgcn_mfma_f32_32x32x16_bf16(aa, ba, accA, 0, 0, 0); }
        __builtin_amdgcn_sched_barrier(0);
#pragma unroll 2
        for (int ks = 0; ks < 12; ++ks) { const bf16x8 bg = *(const LAS bf16x8*)(L + ACT_G * CMB + t * GPITCH + (16 * ks + 8 * hi) * 2);
            const bf16x8 ag = *(const GAS bf16x8*)(g2t + (h * HD + 32 * tr + r32) * 192 + 16 * ks + 8 * hi);
            accG = __builtin_amdgcn_mfma_f32_32x32x16_bf16(ag, bg, accG, 0, 0, 0); }
        __builtin_amdgcn_sched_barrier(0);
        const float *w0 = F.in[10], *a0 = F.in[12], *k_k = F.in[15], *k_a = F.in[16], *r_k = F.in[17];
        float n2 = 0.f, bon = 0.f;
#pragma unroll
        for (int gq = 0; gq < 2; ++gq) { const int g = 2 * half + gq, jb = 32 * tr + 8 * g + 4 * hi;
            const v2u rw_ = *(const LAS v2u*)(L + RAW_R * CMB + t * CP + jb * 2), kw_ = *(const LAS v2u*)(L + RAW_K * CMB + t * CP + jb * 2);
            const float rr[4] = {bflo(rw_.x), bfhi(rw_.x), bflo(rw_.y), bfhi(rw_.y)}, kr[4] = {bflo(kw_.x), bfhi(kw_.x), bflo(kw_.y), bfhi(kw_.y)};
            const f32x4 w0v = *(const GAS f32x4*)(w0 + h * HD + jb), a0v = *(const GAS f32x4*)(a0 + h * HD + jb), kkv = *(const GAS f32x4*)(k_k + h * HD + jb), kav = *(const GAS f32x4*)(k_a + h * HD + jb), rkv = *(const GAS f32x4*)(r_k + h * HD + jb);
            float e4[4], kp4[4], g4[4];
#pragma unroll
            for (int i = 0; i < 4; ++i) { const float aW = half ? accW[8 + 4 * gq + i] : accW[4 * gq + i], aA = half ? accA[8 + 4 * gq + i] : accA[4 * gq + i]; g4[i] = half ? accG[8 + 4 * gq + i] : accG[4 * gq + i];
                const float a = 1.f / (1.f + __expf(-(a0v[i] + aA)));
                const float x = -(w0v[i] + aW); const float sp = fmaxf(x, 0.f) + __logf(1.f + __expf(-fabsf(x)));
                e4[i] = __expf(-sp - 0.5f);
                const float kq = kr[i] * kkv[i]; kp4[i] = kr[i] * (1.f + (a - 1.f) * kav[i]);
                n2 += kq * kq; bon += rr[i] * kp4[i] * rkv[i]; a_[4 * gq + i] = a; kq_[4 * gq + i] = kq; }
            v2u ew, kw2, gw2; ew.x = cvtpk(e4[0], e4[1]); ew.y = cvtpk(e4[2], e4[3]); kw2.x = cvtpk(kp4[0], kp4[1]); kw2.y = cvtpk(kp4[2], kp4[3]); gw2.x = cvtpk(g4[0], g4[1]); gw2.y = cvtpk(g4[2], g4[3]);
            *(LAS v2u*)(L + RAW_E * CMB + t * CP + jb * 2) = ew; *(LAS v2u*)(L + RAW_KP * CMB + t * CP + jb * 2) = kw2;
            *(GAS v2u*)(VG + VG_GG / 2 + (size_t)t * 64 + jb) = gw2; }
        n2 = swapsum(n2); bon = swapsum(bon);
        if (hi == 0) { part[(tr * 2 + half) * 64 + t] = n2; part[256 + (tr * 2 + half) * 64 + t] = bon; }
        LBAR();
        {
            const float n2t = (part[t] + part[64 + t]) + (part[128 + t] + part[192 + t]), bont = (part[256 + t] + part[320 + t]) + (part[384 + t] + part[448 + t]);
            const float inv = 1.f / fmaxf(sqrtf(n2t), 1e-12f);
            if (tr == 0 && half == 0 && hi == 0) ((float*)(F.ws + WS_BONUS))[(m0 + t) * NH + h] = bont;
#pragma unroll
            for (int gq = 0; gq < 2; ++gq) { const int g = 2 * half + gq, jb = 32 * tr + 8 * g + 4 * hi; float kk4[4], bb4[4];
#pragma unroll
                for (int i = 0; i < 4; ++i) { kk4[i] = kq_[4 * gq + i] * inv; bb4[i] = kk4[i] * a_[4 * gq + i]; }
                v2u kw_, bw_; kw_.x = cvtpk(kk4[0], kk4[1]); kw_.y = cvtpk(kk4[2], kk4[3]); bw_.x = cvtpk(bb4[0], bb4[1]); bw_.y = cvtpk(bb4[2], bb4[3]);
                *(LAS v2u*)(L + RAW_KK * CMB + t * CP + jb * 2) = kw_; *(LAS v2u*)(L + RAW_BB * CMB + t * CP + jb * 2) = bw_; }
        }
        LBAR();
    }
    {
        const int j = tidv & 63, tg = tidv >> 6;
        float r_[8], e_[8], kp_[8], v_[8], kk_[8], bb_[8];
#pragma unroll
        for (int i = 0; i < 8; ++i) { const int o = (8 * tg + i) * CP + j * 2;
            r_[i] = bf2f(*(const LAS bf16*)(L + RAW_R * CMB + o)); e_[i] = bf2f(*(const LAS bf16*)(L + RAW_E * CMB + o)); kp_[i] = bf2f(*(const LAS bf16*)(L + RAW_KP * CMB + o));
            v_[i] = bf2f(*(const LAS bf16*)(L + RAW_V * CMB + o)); kk_[i] = bf2f(*(const LAS bf16*)(L + RAW_KK * CMB + o)); bb_[i] = bf2f(*(const LAS bf16*)(L + RAW_BB * CMB + o)); }
        float cs[8]; cs[0] = e_[0];
#pragma unroll
        for (int i = 1; i < 8; ++i) cs[i] = cs[i - 1] + e_[i];
        totals[tg * 64 + j] = cs[7];
        LBAR();
        float pre = 0.f, tot = 0.f;
#pragma unroll
        for (int g = 0; g < 8; ++g) { const float t_ = totals[g * 64 + j]; tot += t_; if (g < tg) pre += t_; }
        if (tg == 0) gend[j] = __expf(-tot);
#pragma unroll
        for (int i = 0; i < 8; ++i) { const int t = 8 * tg + i; const float ct = pre + cs[i];
            const float Gt = __expf(-ct), Gp = __expf(-(ct - e_[i])), iG = __expf(ct), gE = __expf(ct - tot);
            const int o = t * CP + j * 2;
            *(LAS bf16*)(L + C_AT * CMB + o) = (bf16)f2bf(-kk_[i] * Gp);
            *(LAS bf16*)(L + C_BT * CMB + o) = (bf16)f2bf(bb_[i] * iG);
            *(LAS bf16*)(L + C_KT * CMB + o) = (bf16)f2bf(kp_[i] * iG);
            *(LAS bf16*)(L + C_RT * CMB + o) = (bf16)f2bf(r_[i] * Gt);
            *(LAS bf16*)(L + C_BP * CMB + o) = (bf16)f2bf(bb_[i] * gE);
            *(LAS bf16*)(L + C_KP * CMB + o) = (bf16)f2bf(kp_[i] * gE);
            *(LAS bf16*)(L + C_VV * CMB + o) = (bf16)f2bf(v_[i]);
            *(LAS bf16*)(L + C_X0 * CMB + o) = (t == j) ? (bf16)0x3f80 : (bf16)0;
            VG[VG_VS / 2 + t * 64 + j] = (bf16)f2bf(v_[i]); }
        LBAR();
    }
    {
        const int p = w >> 1, tr = w & 1;
        const LAS unsigned char* A = L + ((p & 1) ? C_KT : C_BT) * CMB; const LAS unsigned char* B = L + ((p >> 1) ? C_RT : C_AT) * CMB;
        LAS unsigned char* Z = L + (p == 0 ? C_Q0 : p == 1 ? C_AK : p == 2 ? C_BR : C_KR) * CMB;
#pragma unroll
        for (int tc = 0; tc < 2; ++tc) { f32x16 acc = {};
            if (tr <= tc) { acc = tile_mm<false, false>(A, 32 * tr, B, 32 * tc, acc, lane);
#pragma unroll
                for (int r = 0; r < 16; ++r) { const int s_ = 32 * tr + crow(r, hi), t_ = 32 * tc + r32; const bool keep = (p < 2) ? (s_ < t_) : (s_ <= t_); acc[r] = keep ? acc[r] : 0.f; } }
            tile_store_lds(Z, 32 * tr, 32 * tc, acc, lane); }
        LBAR();
    }
    {
        const int tr = (w >> 1) & 1, tc = w & 1; f32x16 xacc = {};
        if (w < 4 && tr == tc) {
#pragma unroll
            for (int r = 0; r < 16; ++r) xacc[r] = (crow(r, hi) == r32) ? 1.f : 0.f; }
#pragma unroll 1
        for (int k = 0; k < 6; ++k) {
            const LAS unsigned char* Xc = L + ((k & 1) ? C_X1 : C_X0) * CMB; const LAS unsigned char* Qc = L + ((k & 1) ? C_Q1 : C_Q0) * CMB;
            LAS unsigned char* Xn = L + ((k & 1) ? C_X0 : C_X1) * CMB; LAS unsigned char* Qn = L + ((k & 1) ? C_Q0 : C_Q1) * CMB;
            if (w < 4) { if (tr <= tc) xacc = tile_mm<false, true>(Xc, 32 * tr, Qc, 32 * tc, xacc, lane);
                tile_store_lds(Xn, 32 * tr, 32 * tc, xacc, lane); }
            else if (k < 5) { f32x16 q = {}; if (tr <= tc) q = tile_mm<false, true>(Qc, 32 * tr, Qc, 32 * tc, q, lane);
                tile_store_lds(Qn, 32 * tr, 32 * tc, q, lane); }
            LBAR();
        }
    }
    {
        const int tr = (w >> 1) & 1, tc = w & 1; f32x16 acc = {};
        if (w < 4) { acc = tile_mm<true, true>(L + C_AT * CMB, 32 * tr, L + C_X0 * CMB, 32 * tc, acc, lane); tile_store_lds(L + C_BT * CMB, 32 * tr, 32 * tc, acc, lane); }
        else { if (tr <= tc) acc = tile_mm<false, true>(L + C_AK * CMB, 32 * tr, L + C_X0 * CMB, 32 * tc, acc, lane); tile_store_lds(L + C_KT * CMB, 32 * tr, 32 * tc, acc, lane); }
        LBAR();
    }
    {
        const int p = w >> 1, tr = w & 1;
        const LAS unsigned char* A = L + ((p & 1) ? C_KT : C_BT) * CMB; const LAS unsigned char* B = L + ((p >> 1) ? C_BR : C_BP) * CMB;
#pragma unroll
        for (int tc = 0; tc < 2; ++tc) { f32x16 acc = {};
            acc = tile_mm<false, true>(A, 32 * tr, B, 32 * tc, acc, lane);
            if (p == 0) {
#pragma unroll
                for (int r = 0; r < 16; ++r) if (32 * tr + crow(r, hi) == 32 * tc + r32) acc[r] += gend[32 * tc + r32];
                tile_store_glb_t(CH + CH_TT / 2, 32 * tr, 32 * tc, acc, lane);
            } else if (p == 1) {
#pragma unroll
                for (int r = 0; r < 16; ++r) acc[r] += bf2f(*(const LAS bf16*)(L + C_KP * CMB + (32 * tr + crow(r, hi)) * CP + (32 * tc + r32) * 2));
                tile_store_lds(L + C_Q0 * CMB, 32 * tr, 32 * tc, acc, lane);
            } else if (p == 2) {
#pragma unroll
                for (int g = 0; g < 4; ++g) { const v2u rw_ = *(const LAS v2u*)(L + C_RT * CMB + (32 * tc + r32) * CP + (32 * tr + 8 * g + 4 * hi) * 2);
                    acc[4 * g] += bflo(rw_.x); acc[4 * g + 1] += bfhi(rw_.x); acc[4 * g + 2] += bflo(rw_.y); acc[4 * g + 3] += bfhi(rw_.y); }
                tile_store_glb_t(CH + CH_PT / 2, 32 * tr, 32 * tc, acc, lane);
            } else {
#pragma unroll
                for (int r = 0; r < 16; ++r) acc[r] += bf2f(*(const LAS bf16*)(L + C_KR * CMB + (32 * tr + crow(r, hi)) * CP + (32 * tc + r32) * 2));
                tile_store_lds(L + C_Q1 * CMB, 32 * tr, 32 * tc, acc, lane);
            } }
        LBAR();
    }
    {
        const int tr = (w >> 1) & 1, tc = w & 1; f32x16 acc = {};
        acc = tile_mm<true, true>(L + C_VV * CMB, 32 * tr, L + ((w < 4) ? C_Q0 : C_Q1) * CMB, 32 * tc, acc, lane);
        tile_store_glb_t(CH + ((w < 4) ? CH_HT : CH_YV) / 2, 32 * tr, 32 * tc, acc, lane);
        LBAR();
    }
    }
#undef RG_LOAD
}
constexpr int CS_DATA = 2 * CMB, CS_DSZ = 6 * CMB, CS_GPART = CS_DATA + 2 * CS_DSZ;
static_assert(CS_GPART + 2048 <= RING_BYTES, "chunk scan LDS");
__device__ __forceinline__ void chunk_scan(Frame& F, int bh) {
    const int b = bh >> 4, h = bh & 15;
    LAS unsigned char* L = F.lds;
    bf16* mix = (bf16*)(F.ws + WS_MIX);
    const int lane = F.lane, w = F.wave, r32 = lane & 31, hi = lane >> 5;
    const int tr = (w >> 1) & 1, tc = w & 1; const bool isS = w < 4;
    for (int i = F.tid; i < 2 * CMB / 4; i += NT) ((LAS unsigned*)L)[i] = 0u;
    LAS float* gpart = (LAS float*)(L + CS_GPART);
    const unsigned char* CHb = F.ws + WS_WGU + (size_t)(bh * 64) * CH_UNIT + (size_t)(F.tid >> 3) * 128 + (F.tid & 7) * 16;
    const unsigned char* VGb = F.ws + WS_SCAN + (size_t)(bh * 64) * VG_UNIT + (size_t)(F.tid >> 3) * 128 + (F.tid & 7) * 16;
    const int ldst = (F.tid >> 3) * CP + (F.tid & 7) * 16;
    const float* bonus = (const float*)(F.ws + WS_BONUS) + ((size_t)b * SEQ + 32 * tc + r32) * NH + h;
    f32x4 gng[4], gnb[4];
#pragma unroll
    for (int g = 0; g < 4; ++g) { gng[g] = *(const GAS f32x4*)(F.in[18] + h * HD + 32 * tr + 8 * g + 4 * hi); gnb[g] = *(const GAS f32x4*)(F.in[19] + h * HD + 32 * tr + 8 * g + 4 * hi); }
    v4u pre[6];
#define CS_LOAD(cc) do { _Pragma("unroll") for (int k = 0; k < 4; ++k) pre[k] = *(const GAS v4u*)(CHb + (size_t)(cc) * CH_UNIT + k * 8192); \
        pre[4] = *(const GAS v4u*)(VGb + (size_t)(cc) * VG_UNIT); pre[5] = *(const GAS v4u*)(VGb + (size_t)(cc) * VG_UNIT + 8192); } while (0)
#define CS_WRITE(buf) do { _Pragma("unroll") for (int k = 0; k < 6; ++k) *(LAS v4u*)(L + CS_DATA + (buf) * CS_DSZ + k * CMB + ldst) = pre[k]; } while (0)
    CS_LOAD(0); CS_WRITE(0); CS_LOAD(1);
    __syncthreads();
#pragma unroll 1
    for (int c = 0; c < 64; ++c) {
        const LAS unsigned char* Sc = L + (c & 1) * CMB; LAS unsigned char* Sn = L + ((c & 1) ^ 1) * CMB;
        const LAS unsigned char* D = L + CS_DATA + (c & 1) * CS_DSZ;
        if (c + 1 < 64) CS_WRITE((c + 1) & 1);
        if (c + 2 < 64) CS_LOAD(c + 2);
        const float bon = isS ? 0.f : bonus[(size_t)c * 64 * NH];
        const LAS unsigned char* Bm = D + (isS ? 0 : 1) * CMB + (32 * tc + r32) * CP + 8 * hi * 2;
        const LAS unsigned char* Cm = D + (isS ? 2 : 3) * CMB + (32 * tc + r32) * CP + (32 * tr + 4 * hi) * 2;
        f32x16 acc;
#pragma unroll
        for (int g = 0; g < 4; ++g) { const v2u ci = *(const LAS v2u*)(Cm + 16 * g); acc[4 * g] = bflo(ci.x); acc[4 * g + 1] = bfhi(ci.x); acc[4 * g + 2] = bflo(ci.y); acc[4 * g + 3] = bfhi(ci.y); }
#pragma unroll
        for (int ks = 0; ks < 4; ++ks) acc = __builtin_amdgcn_mfma_f32_32x32x16_bf16(trfrag(Sc, 16 * ks, 32 * tr, lane), *(const LAS bf16x8*)(Bm + 32 * ks), acc, 0, 0, 0);
        LAS float* gp = gpart + (c & 1) * 256;
        v2u vv[4], gg[4];
        if (isS) {
#pragma unroll
            for (int g = 0; g < 4; ++g) { v2u o; o.x = pk2(acc[4 * g], acc[4 * g + 1]); o.y = pk2(acc[4 * g + 2], acc[4 * g + 3]);
                *(LAS v2u*)(Sn + (32 * tc + r32) * CP + (32 * tr + 8 * g + 4 * hi) * 2) = o; }
        } else {
            float s1 = 0.f, s2 = 0.f;
#pragma unroll
            for (int r = 0; r < 16; ++r) { s1 += acc[r]; s2 += acc[r] * acc[r]; }
            s1 = swapsum(s1); s2 = swapsum(s2);
            if (hi == 0) { gp[(tr * 2 + tc) * 32 + r32] = s1; gp[128 + (tr * 2 + tc) * 32 + r32] = s2; }
#pragma unroll
            for (int g = 0; g < 4; ++g) { vv[g] = *(const LAS v2u*)(D + 4 * CMB + (32 * tc + r32) * CP + (32 * tr + 8 * g + 4 * hi) * 2); gg[g] = *(const LAS v2u*)(D + 5 * CMB + (32 * tc + r32) * CP + (32 * tr + 8 * g + 4 * hi) * 2); }
        }
        asm volatile("s_waitcnt lgkmcnt(0)" ::: "memory"); __builtin_amdgcn_s_barrier(); asm volatile("" ::: "memory");
        if (!isS) {
            const float t1 = gp[tc * 32 + r32] + gp[(2 + tc) * 32 + r32], t2 = gp[128 + tc * 32 + r32] + gp[128 + (2 + tc) * 32 + r32];
            const float mu = t1 * (1.f / HD); const float rstd = __builtin_amdgcn_rsqf(fmaxf(t2 * (1.f / HD) - mu * mu, 0.f) + GN_EPS);
            bf16* mp = mix + ((size_t)b * SEQ + (size_t)c * 64 + 32 * tc + r32) * DM + AW + h * HD + 32 * tr + 4 * hi;
#pragma unroll
            for (int g = 0; g < 4; ++g) {
                const float v0 = bflo(vv[g].x), v1 = bfhi(vv[g].x), v2 = bflo(vv[g].y), v3 = bfhi(vv[g].y), g0 = bflo(gg[g].x), g1 = bfhi(gg[g].x), g2 = bflo(gg[g].y), g3 = bfhi(gg[g].y);
                const float o0 = ((acc[4 * g] - mu) * rstd * gng[g][0] + gnb[g][0] + bon * v0) * g0, o1 = ((acc[4 * g + 1] - mu) * rstd * gng[g][1] + gnb[g][1] + bon * v1) * g1;
                const float o2 = ((acc[4 * g + 2] - mu) * rstd * gng[g][2] + gnb[g][2] + bon * v2) * g2, o3 = ((acc[4 * g + 3] - mu) * rstd * gng[g][3] + gnb[g][3] + bon * v3) * g3;
                v2u o; o.x = cvtpk(o0, o1); o.y = cvtpk(o2, o3); *(GAS v2u*)(mp + 8 * g) = o; }
        }
    }
    __syncthreads();
#undef CS_LOAD
#undef CS_WRITE
}
__device__ __forceinline__ void rw_finalize(Frame& F) {
    const int gw = F.bid * NWAVES + F.wave, NGW = F.G * NWAVES;
    const float* Y = (const float*)(F.ws + WS_XB); const bf16* VGb = (const bf16*)(F.ws + WS_SCAN);
    const float* bonus = (const float*)(F.ws + WS_BONUS); bf16* mix = (bf16*)(F.ws + WS_MIX);
    const float *gn_g = F.in[18], *gn_b = F.in[19];
    for (int m = gw; m < M; m += NGW) { const int b = m / SEQ, ts = m % SEQ;
        for (int h = 0; h < NH; ++h) { const int c = h * HD + F.lane; const size_t o = (size_t)m * RW + c;
            const bf16* vg = VGb + ((size_t)((b * NH + h) * 64 + (ts >> 6)) * VG_UNIT) / 2 + (ts & 63) * 64 + F.lane;
            const float y = Y[o]; const float mu = wave_sum(y) * (1.f / HD); const float d = y - mu; const float var = wave_sum(d * d) * (1.f / HD);
            const float yn = d * (1.f / sqrtf(var + GN_EPS)) * gn_g[c] + gn_b[c];
            const float val = (yn + bonus[(size_t)m * NH + h] * bf2f(vg[VG_VS / 2])) * bf2f(vg[VG_GG / 2]);
            mix[(size_t)m * DM + AW + c] = (bf16)f2bf(val); }
    }
}

constexpr int AT_K = 0, AT_V = 16384, AT_WS = 32768, AT_GATE = 34816, AT_TAB = 51200, AT_OST = 52224, AT_BYTES = AT_OST + 8 * 4096;
__device__ __forceinline__ int rel_bucket_i(int d) {
    if (d < 16) return d;
    return 16 + (d >= 19) + (d >= 21) + (d >= 24) + (d >= 27) + (d >= 31) + (d >= 35) + (d >= 40) + (d >= 46) + (d >= 52) + (d >= 59) + (d >= 67) + (d >= 77) + (d >= 87) + (d >= 99) + (d >= 113);
}

__device__ __forceinline__ void attn_unit(Frame& F, int b, int h, int qb) {
    const bf16* ub = (const bf16*)(F.ws + WS_BIG); const bf16* km = (const bf16*)(F.ws + WS_SMALL + SM_KMEAN); bf16* mix = (bf16*)(F.ws + WS_MIX);
    const float* rel_bias = F.in[8];
    LAS unsigned char* L = F.lds;
    const int lane = F.lane, wid = F.wave, r32 = lane & 31, hi = lane >> 5;
    const size_t mb = (size_t)b * SEQ;
    const int q0 = qb * 256;
    LAS float* tab = (LAS float*)(L + AT_TAB);
    LAS float* wsf = (LAS float*)(L + AT_WS) + wid * 64;
    constexpr float C2 = 0.125f * LOG2E;
    if (F.tid < 129) tab[F.tid] = rel_bias[rel_bucket_i(F.tid) * NH + h] * LOG2E;
    bf16x8 qr[4];
    { const bf16* Qw = ub + (mb + q0 + wid * 32 + r32) * INP + UQ + h * HD;
#pragma unroll
      for (int d0 = 0; d0 < 4; ++d0) qr[d0] = *(const GAS bf16x8*)(Qw + d0 * 16 + hi * 8); }
    unsigned sel = 0u;
    if (qb > 0) {
        f32x16 g = {};
        const bf16* kmp = km + ((size_t)(b * NH + h) * 16 + (r32 & 15)) * HD;
#pragma unroll
        for (int d0 = 0; d0 < 4; ++d0) { const bf16x8 kf = *(const GAS bf16x8*)(kmp + d0 * 16 + hi * 8); g = __builtin_amdgcn_mfma_f32_32x32x16_bf16(kf, qr[d0], g, 0, 0, 0); }
        LAS float* gs = (LAS float*)(L + AT_GATE) + wid * 512;
#pragma unroll
        for (int r = 0; r < 8; ++r) gs[r32 * 16 + crow(r, hi)] = g[r];
        LDS_WAIT(); asm volatile("" ::: "memory");
        float gv[16];
#pragma unroll
        for (int i = 0; i < 4; ++i) { const f32x4 t = *(const LAS f32x4*)(gs + r32 * 16 + 4 * i); gv[4 * i] = t[0]; gv[4 * i + 1] = t[1]; gv[4 * i + 2] = t[2]; gv[4 * i + 3] = t[3]; }
#pragma unroll
        for (int pass = 0; pass < 3; ++pass) { float best = -INFINITY; int bi = -1;
#pragma unroll
            for (int n = 0; n < 16; ++n) { const bool ok = (n < qb) && !((sel >> n) & 1u) && (gv[n] > best); if (ok) { best = gv[n]; bi = n; } }
            if (bi >= 0) sel |= 1u << bi; }
    }
    const bf16* ksrc = ub + (mb + lane) * INP + UK + h * HD + wid * 8;
    const bf16* vsrc = ub + (mb + 16 * (wid & 3) + (lane >> 2)) * INP + UV + h * HD + (wid >> 2) * 32 + (lane & 3) * 8;
    const int stoff = wid * 1024 + lane * 16;
    const int NTILE = 4 * (qb + 1);
    v4u kreg, vreg;
    kreg = *(const GAS v4u*)(ksrc); vreg = *(const GAS v4u*)(vsrc);
    __syncthreads();
    *(LAS v4u*)(L + AT_K + stoff) = kreg; *(LAS v4u*)(L + AT_V + stoff) = vreg;
    __syncthreads();
    float mrun = -INFINITY, lrun = 0.f; f32x16 o[2]; o[0] = f32x16{}; o[1] = f32x16{};
    const float c31 = tab[128];
    for (int jt = 0; jt < NTILE; ++jt) {
        const int cur = jt & 1;
        if (jt + 1 < NTILE) { kreg = *(const GAS v4u*)(ksrc + (size_t)(jt + 1) * 64 * INP); vreg = *(const GAS v4u*)(vsrc + (size_t)(jt + 1) * 64 * INP); }
        const int n = jt >> 2;
        const int dbase = 256 * (qb - n) + 32 * wid - 64 * (jt & 3);
        const bool lane_ok = (n == qb) || ((sel >> n) & 1u);
        const bool wave_live = (dbase + 31 >= 0) && __any(lane_ok);
        if (wave_live) {
            f32x16 p0 = {}, p1 = {};
            const LAS unsigned char* kb = L + AT_K + cur * 8192 + hi * 1024 + r32 * 16;
#pragma unroll
            for (int d0 = 0; d0 < 4; ++d0) { const bf16x8 b0 = *(const LAS bf16x8*)(kb + d0 * 2048); const bf16x8 b1 = *(const LAS bf16x8*)(kb + d0 * 2048 + 512);
                p0 = __builtin_amdgcn_mfma_f32_32x32x16_bf16(b0, qr[d0], p0, 0, 0, 0); p1 = __builtin_amdgcn_mfma_f32_32x32x16_bf16(b1, qr[d0], p1, 0, 0, 0); }
            const bool far = (dbase - 63 >= 128);
            const int dl = dbase + r32;
            constexpr float THR = 8.f;
            float rm;
            if (far) {
                float a = fmaxf(p0[0], p1[0]), bq = fmaxf(p0[1], p1[1]);
#pragma unroll
                for (int r = 2; r < 16; r += 2) { a = fmaxf(a, fmaxf(p0[r], p1[r])); bq = fmaxf(bq, fmaxf(p0[r + 1], p1[r + 1])); }
                rm = lane_ok ? fmaxf(a, bq) * C2 + c31 : -INFINITY;
            } else {
#pragma unroll
                for (int r = 0; r < 16; ++r) { const int d0_ = dl - crow(r, hi), d1_ = d0_ - 32;
                    const float b0 = tab[min(max(d0_, 0), 128)], b1 = tab[min(max(d1_, 0), 128)];
                    p0[r] = (lane_ok && d0_ >= 0) ? p0[r] * C2 + b0 : -INFINITY; p1[r] = (lane_ok && d1_ >= 0) ? p1[r] * C2 + b1 : -INFINITY; }
                rm = fmaxf(p0[0], p1[0]);
#pragma unroll
                for (int r = 1; r < 16; ++r) rm = fmaxf(rm, fmaxf(p0[r], p1[r]));
            }
            rm = swapmax(rm);
            if (__any(rm > mrun + THR)) {
                const float mnew = fmaxf(mrun, rm);
                const float ms = (mnew == -INFINITY) ? 0.f : mnew;
                const float alpha = __builtin_amdgcn_exp2f(mrun - ms);
                mrun = mnew; lrun *= alpha;
                if (hi == 0) wsf[r32] = alpha;
                LDS_WAIT(); asm volatile("" ::: "memory");
#pragma unroll
                for (int r = 0; r < 16; ++r) { const float f = wsf[crow(r, hi)]; o[0][r] *= f; o[1][r] *= f; }
                asm volatile("" ::: "memory");
            }
            const float msafe = (mrun == -INFINITY) ? 0.f : mrun;
            float ps = 0.f;
            if (far) { const float ad = lane_ok ? (c31 - msafe) : -INFINITY;
#pragma unroll
                for (int r = 0; r < 16; ++r) { p0[r] = __builtin_amdgcn_exp2f(p0[r] * C2 + ad); p1[r] = __builtin_amdgcn_exp2f(p1[r] * C2 + ad); ps += p0[r] + p1[r]; }
            } else {
#pragma unroll
                for (int r = 0; r < 16; ++r) { p0[r] = __builtin_amdgcn_exp2f(p0[r] - msafe); p1[r] = __builtin_amdgcn_exp2f(p1[r] - msafe); ps += p0[r] + p1[r]; }
            }
            lrun += ps;
            v4u pw[4];
            pw[0] = (v4u){cvtpk(p0[0], p0[1]), cvtpk(p0[2], p0[3]), cvtpk(p0[4], p0[5]), cvtpk(p0[6], p0[7])};
            pw[1] = (v4u){cvtpk(p0[8], p0[9]), cvtpk(p0[10], p0[11]), cvtpk(p0[12], p0[13]), cvtpk(p0[14], p0[15])};
            pw[2] = (v4u){cvtpk(p1[0], p1[1]), cvtpk(p1[2], p1[3]), cvtpk(p1[4], p1[5]), cvtpk(p1[6], p1[7])};
            pw[3] = (v4u){cvtpk(p1[8], p1[9]), cvtpk(p1[10], p1[11]), cvtpk(p1[12], p1[13]), cvtpk(p1[14], p1[15])};
            const LAS unsigned char* vb = L + AT_V + cur * 8192 + ((lane >> 4) & 1) * 32 + (lane & 3) * 8 + (4 * hi + ((lane & 15) >> 2)) * 64;
#pragma unroll
            for (int d0 = 0; d0 < 2; ++d0)
#pragma unroll
                for (int ks = 0; ks < 4; ++ks) { const s16x4 lo = vtr(vb + d0 * 4096 + ks * 1024), hh = vtr(vb + d0 * 4096 + ks * 1024 + 512);
                    const bf16x8 vf = (bf16x8){lo[0], lo[1], lo[2], lo[3], hh[0], hh[1], hh[2], hh[3]};
                    o[d0] = __builtin_amdgcn_mfma_f32_32x32x16_bf16(__builtin_bit_cast(bf16x8, pw[ks]), vf, o[d0], 0, 0, 0); }
        }
        if (jt + 1 < NTILE) { *(LAS v4u*)(L + AT_K + (cur ^ 1) * 8192 + stoff) = kreg; *(LAS v4u*)(L + AT_V + (cur ^ 1) * 8192 + stoff) = vreg; }
        __syncthreads();
    }
    lrun = swapsum(lrun);
    if (hi == 0) wsf[32 + r32] = lrun;
    LDS_WAIT(); asm volatile("" ::: "memory");
    LAS bf16* stg = (LAS bf16*)(L + AT_OST) + wid * 2048;
#pragma unroll
    for (int r = 0; r < 16; ++r) { const int orow = crow(r, hi); const float rl = 1.f / wsf[32 + orow];
        stg[orow * 64 + r32] = (bf16)f2bf(o[0][r] * rl); stg[orow * 64 + 32 + r32] = (bf16)f2bf(o[1][r] * rl); }
    LDS_WAIT(); asm volatile("" ::: "memory");
    bf16* Ow = mix + (mb + q0 + wid * 32) * DM + h * HD;
#pragma unroll
    for (int i = 0; i < 4; ++i) { const int row = i * 8 + (lane >> 3), ch = lane & 7; const v4u v = *(const LAS v4u*)(stg + row * 64 + ch * 8); *(GAS v4u*)(Ow + (size_t)row * DM + ch * 8) = v; }
}

__device__ __forceinline__ void attn_queue(Frame& F, unsigned* head) {
    volatile LAS unsigned* slot = (volatile LAS unsigned*)(F.lds + MISC_OFF + 64);
    for (;;) {
        __syncthreads();
        if (F.tid == 0) *slot = __hip_atomic_fetch_add(head, 1u, __ATOMIC_RELAXED, __HIP_MEMORY_SCOPE_AGENT);
        __syncthreads();
        const unsigned u = *slot;
        if (u >= 512u) break;
        const int bh = (int)(u & 31u), qb = 15 - (int)(u >> 5);
        attn_unit(F, bh >> 4, bh & 15, qb);
    }
}

#ifndef REP_PHASE
#define REP_PHASE -1
#endif
#ifndef REP_EXTRA
#define REP_EXTRA 1
#endif
#ifndef MK_PER_PHASE
#define MK_PER_PHASE 0
#endif
constexpr int NPHASE = 11;
__global__ void __launch_bounds__(NT, 2) hymba_fwd(Args args) {
    extern __shared__ __attribute__((aligned(16))) unsigned char lds[];
    Frame F;
    F.lds = (LAS unsigned char*)lds;
    F.tid = threadIdx.x; F.lane = F.tid & 63; F.wave = __builtin_amdgcn_readfirstlane(F.tid >> 6);
    F.G = gridDim.x; F.bid = blockIdx.x; F.in = args.in; F.hz = args.out; F.ws = args.ws;
    volatile LAS unsigned* MISC = (volatile LAS unsigned*)(F.lds + MISC_OFF);
    for (int u = F.tid; u < (LDS_BYTES - LDSCTL_OFF) / 4; u += NT) ((LAS unsigned*)(F.lds + LDSCTL_OFF))[u] = 0u;
    __syncthreads();
    gu32* ctl = (gu32*)(F.ws + WS_CTL);
    XcdBarrier bar; bar.bar = (unsigned*)(ctl + CW_BAR); bar.x = 0; bar.st = nullptr;
    if (!MK_PER_PHASE) bar = xcd_barrier_post((unsigned*)(ctl + CW_BAR), MISC + 8);
    const int lo = args.ph_lo, hi = args.ph_hi;
#define IN(k) (lo <= (k) && (k) < hi)
#define SEAM(k) do { if (IN(k) && IN((k) + 1)) xcd_barrier(bar); } while (0)
    bf16* const Wgu = (bf16*)(F.ws + WS_WGU); bf16* const Wd = (bf16*)(F.ws + WS_WD); bf16* const Win = (bf16*)(F.ws + WS_WIN); bf16* const Wout = (bf16*)(F.ws + WS_WOUT);
    bf16* const Wgu2 = (bf16*)(F.ws + WS_F2); bf16* const Wd2 = (bf16*)(F.ws + WS_F2 + 44 * MiB);
    bf16* const Wpg = (bf16*)(F.ws + WS_WPG); bf16* const Wpu = (bf16*)(F.ws + WS_WPU);
    bf16* const XB = (bf16*)(F.ws + WS_XB); bf16* const BIG = (bf16*)(F.ws + WS_BIG); bf16* const MIX = (bf16*)(F.ws + WS_MIX); bf16* const EB = (bf16*)(F.ws + WS_SCAN); bf16* const PB = (bf16*)(F.ws + WS_PB);

    float* const stats1 = (float*)(F.ws + WS_STATS); float* const stats2 = stats1 + 2 * M; float* const stats3 = stats2 + 2 * M;
    float* const gb1 = (float*)(F.ws + WS_GB); float* const gb2 = gb1 + 2 * DM;
    float* const c1_in = (float*)(F.ws + WS_CVEC); float* const c2_in = c1_in + INP; float* const c1_gu = c2_in + INP; float* const c2_gu = c1_gu + NGU; float* const c1_pg = c2_gu + NGU; float* const c2_pg = c1_pg + DM;
    if (IN(0)) {
        int base = 0;
        ffn_weights<false>(F, 2, 3, 4, Wgu, Wd, base);
        transpose_job<true>(F, F.in[7], DM, DM, INC, Win, DM, 0, base, F.in[5], F.in[6], c1_in, c2_in);
        transpose_job<false>(F, F.in[20], DM, DM, DM, Wout, DM, 0, base);
        transpose_job<true>(F, F.in[29], DM, DM, DM, Wpg, DM, 0, base, F.in[26], F.in[27], c1_pg, c2_pg);
        transpose_job<false>(F, F.in[28], PLE, PLE, DM, Wpu, PLE, 0, base);
        transpose_job<false>(F, F.in[11], 64, 64, RW, (bf16*)(F.ws + WS_SMALL + SM_W2T), 64, 0, base);
        transpose_job<false>(F, F.in[13], 64, 64, RW, (bf16*)(F.ws + WS_SMALL + SM_A2T), 64, 0, base);
        transpose_job<false>(F, F.in[14], 160, 192, RW, (bf16*)(F.ws + WS_SMALL + SM_G2T), 192, 0, base);
        convert_bf16(F, F.in[0], XB, (size_t)M * DM);
        convert_bf16(F, F.in[1], PB, (size_t)M * PLE);
        if (F.bid == 0) for (int i = F.tid; i < DM; i += NT) { gb1[i] = F.in[5][i]; gb1[DM + i] = F.in[6][i]; gb2[i] = F.in[21][i]; gb2[DM + i] = F.in[22][i]; }
    }
    SEAM(0);
    if (IN(1)) { pg8::Gemm g{XB, Wgu, M, NGU, DM}; pg8::StaticOrder S; S.init(M, NGU, F.G, F.bid); pg8::EpiSwiGLU E{BIG, DFF};
        pg8::gemm_phase<pg8::EpiSwiGLU, pg8::StaticOrder, true, true>(F.lds, g, S, E);
        { const int nwg = (M / 256) * (NGU / 256), rem = nwg % F.G; int base = 0;
          if (rem == 0) ffn_weights<true>(F, 23, 24, 25, Wgu2, Wd2, base, F.in[21], F.in[22], c1_gu, c2_gu);
          else if (F.bid >= rem) ffn_weights<true>(F, 23, 24, 25, Wgu2, Wd2, base, F.in[21], F.in[22], c1_gu, c2_gu, (F.bid - rem) * NWAVES + F.wave, (F.G - rem) * NWAVES); } }
    SEAM(1);
    if (IN(2)) { pg8::Gemm g{BIG, Wd, M, DM, DFF}; pg8::StaticOrder S; S.init(M, DM, F.G, F.bid);
        pg8::EpiResidLN<false> E{F.in[0], F.hz, XB, DM, ALPHA, 0.5f, pg8::RowStats{nullptr, 0.f, 0.f}, nullptr, nullptr, stats1};
        pg8::gemm_phase<pg8::EpiResidLN<false>, pg8::StaticOrder, true, true>(F.lds, g, S, E); }
    SEAM(2);
#ifndef DUP3
#define DUP3 1
#endif
#ifndef DUP7
#define DUP7 1
#endif
    if (IN(3))
#pragma unroll 1
    for (int rep3_ = 0; rep3_ < DUP3; ++rep3_) { pg8::Gemm g{XB, Win, M, INP, DM}; pg8::StaticOrder S; S.init(M, INP, F.G, F.bid); pg8::EpiBf16LN E{BIG, INP, pg8::RowStats{stats1, 1.f / DM, LN_EPS}, c1_in, c2_in};
        pg8::gemm_phase<pg8::EpiBf16LN, pg8::StaticOrder, true, true>(F.lds, g, S, E); }
    SEAM(3);
    if (IN(4)) { kmean_tasks(F); __syncthreads(); for (int g = F.bid; g < BATCH * 64 * 2; g += F.G) rwkv_group(F, g); }
    SEAM(4);
    if (IN(5)) {
#ifndef DUPSCAN
#define DUPSCAN 1
#endif
#pragma unroll 1
        for (int rep_ = 0; rep_ < DUPSCAN; ++rep_) for (int t = F.bid; t < BATCH * NH; t += F.G) chunk_scan(F, t);
        attn_queue(F, (unsigned*)(ctl + CW_QUEUE));
    }
    SEAM(5);
    if (IN(6)) { { pg8::Gemm g{MIX, Wout, M, DM, DM}; pg8::StaticOrder S; S.init(M, DM, F.G, F.bid);
          pg8::EpiResidLNip E{F.hz, XB, stats1, gb1, DM, M, ALPHA, 1.0f, 1.f / DM, LN_EPS};
          pg8::gemm_phase<pg8::EpiResidLNip, pg8::StaticOrder, true, true>(F.lds, g, S, E); }
        { pg8::Gemm g{PB, Wpu, M, DM, PLE}; pg8::StaticOrder S; S.init(M, DM, F.G, F.bid); pg8::EpiBf16<0> E{EB, DM, nullptr, 0, 0, 1.f};
          pg8::gemm_phase<pg8::EpiBf16<0>, pg8::StaticOrder, true, true>(F.lds, g, S, E); } }
    SEAM(6);
    if (IN(7))
#pragma unroll 1
    for (int rep7_ = 0; rep7_ < DUP7; ++rep7_) { pg8::Gemm g{XB, Wgu2, M, NGU, DM}; pg8::StaticOrder S; S.init(M, NGU, F.G, F.bid); pg8::EpiSwiGLULN E{BIG, DFF, pg8::RowStats{stats2, 1.f / DM, LN_EPS}, c1_gu, c2_gu};
        pg8::gemm_phase<pg8::EpiSwiGLULN, pg8::StaticOrder, true, true>(F.lds, g, S, E); }
    SEAM(7);
    if (IN(8)) { pg8::Gemm g{BIG, Wd2, M, DM, DFF}; pg8::StaticOrder S; S.init(M, DM, F.G, F.bid);
        pg8::EpiResidLNip E{F.hz, XB, stats2, gb2, DM, M, ALPHA, 0.5f, 1.f / DM, LN_EPS};
        pg8::gemm_phase<pg8::EpiResidLNip, pg8::StaticOrder, true, true>(F.lds, g, S, E); }
    SEAM(8);
    if (IN(9)) { pg8::Gemm g{XB, Wpg, M, DM, DM}; pg8::StaticOrder S; S.init(M, DM, F.G, F.bid);
        pg8::EpiPleLN E{F.hz, F.hz, EB, F.in[30], DM, ALPHA, pg8::RowStats{stats3, 1.f / DM, LN_EPS}, F.in[26], F.in[27], c1_pg, c2_pg};
        pg8::gemm_phase<pg8::EpiPleLN, pg8::StaticOrder, true, true>(F.lds, g, S, E); }
    SEAM(9);
    if (IN(10)) {
        if (!MK_PER_PHASE && xb_ld((unsigned*)(ctl + CW_BAR) + XB_TMO) != 0u) {
            const float q = __builtin_nanf(""); for (size_t i = (size_t)F.bid * NT + F.tid; i < (size_t)M * DM; i += (size_t)F.G * NT) F.hz[i] = q;
        } else ln_phase<false>(F, F.hz, F.in[31], F.in[32], nullptr);
    }
#undef IN
#undef SEAM
}

extern "C" void kernel_launch(void* const* d_in, const int* in_sizes, int n_in, void* d_out, int out_size, void* d_ws, size_t ws_size, hipStream_t stream) {
    static int grid = 0;
    if (grid == 0) {
        if (n_in != 33 || out_size != M * DM || ws_size < WS_END) { fprintf(stderr, "kernel_launch: unexpected problem (n_in %d out %d ws %zu, need %zu); nothing launched\n", n_in, out_size, ws_size, (size_t)WS_END); grid = -1; return; }
        int dev = 0, cus = 0;
        if (hipGetDevice(&dev) != hipSuccess || hipDeviceGetAttribute(&cus, hipDeviceAttributeMultiprocessorCount, dev) != hipSuccess) { grid = -1; return; }
        if (hipFuncSetAttribute((const void*)hymba_fwd, hipFuncAttributeMaxDynamicSharedMemorySize, LDS_BYTES) != hipSuccess) { fprintf(stderr, "kernel_launch: hipFuncSetAttribute failed\n"); grid = -1; return; }
        grid = cus > 0 ? cus : 256;
        fprintf(stderr, "kernel_launch: grid %d, ws %zu\n", grid, ws_size);
    }
    if (grid < 0) return;
    (void)hipMemsetAsync((char*)d_ws + WS_CTL, 0, CTL_ZERO_BYTES, stream);
    Args a{};
    for (int i = 0; i < 33; ++i) a.in[i] = (const float*)d_in[i];
    a.out = (float*)d_out; a.ws = (unsigned char*)d_ws;
#if MK_PER_PHASE
    for (int p = 0; p < NPHASE; ++p) { a.ph_lo = p; a.ph_hi = p + 1; const int reps = (p == REP_PHASE) ? 1 + REP_EXTRA : 1;
        for (int r = 0; r < reps; ++r) hipLaunchKernelGGL(hymba_fwd, dim3(grid), dim3(NT), LDS_BYTES, stream, a);
        if (p == 5 && REP_PHASE >= 20) { a.ph_lo = REP_PHASE; a.ph_hi = REP_PHASE + 1; hipLaunchKernelGGL(hymba_fwd, dim3(grid), dim3(NT), LDS_BYTES, stream, a); } }
#else
    a.ph_lo = 0; a.ph_hi = NPHASE;
    hipLaunchKernelGGL(hymba_fwd, dim3(grid), dim3(NT), LDS_BYTES, stream, a);
#endif
}
```
